# Optimizing an MI355X kernel written in HIP

```python
import math
import jax
import jax.numpy as jnp
from jax import lax
import numpy as np

D_MODEL = 2048
BATCH = 8
SEQ = 2048
DEPTH = 1

EPS = 1e-6
NEG = -1e30
HA = D_MODEL // 128
DK_A = 128
DV_A = 128
CONV_W = 4
CHUNK = 64
HB = D_MODEL // 128
G_KV = 4
R_GRP = HB // G_KV
DH_B = 128
ROT_DIM = DH_B // 4
ROPE_THETA = 500000.0
L_CMP = 32
STRIDE_CMP = 16
L_SLC = 64
T_SEL = 8
WINDOW = 512
Q_BLK = 32
N_EXP = 32
TOP_K = 4
D_FF = D_MODEL
SWIGLU_LIMIT = 7.0
SWIGLU_ALPHA = 1.702
MOE_BLK = 512
SPLIT_SIZES = (HA * DK_A, HA * DK_A, HA * DV_A, HA * DV_A, HA, HA,
               HB * DH_B, G_KV * DH_B, G_KV * DH_B, G_KV * DH_B, G_KV * DH_B, G_KV * DH_B, G_KV * DH_B,
               3 * HB, 2 * D_MODEL)
SPLIT_POINTS = tuple(sum(SPLIT_SIZES[:i + 1]) for i in range(len(SPLIT_SIZES) - 1))
D_IN = sum(SPLIT_SIZES)
CONV_DIM = 2 * HA * DK_A + HA * DV_A

kernel_name = 'hybrid_gdn_nsa_moe_block'


def rms_norm(x, gain):
    xf = x.astype(jnp.float32)
    y = xf * lax.rsqrt(jnp.mean(xf * xf, axis=-1, keepdims=True) + EPS)
    return (y * gain.astype(jnp.float32)).astype(x.dtype)


def l2_normalize(x):
    return x * lax.rsqrt(jnp.sum(x * x, axis=-1, keepdims=True) + EPS)


def partial_rotary(x, positions):
    half = ROT_DIM // 2
    inv_freq = ROPE_THETA ** (-jnp.arange(half, dtype=jnp.float32) * 2.0 / ROT_DIM)
    ang = positions.astype(jnp.float32)[..., None] * inv_freq
    cos = jnp.cos(ang)[:, :, None, :]
    sin = jnp.sin(ang)[:, :, None, :]
    xf = x.astype(jnp.float32)
    x1, x2 = xf[..., :half], xf[..., half:ROT_DIM]
    out = jnp.concatenate([x1 * cos - x2 * sin, x2 * cos + x1 * sin, xf[..., ROT_DIM:]], axis=-1)
    return out.astype(x.dtype)


def causal_short_conv(x, w):
    s = x.shape[1]
    xp = jnp.pad(x, ((0, 0), (CONV_W - 1, 0), (0, 0)))
    y = xp[:, 0:s] * w[0]
    for i in range(1, CONV_W):
        y = y + xp[:, i:i + s] * w[i]
    return y


def chunk_gated_delta_rule(q, k, v, g, beta):
    b, h, s, dk = q.shape
    dv = v.shape[-1]
    n = s // CHUNK
    q = q.reshape(b, h, n, CHUNK, dk)
    k = k.reshape(b, h, n, CHUNK, dk)
    v = v.reshape(b, h, n, CHUNK, dv)
    g = g.reshape(b, h, n, CHUNK)
    beta = beta.reshape(b, h, n, CHUNK)
    gc = jnp.cumsum(g, axis=-1)
    idx = jnp.arange(CHUNK)
    incl = idx[:, None] >= idx[None, :]
    strict = idx[:, None] > idx[None, :]
    decay = jnp.exp(jnp.where(incl, gc[..., :, None] - gc[..., None, :], -jnp.inf))
    k_beta = k * beta[..., None]
    v_beta = v * beta[..., None]
    lmat = jnp.where(strict, jnp.einsum('bhncd,bhnmd->bhncm', k_beta, k) * decay, 0.0)
    tmat = lmat + jnp.eye(CHUNK, dtype=q.dtype)
    u = lax.linalg.triangular_solve(tmat, v_beta, left_side=True, lower=True, unit_diagonal=True)
    w = lax.linalg.triangular_solve(tmat, k_beta * jnp.exp(gc)[..., None], left_side=True, lower=True,
                                    unit_diagonal=True)
    a_intra = jnp.einsum('bhncd,bhnmd->bhncm', q, k) * decay
    xs = tuple(jnp.moveaxis(t, 2, 0) for t in (q, k, u, w, gc, a_intra))

    def step(state, inp):
        qi, ki, ui, wi, gi, ai = inp
        v_new = ui - jnp.einsum('bhcd,bhde->bhce', wi, state)
        o = (jnp.einsum('bhcd,bhde->bhce', qi * jnp.exp(gi)[..., None], state)
             + jnp.einsum('bhcm,bhme->bhce', ai, v_new))
        g_last = gi[..., -1]
        k_dec = ki * jnp.exp(g_last[..., None] - gi)[..., None]
        state = state * jnp.exp(g_last)[..., None, None] + jnp.einsum('bhcd,bhce->bhde', k_dec, v_new)
        return state, o

    s0 = jnp.zeros((b, h, dk, dv), q.dtype)
    _, o = lax.scan(step, s0, xs)
    return jnp.moveaxis(o, 0, 2).reshape(b, h, s, dv)


def gated_deltanet(qa, ka, va, za, a_in, b_in, conv_w, a_log, dt_bias, norm_gdn):
    bsz, s, _ = qa.shape
    qkv = jax.nn.silu(causal_short_conv(jnp.concatenate([qa, ka, va], axis=-1), conv_w)).astype(jnp.float32)
    q, k, v = jnp.split(qkv, [HA * DK_A, 2 * HA * DK_A], axis=-1)
    q = l2_normalize(q.reshape(bsz, s, HA, DK_A).transpose(0, 2, 1, 3)) * (DK_A ** -0.5)
    k = l2_normalize(k.reshape(bsz, s, HA, DK_A).transpose(0, 2, 1, 3))
    v = v.reshape(bsz, s, HA, DV_A).transpose(0, 2, 1, 3)
    g = -jnp.exp(a_log.astype(jnp.float32)) * jax.nn.softplus(a_in.astype(jnp.float32) + dt_bias.astype(jnp.float32))
    beta = jax.nn.sigmoid(b_in.astype(jnp.float32))
    o = chunk_gated_delta_rule(q, k, v, g.transpose(0, 2, 1), beta.transpose(0, 2, 1))
    o = o.transpose(0, 2, 1, 3)
    o = rms_norm(o, norm_gdn) * jax.nn.silu(za.reshape(bsz, s, HA, DV_A).astype(jnp.float32))
    return o.reshape(bsz, s, HA * DV_A).astype(qa.dtype)


def compress_blocks(kv, pe, w1, w2):
    bsz, s, g, dh = kv.shape
    n_cmp = (s - L_CMP) // STRIDE_CMP + 1
    idx = np.arange(n_cmp)[:, None] * STRIDE_CMP + np.arange(L_CMP)[None, :]
    blk = kv[:, idx] + pe[None, None, :, None, :]
    flat = blk.transpose(0, 1, 3, 2, 4).reshape(bsz, n_cmp, g, L_CMP * dh)
    return jax.nn.gelu(flat @ w1) @ w2


def nsa_local_branches(q, k_slc, v_slc, k_win, v_win, sel):
    bsz, s, g, r, dh = q.shape
    scale = dh ** -0.5
    n_slc = s // L_SLC
    kblk = k_slc.reshape(bsz, n_slc, L_SLC, g, dh).transpose(0, 3, 1, 2, 4)
    vblk = v_slc.reshape(bsz, n_slc, L_SLC, g, dh).transpose(0, 3, 1, 2, 4)
    kpad = jnp.pad(k_win, ((0, 0), (WINDOW, 0), (0, 0), (0, 0)))
    vpad = jnp.pad(v_win, ((0, 0), (WINDOW, 0), (0, 0), (0, 0)))
    b_ix = jnp.arange(bsz)[:, None, None, None]
    g_ix = jnp.arange(g)[None, :, None, None]
    t_sel = sel.shape[-1]

    def body(qb):
        t0 = qb * Q_BLK
        t = t0 + jnp.arange(Q_BLK)
        qblk = lax.dynamic_slice_in_dim(q, t0, Q_BLK, axis=1)
        sb = lax.dynamic_slice_in_dim(sel, t0, Q_BLK, axis=2)
        ks = kblk[b_ix, g_ix, sb]
        vs = vblk[b_ix, g_ix, sb]
        s_sel = jnp.einsum('bqgrd,bgqkld->bgrqkl', qblk, ks).astype(jnp.float32) * scale
        key_pos = sb[..., None] * L_SLC + jnp.arange(L_SLC)
        ok = key_pos <= t[None, None, :, None, None]
        s_sel = jnp.where(ok[:, :, None], s_sel, NEG).reshape(bsz, g, r, Q_BLK, t_sel * L_SLC)
        p_sel = jax.nn.softmax(s_sel, axis=-1).astype(vs.dtype)
        o_slc = jnp.einsum('bgrqn,bgqnd->bqgrd', p_sel, vs.reshape(bsz, g, Q_BLK, t_sel * L_SLC, dh))
        kw = lax.dynamic_slice_in_dim(kpad, t0, WINDOW + Q_BLK, axis=1)
        vw = lax.dynamic_slice_in_dim(vpad, t0, WINDOW + Q_BLK, axis=1)
        j = t0 - WINDOW + jnp.arange(WINDOW + Q_BLK)
        wmask = (j[None, :] <= t[:, None]) & (j[None, :] > t[:, None] - WINDOW) & (j[None, :] >= 0)
        s_win = jnp.einsum('bqgrd,bkgd->bgrqk', qblk, kw).astype(jnp.float32) * scale
        p_win = jax.nn.softmax(jnp.where(wmask, s_win, NEG), axis=-1).astype(vw.dtype)
        o_win = jnp.einsum('bgrqk,bkgd->bqgrd', p_win, vw)
        return o_slc, o_win

    o_slc, o_win = lax.map(body, jnp.arange(s // Q_BLK))
    o_slc = jnp.moveaxis(o_slc, 0, 1).reshape(bsz, s, g, r, dh)
    o_win = jnp.moveaxis(o_win, 0, 1).reshape(bsz, s, g, r, dh)
    return o_slc, o_win


def native_sparse_attention(qb, kc, vc, ks, vs, kw, vw, gb, positions, pe_ck, w1_ck, w2_ck, pe_cv, w1_cv, w2_cv):
    bsz, s, _ = qb.shape
    scale = DH_B ** -0.5
    q = partial_rotary(qb.reshape(bsz, s, HB, DH_B), positions).reshape(bsz, s, G_KV, R_GRP, DH_B)
    kc = partial_rotary(kc.reshape(bsz, s, G_KV, DH_B), positions)
    ks = partial_rotary(ks.reshape(bsz, s, G_KV, DH_B), positions)
    kw = partial_rotary(kw.reshape(bsz, s, G_KV, DH_B), positions)
    vc = vc.reshape(bsz, s, G_KV, DH_B)
    vs = vs.reshape(bsz, s, G_KV, DH_B)
    vw = vw.reshape(bsz, s, G_KV, DH_B)
    k_cmp = compress_blocks(kc, pe_ck, w1_ck, w2_ck)
    v_cmp = compress_blocks(vc, pe_cv, w1_cv, w2_cv)
    n_cmp = k_cmp.shape[1]
    t = jnp.arange(s)
    cmp_valid = (jnp.arange(n_cmp) * STRIDE_CMP + L_CMP - 1)[None, :] <= t[:, None]
    s_cmp = jnp.einsum('bsgrd,bcgd->bgrsc', q, k_cmp).astype(jnp.float32) * scale
    p_cmp = jax.nn.softmax(jnp.where(cmp_valid, s_cmp, NEG), axis=-1)
    p_cmp = jnp.where(jnp.any(cmp_valid, axis=-1)[:, None], p_cmp, 0.0)
    o_cmp = jnp.einsum('bgrsc,bcgd->bsgrd', p_cmp.astype(v_cmp.dtype), v_cmp)
    n_slc = s // L_SLC
    c_start = np.arange(n_cmp) * STRIDE_CMP
    j_start = np.arange(n_slc) * L_SLC
    overlap = ((c_start[:, None] < j_start[None, :] + L_SLC)
               & (c_start[:, None] + L_CMP > j_start[None, :])).astype(np.float32)
    imp = jnp.einsum('bgrsc,cj->bgsj', p_cmp, jnp.asarray(overlap))
    blk = jnp.arange(n_slc)
    cur = t // L_SLC
    forced = (blk[None, :] == 0) | (blk[None, :] == cur[:, None])
    imp = jnp.where(forced, jnp.inf, jnp.where(blk[None, :] <= cur[:, None], imp, -jnp.inf))
    _, sel = lax.top_k(imp, min(T_SEL, n_slc))
    o_slc, o_win = nsa_local_branches(q, ks, vs, kw, vw, sel)
    gates = jax.nn.sigmoid(gb.astype(jnp.float32)).reshape(bsz, s, G_KV, R_GRP, 3)
    o = gates[..., 0:1] * o_cmp + gates[..., 1:2] * o_slc + gates[..., 2:3] * o_win
    return o.reshape(bsz, s, HB * DH_B).astype(qb.dtype)


def moe_ffn(h, w_router, b_router, w_gate, b_gate, w_up, b_up, w_down, b_down):
    bsz, s, d = h.shape
    xt = h.reshape(-1, d)
    n_tok = xt.shape[0]
    logits = (xt @ w_router + b_router).astype(jnp.float32)
    top_val, top_idx = lax.top_k(logits, TOP_K)
    weights = jax.nn.softmax(top_val, axis=-1)
    n_asg = n_tok * TOP_K
    e_flat = top_idx.reshape(-1)
    w_flat = weights.reshape(-1).astype(h.dtype)
    tok = jnp.arange(n_asg, dtype=jnp.int32) // TOP_K
    order = jnp.argsort(e_flat)
    e_sorted = e_flat[order]
    tok_sorted = tok[order]
    counts = jnp.zeros((N_EXP,), jnp.int32).at[e_flat].add(1)
    padded = ((counts + MOE_BLK - 1) // MOE_BLK) * MOE_BLK
    pad_end = jnp.cumsum(padded)
    pad_start = pad_end - padded
    start = jnp.cumsum(counts) - counts
    dest = pad_start[e_sorted] + jnp.arange(n_asg, dtype=jnp.int32) - start[e_sorted]
    n_blocks = (n_asg + N_EXP * (MOE_BLK - 1) + MOE_BLK - 1) // MOE_BLK
    rows = jnp.zeros((n_blocks * MOE_BLK, d), h.dtype).at[dest].set(xt[tok_sorted])
    block_e = jnp.minimum(jnp.searchsorted(pad_end, jnp.arange(n_blocks) * MOE_BLK, side='right'), N_EXP - 1)

    def expert_block(args):
        xb, e = args
        gate = jnp.minimum(xb @ w_gate[e] + b_gate[e], SWIGLU_LIMIT)
        up = jnp.clip(xb @ w_up[e] + b_up[e], -SWIGLU_LIMIT, SWIGLU_LIMIT)
        act = (up + 1.0) * gate * jax.nn.sigmoid(SWIGLU_ALPHA * gate)
        return act @ w_down[e] + b_down[e]

    yb = lax.map(expert_block, (rows.reshape(n_blocks, MOE_BLK, d), block_e))
    y_asg = yb.reshape(-1, d)[dest] * w_flat[order][:, None]
    out = jax.ops.segment_sum(y_asg, tok_sorted, num_segments=n_tok)
    return out.reshape(bsz, s, d)


def hybrid_layer(x, positions, norm_mix, w_in, conv_w, a_log, dt_bias, norm_gdn, pe_ck, w1_ck, w2_ck,
                 pe_cv, w1_cv, w2_cv, w_proj_a, w_proj_b, w_out, norm_ffn, w_router, b_router,
                 w_gate, b_gate, w_up, b_up, w_down, b_down):
    bsz, s, d = x.shape
    h = rms_norm(x, norm_mix)
    (qa, ka, va, za, aa, ba, qb, kc, vc, ks, vs, kw, vw, gb, gm) = jnp.split(h @ w_in, SPLIT_POINTS, axis=-1)
    y_a = gated_deltanet(qa, ka, va, za, aa, ba, conv_w, a_log, dt_bias, norm_gdn) @ w_proj_a
    y_b = native_sparse_attention(qb, kc, vc, ks, vs, kw, vw, gb, positions,
                                  pe_ck, w1_ck, w2_ck, pe_cv, w1_cv, w2_cv) @ w_proj_b
    gm = jax.nn.sigmoid(gm.astype(jnp.float32)).reshape(bsz, s, 2, d)
    merged = (gm[:, :, 0] * y_a + gm[:, :, 1] * y_b).astype(x.dtype)
    x = x + merged @ w_out
    x = x + moe_ffn(rms_norm(x, norm_ffn), w_router, b_router, w_gate, b_gate, w_up, b_up, w_down, b_down)
    return x


def setup_inputs(seed: int = 0) -> dict:
    key = jax.random.key(seed)
    ks = jax.random.split(key, 32)
    L = DEPTH
    f32 = jnp.float32

    def nrm(k, shape, fan_in):
        return jax.random.normal(k, shape, f32) * (fan_in ** -0.5)

    def gain(k, shape):
        return 1.0 + 0.02 * jax.random.normal(k, shape, f32)

    x = jax.random.normal(ks[0], (BATCH, SEQ, D_MODEL), f32)
    positions = (jnp.arange(SEQ, dtype=jnp.int32)[None, :]
                 + jax.random.randint(ks[1], (BATCH, 1), 0, 4096, dtype=jnp.int32))
    norm_mix = gain(ks[2], (L, D_MODEL))
    w_in = nrm(ks[3], (L, D_MODEL, D_IN), D_MODEL)
    conv_w = nrm(ks[4], (L, CONV_W, CONV_DIM), CONV_W)
    a_log = jnp.log(jax.random.uniform(ks[5], (L, HA), f32, minval=1.0, maxval=16.0))
    dt = jnp.exp(jax.random.uniform(ks[6], (L, HA), f32, minval=math.log(1e-3), maxval=math.log(1e-1)))
    dt_bias = dt + jnp.log(-jnp.expm1(-dt))
    norm_gdn = gain(ks[7], (L, DV_A))
    pe_ck = 0.02 * jax.random.normal(ks[8], (L, L_CMP, DH_B), f32)
    w1_ck = nrm(ks[9], (L, L_CMP * DH_B, DH_B), L_CMP * DH_B)
    w2_ck = nrm(ks[10], (L, DH_B, DH_B), DH_B)
    pe_cv = 0.02 * jax.random.normal(ks[11], (L, L_CMP, DH_B), f32)
    w1_cv = nrm(ks[12], (L, L_CMP * DH_B, DH_B), L_CMP * DH_B)
    w2_cv = nrm(ks[13], (L, DH_B, DH_B), DH_B)
    w_proj_a = nrm(ks[14], (L, HA * DV_A, D_MODEL), HA * DV_A)
    w_proj_b = nrm(ks[15], (L, HB * DH_B, D_MODEL), HB * DH_B)
    w_out = nrm(ks[16], (L, D_MODEL, D_MODEL), D_MODEL)
    norm_ffn = gain(ks[17], (L, D_MODEL))
    w_router = nrm(ks[18], (L, D_MODEL, N_EXP), D_MODEL)
    b_router = 0.01 * jax.random.normal(ks[19], (L, N_EXP), f32)
    w_gate = nrm(ks[20], (L, N_EXP, D_MODEL, D_FF), D_MODEL)
    b_gate = 0.01 * jax.random.normal(ks[21], (L, N_EXP, D_FF), f32)
    w_up = nrm(ks[22], (L, N_EXP, D_MODEL, D_FF), D_MODEL)
    b_up = 0.01 * jax.random.normal(ks[23], (L, N_EXP, D_FF), f32)
    w_down = nrm(ks[24], (L, N_EXP, D_FF, D_MODEL), D_FF)
    b_down = 0.01 * jax.random.normal(ks[25], (L, N_EXP, D_MODEL), f32)
    norm_final = gain(ks[26], (D_MODEL,))
    return {'x': x, 'positions': positions, 'norm_mix': norm_mix, 'w_in': w_in, 'conv_w': conv_w,
            'a_log': a_log, 'dt_bias': dt_bias, 'norm_gdn': norm_gdn,
            'pe_ck': pe_ck, 'w1_ck': w1_ck, 'w2_ck': w2_ck, 'pe_cv': pe_cv, 'w1_cv': w1_cv, 'w2_cv': w2_cv,
            'w_proj_a': w_proj_a, 'w_proj_b': w_proj_b, 'w_out': w_out, 'norm_ffn': norm_ffn,
            'w_router': w_router, 'b_router': b_router, 'w_gate': w_gate, 'b_gate': b_gate,
            'w_up': w_up, 'b_up': b_up, 'w_down': w_down, 'b_down': b_down, 'norm_final': norm_final}


def reference(x, positions, norm_mix, w_in, conv_w, a_log, dt_bias, norm_gdn, pe_ck, w1_ck, w2_ck,
              pe_cv, w1_cv, w2_cv, w_proj_a, w_proj_b, w_out, norm_ffn, w_router, b_router,
              w_gate, b_gate, w_up, b_up, w_down, b_down, norm_final):
    for l in range(DEPTH):
        x = hybrid_layer(x, positions, norm_mix[l], w_in[l], conv_w[l], a_log[l], dt_bias[l], norm_gdn[l],
                         pe_ck[l], w1_ck[l], w2_ck[l], pe_cv[l], w1_cv[l], w2_cv[l],
                         w_proj_a[l], w_proj_b[l], w_out[l], norm_ffn[l], w_router[l], b_router[l],
                         w_gate[l], b_gate[l], w_up[l], b_up[l], w_down[l], b_down[l])
    return rms_norm(x, norm_final)
```

```cpp
#include <hip/hip_runtime.h>
#include <cstdio>
#include <cstdint>
namespace pg8 {
#define PG8_LAS __attribute__((address_space(3)))
typedef unsigned short bf16_t;
typedef short bf16x8 __attribute__((ext_vector_type(8)));
typedef float f32x4 __attribute__((ext_vector_type(4)));
typedef unsigned u32x4 __attribute__((ext_vector_type(4)));
constexpr int BM = 256, BK = 64, HALF = 128, HTB = HALF * BK * 2  , STAGE_BYTES = 8 * HTB, NXCD = 8, WGM = 8;

__host__ __device__ __forceinline__ int lds_byte(int r, int c) { const int st = (r >> 4) * 2 + (c >> 5), rr = r & 15, cc = c & 31, ob = rr * 64 + cc * 2; return st * 1024 + (ob ^ (((ob >> 9) & 1) << 5)); }
__host__ __device__ __forceinline__ void stage_rc(int b, int& R, int& C) { const int st = b / 1024, sb = b % 1024, swz = sb ^ (((sb >> 9) & 1) << 5); R = (st >> 1) * 16 + swz / 64; C = (st & 1) * 32 + (swz % 64) / 2; }
__host__ __device__ __forceinline__ int perm32(int rho) { const int n = rho >> 4, i = rho & 15; return 8 * (i >> 2) + 4 * n + (i & 3); }

struct Unit { int pm, pn; };
struct Gemm { const bf16_t* A; const bf16_t* Bt; int M, N, K; };

struct StaticOrder {
    static constexpr bool GATHER = false;
    static constexpr int B_AUX = 0;
    __device__ __forceinline__ bool upper_half_empty(const Unit&) const { return false; }
    int nM, nN, nwg, G, c;
    __host__ __device__ void init(int M, int N, int G_, int c_) { nM = M / BM; nN = N / BM; nwg = nM * nN; G = G_; c = c_; }
    __host__ __device__ bool next(int i, Unit& u) const {
        const long L = (long)i * G + c; if (L >= nwg) return false;
        int wgid = (int)L; { const int q = nwg / NXCD, r = nwg % NXCD, xcd = wgid % NXCD, off = wgid / NXCD; wgid = (xcd < r ? xcd * (q + 1) : r * (q + 1) + (xcd - r) * q) + off; }
        const int nig = WGM * nN, gid = wgid / nig, fm = gid * WGM, gsz = (nM - fm) < WGM ? (nM - fm) : WGM;
        u.pm = fm + ((wgid % nig) % gsz); u.pn = (wgid % nig) / gsz; return true;
    }
    __device__ __forceinline__ void a_ready(const Unit&) const {}
    __device__ __forceinline__ void done(const Unit&) const {}
};

__device__ __forceinline__ unsigned cvt_pk_bf16(float lo, float hi) { unsigned r; asm volatile("v_cvt_pk_bf16_f32 %0, %1, %2" : "=v"(r) : "v"(lo), "v"(hi)); return r; }
typedef float f32x2 __attribute__((ext_vector_type(2)));

template <class Epi, class Sched, bool ALIGN_EPI = false, bool SP2 = false>
__device__ __forceinline__ void gemm_phase(PG8_LAS unsigned char* lds, const Gemm g, const Sched& S, const Epi& E) {
    const int tid = threadIdx.x, wid = __builtin_amdgcn_readfirstlane(tid >> 6), lane = tid & 63, wr = wid >> 2, wc = wid & 3, fr = lane & 15, fq = lane >> 4;
    const int K = g.K, nt = K / BK;
    unsigned voffA[2], voffB[2];
#pragma unroll
    for (int i = 0; i < 2; ++i) { int R, C; stage_rc(tid * 16 + i * 8192, R, C); const int Rb = Epi::PERM ? ((R & ~31) + perm32(R & 31)) : R;
        voffA[i] = (unsigned)(R * K + C) * 2u; voffB[i] = (unsigned)(Rb * K + C) * 2u; }
    const size_t kstep = (size_t)(BK * 2);
    const size_t hstep = (size_t)HALF * K * 2;
    const size_t tstep = 2 * hstep;
    const unsigned ldsw = (unsigned)wid * 1024u;
    const int aoff = lds_byte(wr * 64 + fr, fq * 8), boff = lds_byte(wc * 32 + fr, fq * 8);
#define PG8_SA(b, h) (((b) * 2 + (h)) * HTB)
#define PG8_SB(b, h) ((4 + (b) * 2 + (h)) * HTB)
#define PG8_STAGE(bufoff, gbase, voff) do { _Pragma("unroll") for (int _i = 0; _i < 2; ++_i) \
        __builtin_amdgcn_global_load_lds((const unsigned*)((const char*)(gbase) + (voff)[_i]), (PG8_LAS unsigned*)(lds + (bufoff) + ldsw + _i * 8192), 16, 0, 0); } while (0)
#define PG8_STAGE_BW(bufoff, gbase, voff) do { _Pragma("unroll") for (int _i = 0; _i < 2; ++_i) \
        __builtin_amdgcn_global_load_lds((const unsigned*)((const char*)(gbase) + (voff)[_i]), (PG8_LAS unsigned*)(lds + (bufoff) + ldsw + _i * 8192), 16, 0, Sched::B_AUX); } while (0)
#define PG8_LDA(dst, b, h) do { _Pragma("unroll") for (int m = 0; m < 4; ++m) _Pragma("unroll") for (int k = 0; k < 2; ++k) dst[m][k] = *(const PG8_LAS bf16x8*)(lds + PG8_SA(b, h) + aoff + m * 2048 + k * 1024); } while (0)
#define PG8_LDB(dst, b, h) do { _Pragma("unroll") for (int n = 0; n < 2; ++n) _Pragma("unroll") for (int k = 0; k < 2; ++k) dst[n][k] = *(const PG8_LAS bf16x8*)(lds + PG8_SB(b, h) + boff + n * 2048 + k * 1024); } while (0)
#define PG8_MMA(ai, bj, At, Bt) do { __builtin_amdgcn_s_setprio(1); _Pragma("unroll") for (int m = 0; m < 4; ++m) _Pragma("unroll") for (int n = 0; n < 2; ++n) _Pragma("unroll") for (int k = 0; k < 2; ++k) \
        acc[ai][bj][m][n] = __builtin_amdgcn_mfma_f32_16x16x32_bf16(Bt[n][k], At[m][k], acc[ai][bj][m][n], 0, 0, 0); __builtin_amdgcn_s_setprio(0); } while (0)
#define PG8_WAIT_V(n) asm volatile("s_waitcnt vmcnt(" #n ")" ::: "memory")
#define PG8_WAIT_L(n) asm volatile("s_waitcnt lgkmcnt(" #n ")" ::: "memory")
#define PG8_BAR __builtin_amdgcn_s_barrier()
#define PG8_SCHED __builtin_amdgcn_sched_barrier(0)
    Unit cur, nxt; int ui = 0;
    if (!S.next(0, cur)) return;
    unsigned vGc[2][2] = {{0u, 0u}, {0u, 0u}}, vGn[2][2] = {{0u, 0u}, {0u, 0u}};
    if constexpr (Sched::GATHER) {
#pragma unroll
        for (int h = 0; h < 2; ++h)
#pragma unroll
            for (int i = 0; i < 2; ++i) { int R, Cc; stage_rc(tid * 16 + i * 8192, R, Cc); vGc[h][i] = S.row_of(cur, h * HALF + R) * (unsigned)(K * 2) + (unsigned)(Cc * 2); }
    }
#define PG8_STAGE_A(bufoff, aptr, half, nx) do { if constexpr (Sched::GATHER) { _Pragma("unroll") for (int _i = 0; _i < 2; ++_i) { const unsigned _vo = (nx) ? vGn[half][_i] : vGc[half][_i]; \
        __builtin_amdgcn_global_load_lds((const unsigned*)((const char*)(aptr) + _vo), (PG8_LAS unsigned*)(lds + (bufoff) + ldsw + _i * 8192), 16, 0, 0); } } \
        else { PG8_STAGE(bufoff, (aptr) + ((half) ? hstep : 0), voffA); } } while (0)
    f32x4 acc[2][2][4][2];
#pragma unroll
    for (int a = 0; a < 2; ++a)
#pragma unroll
        for (int b = 0; b < 2; ++b)
#pragma unroll
            for (int m = 0; m < 4; ++m)
#pragma unroll
                for (int n = 0; n < 2; ++n) acc[a][b][m][n] = (f32x4){0.f, 0.f, 0.f, 0.f};
    bf16x8 At[4][2], B0[2][2], B1[2][2];
    const char* cA = (const char*)g.A + (Sched::GATHER ? (size_t)0 : (size_t)cur.pm * tstep); const char* cB = (const char*)g.Bt + (size_t)cur.pn * tstep;
    S.a_ready(cur);
    if constexpr (SP2) {
        PG8_STAGE_BW(PG8_SB(0, 0), cB, voffB); PG8_STAGE_BW(PG8_SB(0, 1), cB + hstep, voffB); PG8_STAGE_A(PG8_SA(0, 0), cA, 0, false); PG8_STAGE_A(PG8_SA(0, 1), cA, 1, false);
        if (wr == 1) PG8_BAR;
        PG8_WAIT_V(2); PG8_BAR;
        PG8_STAGE_BW(PG8_SB(1, 0), cB + kstep, voffB); PG8_STAGE_A(PG8_SA(1, 0), cA + kstep, 0, false); PG8_STAGE_BW(PG8_SB(1, 1), cB + hstep + kstep, voffB);
        PG8_WAIT_V(6); PG8_BAR;
    } else {
        PG8_STAGE_BW(PG8_SB(0, 0), cB, voffB); PG8_STAGE_A(PG8_SA(0, 0), cA, 0, false); PG8_STAGE_BW(PG8_SB(0, 1), cB + hstep, voffB); PG8_STAGE_A(PG8_SA(0, 1), cA, 1, false);
        if (wr == 1) PG8_BAR;
        PG8_WAIT_V(4); PG8_BAR;
        PG8_STAGE_BW(PG8_SB(1, 0), cB + kstep, voffB); PG8_STAGE_A(PG8_SA(1, 0), cA + kstep, 0, false); PG8_STAGE_BW(PG8_SB(1, 1), cB + hstep + kstep, voffB);
        PG8_WAIT_V(6); PG8_BAR;
    }
    for (;;) {
        const bool has_next = S.next(ui + 1, nxt);
        if constexpr (Sched::GATHER) { if (has_next) {
#pragma unroll
            for (int h = 0; h < 2; ++h)
#pragma unroll
                for (int i = 0; i < 2; ++i) { int R, Cc; stage_rc(tid * 16 + i * 8192, R, Cc); vGn[h][i] = S.row_of(nxt, h * HALF + R) * (unsigned)(K * 2) + (unsigned)(Cc * 2); } }
            else { vGn[0][0] = vGc[0][0]; vGn[0][1] = vGc[0][1]; vGn[1][0] = vGc[1][0]; vGn[1][1] = vGc[1][1]; } }
        const char* nA = (has_next && !Sched::GATHER) ? (const char*)g.A + (size_t)nxt.pm * tstep : cA; const char* nB = has_next ? (const char*)g.Bt + (size_t)nxt.pn * tstep : cB;
        for (int t = 0; t < nt; t += 2) {
            const bool last = (t == nt - 2);
            const char* a1 = cA + (size_t)(t + 1) * kstep;
            const char* a2 = last ? nA : cA + (size_t)(t + 2) * kstep; const char* b2 = last ? nB : cB + (size_t)(t + 2) * kstep;
            const char* a3 = a2 + kstep; const char* b3 = b2 + kstep;
            if (last && has_next) S.a_ready(nxt);
            if constexpr (SP2) {
            PG8_LDB(B0, 0, 0); PG8_LDB(B1, 0, 1); PG8_SCHED; PG8_LDA(At, 0, 0); PG8_STAGE_A(PG8_SA(1, 1), a1, 1, false);
            PG8_WAIT_V(8); PG8_WAIT_L(0); PG8_BAR; PG8_MMA(0, 0, At, B0); PG8_MMA(0, 1, At, B1); PG8_BAR; PG8_SCHED;
            PG8_LDA(At, 0, 1); PG8_STAGE_BW(PG8_SB(0, 0), b2, voffB); PG8_STAGE_BW(PG8_SB(0, 1), b2 + hstep, voffB); PG8_STAGE_A(PG8_SA(0, 0), a2, 0, last);
            PG8_WAIT_V(8); PG8_WAIT_L(0); PG8_BAR; PG8_MMA(1, 0, At, B0); PG8_MMA(1, 1, At, B1); PG8_BAR; PG8_SCHED;
            PG8_LDB(B0, 1, 0); PG8_LDB(B1, 1, 1); PG8_SCHED; PG8_LDA(At, 1, 0); PG8_STAGE_A(PG8_SA(0, 1), a2, 1, last);
            PG8_WAIT_V(8); PG8_WAIT_L(0); PG8_BAR; PG8_MMA(0, 0, At, B0); PG8_MMA(0, 1, At, B1); PG8_BAR; PG8_SCHED;
            PG8_LDA(At, 1, 1); PG8_STAGE_BW(PG8_SB(1, 0), b3, voffB); PG8_STAGE_BW(PG8_SB(1, 1), b3 + hstep, voffB); PG8_STAGE_A(PG8_SA(1, 0), a3, 0, last);
            PG8_WAIT_V(8); PG8_WAIT_L(0); PG8_BAR; PG8_MMA(1, 0, At, B0); PG8_MMA(1, 1, At, B1); PG8_BAR; PG8_SCHED;
            } else {
            PG8_LDB(B0, 0, 0); PG8_SCHED; PG8_LDA(At, 0, 0); PG8_STAGE_A(PG8_SA(1, 1), a1, 1, false);
            PG8_WAIT_L(8); PG8_BAR; PG8_WAIT_L(0); PG8_MMA(0, 0, At, B0); PG8_BAR; PG8_SCHED;
            PG8_LDB(B1, 0, 1); PG8_STAGE_BW(PG8_SB(0, 0), b2, voffB);
            PG8_BAR; PG8_WAIT_L(0); PG8_MMA(0, 1, At, B1); PG8_BAR;
            PG8_LDA(At, 0, 1); PG8_STAGE_A(PG8_SA(0, 0), a2, 0, last);
            PG8_BAR; PG8_WAIT_L(0); PG8_MMA(1, 0, At, B0); PG8_BAR; PG8_SCHED;
            PG8_STAGE_BW(PG8_SB(0, 1), b2 + hstep, voffB);
            PG8_WAIT_V(6); PG8_BAR; PG8_MMA(1, 1, At, B1); PG8_BAR;
            PG8_LDB(B0, 1, 0); PG8_SCHED; PG8_LDA(At, 1, 0); PG8_STAGE_A(PG8_SA(0, 1), a2, 1, last);
            PG8_WAIT_L(8); PG8_BAR; PG8_WAIT_L(0); PG8_MMA(0, 0, At, B0); PG8_BAR; PG8_SCHED;
            PG8_LDB(B1, 1, 1); PG8_STAGE_BW(PG8_SB(1, 0), b3, voffB);
            PG8_BAR; PG8_WAIT_L(0); PG8_MMA(0, 1, At, B1); PG8_BAR;
            PG8_LDA(At, 1, 1); PG8_STAGE_A(PG8_SA(1, 0), a3, 0, last);
            PG8_BAR; PG8_WAIT_L(0); PG8_MMA(1, 0, At, B0); PG8_BAR; PG8_SCHED;
            PG8_STAGE_BW(PG8_SB(1, 1), b3 + hstep, voffB);
            PG8_WAIT_V(6); PG8_BAR; PG8_MMA(1, 1, At, B1); PG8_BAR;
            }
        }
        if constexpr (ALIGN_EPI) { if (wr == 0) PG8_BAR; }
        if constexpr (!Epi::AFTER_DRAIN) { E(acc, cur, wr, wc, fr, fq); S.done(cur); }
        if (!has_next) break;
#pragma unroll
        for (int a = 0; a < 2; ++a)
#pragma unroll
            for (int b = 0; b < 2; ++b)
#pragma unroll
                for (int m = 0; m < 4; ++m)
#pragma unroll
                    for (int n = 0; n < 2; ++n) acc[a][b][m][n] = (f32x4){0.f, 0.f, 0.f, 0.f};
        cur = nxt; cA = nA; cB = nB; ++ui;
        if constexpr (Sched::GATHER) { vGc[0][0] = vGn[0][0]; vGc[0][1] = vGn[0][1]; vGc[1][0] = vGn[1][0]; vGc[1][1] = vGn[1][1]; }
        if constexpr (ALIGN_EPI) { if (wr == 1) PG8_BAR; }
    }
    PG8_WAIT_V(0);
    if constexpr (!ALIGN_EPI) { if (wr == 0) PG8_BAR; }
    PG8_BAR;
    if constexpr (Epi::AFTER_DRAIN) { E.fused(acc, cur, wr, wc, fr, fq, lds, wid, lane); S.done(cur); }
#undef PG8_SA
#undef PG8_SB
#undef PG8_STAGE
#undef PG8_STAGE_BW
#undef PG8_STAGE_A
#undef PG8_LDA
#undef PG8_LDB
#undef PG8_MMA
#undef PG8_WAIT_V
#undef PG8_WAIT_L
#undef PG8_BAR
#undef PG8_SCHED
}
}
#ifndef PG8_SP2
#define PG8_SP2 true
#endif
#ifndef PG8_ALIGN
#define PG8_ALIGN true
#endif
constexpr int NWAVES = 8, NTHR = 512;
constexpr int BATCH = 8, SEQ = 2048, DM = 2048, T = BATCH * SEQ;
constexpr int HA = 16, DKA = 128, CHUNK = 64;
constexpr int HB = 16, GKV = 4, RG = 4, DH = 128;
constexpr int NCMP = 127, NSLC = 32, WIN = 512;
constexpr int NEXP = 32, TOPK = 4, DFF = 2048;
constexpr int DIN = 17488, NP = 17664;
constexpr int C_QA = 0, C_KA = 2048, C_VA = 4096, C_ZA = 6144, C_QB = 8192, C_KC = 10240, C_VC = 10752, C_KS = 11264, C_VS = 11776,
              C_KW = 12288, C_VW = 12800, C_GM = 13312, C_AA = 17408, C_BA = 17424, C_GB = 17440;
constexpr unsigned long long ROTMASK = (0x3FFull << 32) | (3ull << 44) | (3ull << 48);
constexpr float EPS = 1e-6f;
constexpr int MOE_ROWS = T * TOPK + NEXP * 256;

constexpr size_t MiB = 1u << 20;
constexpr size_t WS_CTL = 0, CTL_ZERO_BYTES = 1 * MiB;
constexpr size_t WS_RC = 1 * MiB, WS_RS = 2 * MiB, WS_G = 3 * MiB, WS_BETA = 4 * MiB, WS_KCMP = 5 * MiB, WS_VCMP = 7 * MiB, WS_SEL = 9 * MiB;
constexpr size_t WS_TOPE = 10 * MiB, WS_TOPW = WS_TOPE + 256 * 1024, WS_POS = WS_TOPW + 256 * 1024, WS_DEST = WS_POS + 256 * 1024;
constexpr size_t WS_WINT = 16 * MiB, WS_WPA = 85 * MiB, WS_WPB = 93 * MiB, WS_WOT = 101 * MiB;
constexpr size_t WS_H = 112 * MiB, WS_OWB = 112 * MiB, WS_OB = 176 * MiB, WS_P = 240 * MiB;
constexpr size_t WS_OSB = 792 * MiB, WS_OA = 856 * MiB, WS_M1 = 920 * MiB, WS_MERGED = 984 * MiB, WS_OCB = 1112 * MiB;
constexpr size_t WS_WGU = 1280 * MiB, WS_WD = 1792 * MiB, WS_END = 2048 * MiB;
constexpr size_t WS_X1 = 240 * MiB, WS_HN = 368 * MiB, WS_XG = 432 * MiB, WS_ACT = 720 * MiB, WS_Y = 432 * MiB;
static_assert(WS_P + (size_t)T * NP * 2 <= WS_OSB && WS_ACT + (size_t)MOE_ROWS * DFF * 2 <= WS_WGU && WS_WINT + (size_t)NP * DM * 2 <= WS_WPA, "ws map");
constexpr int CW_BAR = 4096;
constexpr int CW_CNT = 2048;
constexpr int CW_CQ = 2304;

constexpr int RING_OFF = 0, RING_BYTES = 131072;
constexpr int XTRA_OFF = RING_BYTES;
constexpr int TAB_OFF = 145920;
constexpr int MISC_OFF = 146944;
constexpr int LDS_BYTES = 147456;

#define GAS __attribute__((address_space(1)))
#define LAS __attribute__((address_space(3)))
typedef unsigned short bf16;
typedef unsigned v4u __attribute__((ext_vector_type(4)));
typedef unsigned v2u __attribute__((ext_vector_type(2)));
typedef float f32x4 __attribute__((ext_vector_type(4)));
typedef short bf16x8 __attribute__((ext_vector_type(8)));
#define LDS_WAIT() asm volatile("s_waitcnt lgkmcnt(0)" ::: "memory")
#define VM_WAIT() asm volatile("s_waitcnt vmcnt(0)" ::: "memory")
__device__ __forceinline__ unsigned f2bf(float f) { unsigned u = __builtin_bit_cast(unsigned, f); return (u + 0x7fffu + ((u >> 16) & 1u)) >> 16; }
__device__ __forceinline__ unsigned pk2(float lo, float hi) { return f2bf(lo) | (f2bf(hi) << 16); }
__device__ __forceinline__ float bf2f(unsigned short b) { return __builtin_bit_cast(float, ((unsigned)b) << 16); }
__device__ __forceinline__ float bflo(unsigned w) { return __builtin_bit_cast(float, w << 16); }
__device__ __forceinline__ float bfhi(unsigned w) { return __builtin_bit_cast(float, w & 0xffff0000u); }
__device__ __forceinline__ float sigmoidf_(float x) { return __builtin_amdgcn_rcpf(1.f + __expf(-x)); }
__device__ __forceinline__ float wave_sum(float v) {
#pragma unroll
    for (int o = 1; o < 64; o <<= 1) v += __shfl_xor(v, o);
    return v;
}
__device__ __forceinline__ float wave_max(float v) {
#pragma unroll
    for (int o = 1; o < 64; o <<= 1) v = fmaxf(v, __shfl_xor(v, o));
    return v;
}
#define XB_TMO      128
#define XB_XCNT(j)  (256  + 64 * (j))
#define XB_XSUB(j)  (1280 + 64 * (j))
#define XB_XGEN(j)  (2304 + 64 * (j))
#define XB_TOP      3328
#define XB_TOPGEN   3392
#define XCD_BAR_WORDS 3456
#define XB_SPIN_CAP (1u << 18)

__device__ __forceinline__ unsigned xb_ld(unsigned* p)              { return __hip_atomic_load(p, __ATOMIC_RELAXED, __HIP_MEMORY_SCOPE_AGENT); }
__device__ __forceinline__ unsigned xb_add(unsigned* p, unsigned v) { return __hip_atomic_fetch_add(p, v, __ATOMIC_RELAXED, __HIP_MEMORY_SCOPE_AGENT); }
__device__ __forceinline__ unsigned xb_xcc_id() { return (unsigned)__builtin_amdgcn_s_getreg((3 << 11) | 20) & 0xFu; }
#define XB_SPIN(cond, bar) do { unsigned _sp = 0; while (cond) { __builtin_amdgcn_s_sleep(1); \
    if ((++_sp & 255u) == 0u) { if (xb_ld(&(bar)[XB_TMO])) break; if (_sp > XB_SPIN_CAP) { atomicAdd(&(bar)[XB_TMO], 1u); break; } } } } while (0)

struct XcdBarrier {
    unsigned* bar; unsigned x;
    volatile LAS unsigned* st;
};

__device__ __forceinline__ XcdBarrier xcd_barrier_post(unsigned* bar, volatile LAS unsigned* st) {
    XcdBarrier b; b.bar = bar; b.x = xb_xcc_id(); b.st = st;
    if (threadIdx.x == 0) (void)xb_add(&bar[XB_XCNT(b.x)], 1u);
    return b;
}
__device__ __forceinline__ void xcd_barrier_complete(unsigned* bar, unsigned x, unsigned& nloc, unsigned& nx) {
    const unsigned G = gridDim.x * gridDim.y * gridDim.z;
    unsigned sum, cnt, mine, sp = 0u;
    for (;;) {
        sum = 0u; cnt = 0u; mine = 0u;
#pragma unroll
        for (unsigned j = 0; j < 16; ++j) { const unsigned c = xb_ld(&bar[XB_XCNT(j)]); sum += c; cnt += (c > 0u) ? 1u : 0u; mine = (j == x) ? c : mine; }
        if (sum == G) break;
        __builtin_amdgcn_s_sleep(1);
        if ((++sp & 255u) == 0u) { if (xb_ld(&bar[XB_TMO])) break; if (sp > XB_SPIN_CAP) { atomicAdd(&bar[XB_TMO], 1u); break; } }
    }
    nloc = mine > 0u ? mine : 1u; nx = cnt > 0u ? cnt : 1u;
}

__device__ __forceinline__ void xcd_barrier(const XcdBarrier& b) {
    asm volatile("s_waitcnt vmcnt(0)" ::: "memory");
    __syncthreads();
    if (threadIdx.x == 0) {
        unsigned* bar = b.bar;
        __builtin_amdgcn_s_waitcnt(0);
        unsigned nloc = b.st[0], nx = b.st[1];
        if (nloc == 0u) { xcd_barrier_complete(bar, b.x, nloc, nx); b.st[0] = nloc; b.st[1] = nx; }
        const unsigned old = xb_add(&bar[XB_XSUB(b.x)], 1u);
        const unsigned gen = old / nloc;
        if (old + 1u == (gen + 1u) * nloc) {
            __builtin_amdgcn_fence(__ATOMIC_RELEASE, "agent");
            asm volatile("s_waitcnt vmcnt(0)" ::: "memory");
            const unsigned og = xb_add(&bar[XB_TOP], 1u);
            const unsigned tg = og / nx;
            if (og + 1u == (tg + 1u) * nx) xb_add(&bar[XB_TOPGEN], 1u);
            else XB_SPIN(xb_ld(&bar[XB_TOPGEN]) == tg, bar);
            __builtin_amdgcn_fence(__ATOMIC_ACQUIRE, "agent");
            xb_add(&bar[XB_XGEN(b.x)], 1u);
            asm volatile("s_waitcnt vmcnt(0)" ::: "memory");
        } else {
            XB_SPIN(xb_ld(&bar[XB_XGEN(b.x)]) == gen, bar);
            __builtin_amdgcn_fence(__ATOMIC_ACQUIRE, "agent");
            asm volatile("s_waitcnt vmcnt(0)" ::: "memory");
        }
    }
    __syncthreads();
}

#define WT_RSRC(p) __builtin_amdgcn_make_buffer_rsrc((void*)(p), 0, 0x7FFFFFFF, 0x00020000)
#define WT_ST16(rsrc, byteoff, v) __builtin_amdgcn_raw_buffer_store_b128((v), (rsrc), (int)(byteoff), 0, 16)
typedef unsigned u32x2w __attribute__((ext_vector_type(2)));
#define WT_ST8(rsrc, byteoff, v) __builtin_amdgcn_raw_buffer_store_b64((v), (rsrc), (int)(byteoff), 0, 16)
using pg8::Unit; using pg8::cvt_pk_bf16;
typedef pg8::u32x4 u32x4;
struct EpiP1 {
    static constexpr bool PERM = true, AFTER_DRAIN = false;
    bf16* P; const float* rc; const float* rs;
    __device__ __forceinline__ void operator()(const f32x4 (&acc)[2][2][4][2], const Unit& u, int wr, int wc, int fr, int fq) const {
        const int row0 = u.pm * 256 + wr * 64 + fr, col0 = u.pn * 256 + wc * 32 + 8 * fq;
        const bool rot = (u.pn < 64) && ((ROTMASK >> u.pn) & 1ull) && (wc == 0);
        const float sgn = fq < 2 ? -1.f : 1.f;
#pragma unroll
        for (int ai = 0; ai < 2; ++ai)
#pragma unroll
            for (int m = 0; m < 4; ++m) {
                const int row = row0 + ai * 128 + m * 16;
                f32x4 c0 = {1.f, 1.f, 1.f, 1.f}, c1 = c0, s0 = {0.f, 0.f, 0.f, 0.f}, s1 = s0;
                if (rot) { const float* pc = rc + (size_t)row * 16 + 8 * (fq & 1); const float* ps = rs + (size_t)row * 16 + 8 * (fq & 1);
                    c0 = *(const f32x4*)pc; c1 = *(const f32x4*)(pc + 4); s0 = *(const f32x4*)ps; s1 = *(const f32x4*)(ps + 4); }
#pragma unroll
                for (int bj = 0; bj < 2; ++bj) {
                    f32x4 v0 = acc[ai][bj][m][0], v1 = acc[ai][bj][m][1];
                    if (rot) {
#pragma unroll
                        for (int j = 0; j < 4; ++j) { const float p0 = __shfl_xor(v0[j], 32), p1 = __shfl_xor(v1[j], 32);
                            v0[j] = v0[j] * c0[j] + sgn * p0 * s0[j]; v1[j] = v1[j] * c1[j] + sgn * p1 * s1[j]; }
                    }
                    u32x4 w; w.x = cvt_pk_bf16(v0[0], v0[1]); w.y = cvt_pk_bf16(v0[2], v0[3]); w.z = cvt_pk_bf16(v1[0], v1[1]); w.w = cvt_pk_bf16(v1[2], v1[3]);
                    *(u32x4*)(P + (size_t)row * NP + col0 + bj * 128) = w;
                }
            }
    }
};
template <int WHICH> struct EpiProj {
    static constexpr bool PERM = true, AFTER_DRAIN = false;
    const bf16* P; bf16* M1; bf16* MG;
    __device__ __forceinline__ void operator()(const f32x4 (&acc)[2][2][4][2], const Unit& u, int wr, int wc, int fr, int fq) const {
        const int row0 = u.pm * 256 + wr * 64 + fr, col0 = u.pn * 256 + wc * 32 + 8 * fq;
#pragma unroll
        for (int ai = 0; ai < 2; ++ai)
#pragma unroll
            for (int m = 0; m < 4; ++m) {
                const int row = row0 + ai * 128 + m * 16;
#pragma unroll
                for (int bj = 0; bj < 2; ++bj) {
                    const int col = col0 + bj * 128;
                    const u32x4 gw = *(const u32x4*)(P + (size_t)row * NP + C_GM + WHICH * DM + col);
                    const f32x4 v0 = acc[ai][bj][m][0], v1 = acc[ai][bj][m][1];
                    float o[8];
                    o[0] = v0[0] * sigmoidf_(bflo(gw.x)); o[1] = v0[1] * sigmoidf_(bfhi(gw.x)); o[2] = v0[2] * sigmoidf_(bflo(gw.y)); o[3] = v0[3] * sigmoidf_(bfhi(gw.y));
                    o[4] = v1[0] * sigmoidf_(bflo(gw.z)); o[5] = v1[1] * sigmoidf_(bfhi(gw.z)); o[6] = v1[2] * sigmoidf_(bflo(gw.w)); o[7] = v1[3] * sigmoidf_(bfhi(gw.w));
                    if (WHICH == 1) { const u32x4 pw = *(const u32x4*)(M1 + (size_t)row * DM + col);
                        o[0] += bflo(pw.x); o[1] += bfhi(pw.x); o[2] += bflo(pw.y); o[3] += bfhi(pw.y); o[4] += bflo(pw.z); o[5] += bfhi(pw.z); o[6] += bflo(pw.w); o[7] += bfhi(pw.w); }
                    u32x4 w; w.x = cvt_pk_bf16(o[0], o[1]); w.y = cvt_pk_bf16(o[2], o[3]); w.z = cvt_pk_bf16(o[4], o[5]); w.w = cvt_pk_bf16(o[6], o[7]);
                    *(u32x4*)((WHICH == 0 ? M1 : MG) + (size_t)row * DM + col) = w;
                }
            }
    }
};
struct EpiOut {
    static constexpr bool PERM = false, AFTER_DRAIN = false;
    const float* X; float* X1; bf16* HNp; const float* gain;
    __device__ __forceinline__ void operator()(const f32x4 (&acc)[2][2][4][2], const Unit& u, int wr, int wc, int fr, int fq) const {
        const int row0 = u.pm * 256 + wr * 64 + fr, col0 = u.pn * 256 + wc * 32 + 4 * fq;
        f32x4 gv[2][2];
#pragma unroll
        for (int bj = 0; bj < 2; ++bj)
#pragma unroll
            for (int n = 0; n < 2; ++n) gv[bj][n] = *(const f32x4*)(gain + col0 + bj * 128 + n * 16);
#pragma unroll
        for (int ai = 0; ai < 2; ++ai)
#pragma unroll
            for (int m = 0; m < 4; ++m) { const size_t ro = (size_t)(row0 + ai * 128 + m * 16) * DM + col0;
#pragma unroll
                for (int bj = 0; bj < 2; ++bj)
#pragma unroll
                    for (int n = 0; n < 2; ++n) { const f32x4 xv = *(const f32x4*)(X + ro + bj * 128 + n * 16); const f32x4 y = acc[ai][bj][m][n] + xv;
                        *(f32x4*)(X1 + ro + bj * 128 + n * 16) = y;
                        v2u o; o.x = cvt_pk_bf16(y[0] * gv[bj][n][0], y[1] * gv[bj][n][1]); o.y = cvt_pk_bf16(y[2] * gv[bj][n][2], y[3] * gv[bj][n][3]);
                        *(v2u*)(HNp + ro + bj * 128 + n * 16) = o; } }
    }
};
struct EpiMoe1 {
    static constexpr bool PERM = true, AFTER_DRAIN = false;
    bf16* ACT; const float* bg; const float* bu;
    __device__ __forceinline__ void operator()(const f32x4 (&acc)[2][2][4][2], const Unit& u, int wr, int wc, int fr, int fq) const {
        const int e = u.pn >> 4, tn = u.pn & 15;
        const int row0 = u.pm * 256 + wr * 64 + fr, col = tn * 128 + wc * 32 + 8 * fq;
        const f32x4 bg0 = *(const f32x4*)(bg + (size_t)e * DFF + col), bg1 = *(const f32x4*)(bg + (size_t)e * DFF + col + 4);
        const f32x4 bu0 = *(const f32x4*)(bu + (size_t)e * DFF + col), bu1 = *(const f32x4*)(bu + (size_t)e * DFF + col + 4);
#pragma unroll
        for (int ai = 0; ai < 2; ++ai)
#pragma unroll
            for (int m = 0; m < 4; ++m) {
                const int row = row0 + ai * 128 + m * 16;
                float o[8];
#pragma unroll
                for (int j = 0; j < 4; ++j) {
                    float g0 = fminf(acc[ai][0][m][0][j] + bg0[j], 7.f), g1 = fminf(acc[ai][0][m][1][j] + bg1[j], 7.f);
                    float u0 = fminf(fmaxf(acc[ai][1][m][0][j] + bu0[j], -7.f), 7.f), u1 = fminf(fmaxf(acc[ai][1][m][1][j] + bu1[j], -7.f), 7.f);
                    o[j] = (u0 + 1.f) * g0 * sigmoidf_(1.702f * g0); o[4 + j] = (u1 + 1.f) * g1 * sigmoidf_(1.702f * g1);
                }
                u32x4 w; w.x = cvt_pk_bf16(o[0], o[1]); w.y = cvt_pk_bf16(o[2], o[3]); w.z = cvt_pk_bf16(o[4], o[5]); w.w = cvt_pk_bf16(o[6], o[7]);
                *(u32x4*)(ACT + (size_t)row * DFF + col) = w;
            }
    }
};
struct EpiMoe2 {
    static constexpr bool PERM = true, AFTER_DRAIN = false;
    bf16* Y; const float* bd;
    __device__ __forceinline__ void operator()(const f32x4 (&acc)[2][2][4][2], const Unit& u, int wr, int wc, int fr, int fq) const {
        const int e = u.pn >> 3, tn = u.pn & 7;
        const int row0 = u.pm * 256 + wr * 64 + fr, col0 = tn * 256 + wc * 32 + 8 * fq;
#pragma unroll
        for (int bj = 0; bj < 2; ++bj) {
            const int col = col0 + bj * 128;
            const f32x4 b0 = *(const f32x4*)(bd + (size_t)e * DM + col), b1 = *(const f32x4*)(bd + (size_t)e * DM + col + 4);
#pragma unroll
            for (int ai = 0; ai < 2; ++ai)
#pragma unroll
                for (int m = 0; m < 4; ++m) {
                    const int row = row0 + ai * 128 + m * 16;
                    const f32x4 v0 = acc[ai][bj][m][0] + b0, v1 = acc[ai][bj][m][1] + b1;
                    u32x4 w; w.x = cvt_pk_bf16(v0[0], v0[1]); w.y = cvt_pk_bf16(v0[2], v0[3]); w.z = cvt_pk_bf16(v1[0], v1[1]); w.w = cvt_pk_bf16(v1[2], v1[3]);
                    *(u32x4*)(Y + (size_t)row * DM + col) = w;
                }
        }
    }
};
template <bool GATHERED> struct MoeOrder {
    static constexpr bool GATHER = GATHERED;
#ifndef MOE_B_AUX
#define MOE_B_AUX 0
#endif
    static constexpr int B_AUX = MOE_B_AUX;
    const LAS int* tab; int ntn, G, c, total; const int* list;
    __device__ __forceinline__ bool next(int i, Unit& u) const {
        const long L = (long)i * G + c; if (L >= total) return false;
        int id = (int)L; { const int q = total / 8, r = total % 8, xcd = id % 8, off = id / 8; id = (xcd < r ? xcd * (q + 1) : r * (q + 1) + (xcd - r) * q) + off; }
        int e = 0;
#pragma unroll 1
        for (int k = 1; k < NEXP; ++k) e = (id >= tab[k]) ? k : e;
        const int local = id - tab[e], mte = tab[64 + e];
        u.pm = tab[128 + e] + local % mte; u.pn = e * ntn + local / mte; return true;
    }
    __device__ __forceinline__ bool upper_half_empty(const Unit& u) const { const int e = u.pn / ntn; return tab[96 + e] - (u.pm - tab[128 + e]) * 256 <= 128; }
    __device__ __forceinline__ unsigned row_of(const Unit& u, int r) const {
        const int e = u.pn / ntn, rr = (u.pm - tab[128 + e]) * 256 + r;
        return rr < tab[96 + e] ? (unsigned)list[(size_t)e * T + rr] : 0u;
    }
    __device__ __forceinline__ void a_ready(const Unit&) const {}
    __device__ __forceinline__ void done(const Unit&) const {}
};
struct Args { const void* in[27]; float* out; unsigned char* ws; int ph_lo, ph_hi, li, pad; };
struct Ctx {
    LAS unsigned char* lds; int tid, lane, wave, G, bid; const Args* A; float* out; unsigned char* ws; unsigned* ctl;
};
#define WSP(type, off) ((type*)(C.ws + (off)))
__device__ __forceinline__ unsigned cvtpk_c(float lo, float hi) { typedef float f2 __attribute__((ext_vector_type(2))); typedef __bf16 b2 __attribute__((ext_vector_type(2))); f2 v = {lo, hi}; b2 b = __builtin_convertvector(v, b2); return __builtin_bit_cast(unsigned, b); }

struct TrRegs { f32x4 v[16]; };
__device__ __forceinline__ void tr_load(TrRegs& R, const float* W, int ldw, int k0, int src, int lane) {
    const int kr = lane >> 4;
#pragma unroll
    for (int i = 0; i < 16; ++i) R.v[i] = src >= 0 ? __builtin_nontemporal_load((const f32x4*)(W + (size_t)(k0 + 4 * i + kr) * ldw + src)) : (f32x4){0.f, 0.f, 0.f, 0.f};
}
__device__ __forceinline__ void tr_store(const TrRegs& R, bf16* WT, int K, int k0, int n0, LAS float* scr, int lane) {
    const int c4 = 4 * (lane & 15), kr = lane >> 4;
#pragma unroll
    for (int i = 0; i < 16; ++i) { LAS float* d = scr + (4 * i + kr) * 65 + c4; d[0] = R.v[i].x; d[1] = R.v[i].y; d[2] = R.v[i].z; d[3] = R.v[i].w; }
    LDS_WAIT(); asm volatile("" ::: "memory");
    const int c = lane & 7;
#pragma unroll
    for (int j = 0; j < 8; ++j) { const int n = (lane >> 3) + 8 * j; const LAS float* s = scr + (8 * c) * 65 + n;
        v4u o; o.x = cvtpk_c(s[0 * 65], s[1 * 65]); o.y = cvtpk_c(s[2 * 65], s[3 * 65]); o.z = cvtpk_c(s[4 * 65], s[5 * 65]); o.w = cvtpk_c(s[6 * 65], s[7 * 65]);
        __builtin_nontemporal_store(o, (v4u*)(WT + (size_t)(n0 + n) * K + k0 + 8 * c)); }
    LDS_WAIT(); asm volatile("" ::: "memory");
}
struct MapId { __device__ __forceinline__ int operator()(int n) const { return n; } };
struct MapIn { __device__ __forceinline__ int operator()(int r) const {
    return r < 8192 ? r : r < 13312 ? r + 32 : r < 17408 ? r + 80 : r < 17440 ? 8192 + (r - 17408) : r < 17488 ? 13344 + (r - 17440) : -1; } };
template <class Map>
__device__ __forceinline__ void tr_matrix(const Ctx& C, const float* W, int ldw, int K, int Nd, bf16* WT, Map map) {
    LAS float* scr = (LAS float*)(C.lds + C.wave * 16640);
    const int gw = C.bid * NWAVES + C.wave, NGW = C.G * NWAVES, nblk = Nd / 64, nit = nblk * (K / 64), lane = C.lane;
    TrRegs R; int it = gw;
    if (it < nit) tr_load(R, W, ldw, 64 * (it / nblk), map(64 * (it % nblk) + 4 * (lane & 15)), lane);
    while (it < nit) { const int nx = it + NGW; TrRegs N;
        if (nx < nit) tr_load(N, W, ldw, 64 * (nx / nblk), map(64 * (nx % nblk) + 4 * (lane & 15)), lane);
        tr_store(R, WT, K, 64 * (it / nblk), 64 * (it % nblk), scr, lane);
        R = N; it = nx; }
}
__device__ __forceinline__ void rms_row_bf16(const float* xrow, const float* gain, bf16* orow, int lane) {
    f32x4 v[8]; float s = 0.f;
#pragma unroll
    for (int j = 0; j < 8; ++j) { v[j] = *(const f32x4*)(xrow + 4 * lane + 256 * j); s += (v[j].x * v[j].x + v[j].y * v[j].y) + (v[j].z * v[j].z + v[j].w * v[j].w); }
    const float r = __builtin_amdgcn_rsqf(wave_sum(s) * (1.f / DM) + EPS);
#pragma unroll
    for (int j = 0; j < 8; ++j) { const f32x4 g = *(const f32x4*)(gain + 4 * lane + 256 * j);
        v2u o; o.x = pk2(v[j].x * r * g.x, v[j].y * r * g.y); o.y = pk2(v[j].z * r * g.z, v[j].w * r * g.w);
        *(v2u*)(orow + 4 * lane + 256 * j) = o; }
}
__device__ __forceinline__ void p0_prologue(const Ctx& C) {
    { LAS float* scr = (LAS float*)(C.lds + C.wave * 16640);
      const int gw0 = C.bid * NWAVES + C.wave, NGW0 = C.G * NWAVES, lane = C.lane;
      constexpr int N_IN = (NP / 64) * (DM / 64), N_PJ = (DM / 64) * (DM / 64), N_W1 = 0  , N_W2 = 2 * 2, NALL = N_IN + 3 * N_PJ + 2 * N_W1 + 2 * N_W2;
#define P0_DECODE(it_) int i_ = (it_); const float* W_; bf16* WT_; int ldw_, K_, nblk_; bool isin_ = false; \
      if (i_ < N_IN) { W_ = (const float*)C.A->in[3]; WT_ = WSP(bf16, WS_WINT); ldw_ = DIN; K_ = DM; nblk_ = NP / 64; isin_ = true; } \
      else if ((i_ -= N_IN) < 3 * N_PJ) { const int w_ = i_ / N_PJ; i_ -= w_ * N_PJ; W_ = (const float*)C.A->in[14 + w_]; WT_ = WSP(bf16, WS_WPA) + (size_t)w_ * DM * DM; ldw_ = DM; K_ = DM; nblk_ = DM / 64; } \
      else { i_ -= 3 * N_PJ; const int w_ = i_ / N_W2; i_ -= w_ * N_W2; W_ = (const float*)C.A->in[w_ ? 13 : 10]; WT_ = (bf16*)(C.ws + 111 * MiB + w_ * 65536); ldw_ = 128; K_ = 128; nblk_ = 2; } \
      const int k0_ = 64 * (i_ / nblk_), n0_ = 64 * (i_ % nblk_);
      TrRegs R; int it = gw0;
      if (it < NALL) { P0_DECODE(it); const int d_ = n0_ + 4 * (lane & 15); tr_load(R, W_, ldw_, k0_, isin_ ? MapIn()(d_) : d_, lane); }
      while (it < NALL) { const int nx = it + NGW0; TrRegs N;
          if (nx < NALL) { P0_DECODE(nx); const int d_ = n0_ + 4 * (lane & 15); tr_load(N, W_, ldw_, k0_, isin_ ? MapIn()(d_) : d_, lane); }
          { P0_DECODE(it); (void)W_; (void)ldw_; (void)isin_; tr_store(R, WT_, K_, k0_, n0_, scr, lane); }
          R = N; it = nx; }
#undef P0_DECODE
    }
    const int gw = C.bid * NWAVES + C.wave, NGW = C.G * NWAVES;
    for (int m = gw; m < T; m += NGW) rms_row_bf16(((const float*)C.A->in[0]) + (size_t)m * DM, ((const float*)C.A->in[2]), WSP(bf16, WS_H) + (size_t)m * DM, C.lane);
    for (int i = C.bid * NTHR + C.tid; i < 2 * 256 * 4 * 64; i += C.G * NTHR) { const int kv = i >> 16, r_ = i & 65535, ks = r_ >> 8, nt = (r_ >> 6) & 3, ln = r_ & 63;
        const float* w1 = (const float*)C.A->in[kv ? 12 : 9] + (size_t)(16 * ks + 8 * (ln >> 5)) * 128 + 32 * nt + (ln & 31);
        v4u o; o.x = cvtpk_c(w1[0], w1[128]); o.y = cvtpk_c(w1[256], w1[384]); o.z = cvtpk_c(w1[512], w1[640]); o.w = cvtpk_c(w1[768], w1[896]);
        *(v4u*)(C.ws + (109 + kv) * MiB + (size_t)r_ * 16) = o; }
    { bf16* WRH = WSP(bf16, 12 * MiB + 65536); bf16* WRL = WRH + 65536;
      for (int i = C.bid * NTHR + C.tid; i < NEXP * DM; i += C.G * NTHR) { const int e = i >> 11, k = i & 2047;
          const float w = ((const float*)C.A->in[17])[k] * ((const float*)C.A->in[18])[k * NEXP + e]; const unsigned hb = f2bf(w);
          WRH[i] = (bf16)hb; WRL[i] = (bf16)f2bf(w - bf2f((unsigned short)hb)); } }
    float* rc = WSP(float, WS_RC); float* rs = WSP(float, WS_RS);
    for (int i = C.bid * NTHR + C.tid; i < T * 16; i += C.G * NTHR) {
        const int m = i >> 4, f = i & 15; const float invf = exp2f(-(float)f * (18.931568569324174f / 16.f));
        const float ang = (float)((const int*)C.A->in[1])[m] * invf;
        double rev = (double)ang * 0.15915494309189535; rev -= rint(rev);
        const float rf = (float)rev; rc[i] = __builtin_amdgcn_cosf(rf); rs[i] = __builtin_amdgcn_sinf(rf);
    }
}
__device__ __forceinline__ void small_proj(const Ctx& C) {
    const bf16* H = WSP(bf16, WS_H); const bf16* WT = WSP(bf16, WS_WINT); bf16* P = WSP(bf16, WS_P);
    typedef float f32x16s __attribute__((ext_vector_type(16)));
    for (int job = C.bid * NWAVES + C.wave; job < (T / 32) * 3; job += C.G * NWAVES) {
        int lane = C.lane; asm volatile("" : "+v"(lane));
        const int t = lane & 31, hf = lane >> 5, mt = job / 3, nt = job - 3 * mt;
        const bf16* ap = H + (size_t)(32 * mt + t) * DM + 8 * hf; const bf16* bp = WT + (size_t)(17408 + 32 * nt + t) * DM + 8 * hf;
        f32x16s acc = {};
#pragma unroll 16
        for (int s2 = 0; s2 < 128; ++s2) acc = __builtin_amdgcn_mfma_f32_32x32x16_bf16(*(const bf16x8*)(ap + 16 * s2), *(const bf16x8*)(bp + 16 * s2), acc, 0, 0, 0);
        bf16* op = P + (size_t)(32 * mt) * NP + 17408 + 32 * nt + t;
#pragma unroll
        for (int i = 0; i < 16; ++i) { const float v = acc[i], vn = __shfl_xor(v, 1); const int row = (i & 3) + 8 * (i >> 2) + 4 * hf;
            if ((t & 1) == 0) *(unsigned*)(op + (size_t)row * NP) = cvtpk_c(v, vn); }
    }
}
__device__ __forceinline__ void moe_weight_convert(const Ctx& C, int it0, int it1, int wv, int nwv) {
    LAS float* scr = (LAS float*)(C.lds + C.wave * 16640);
    if (wv < 0) return;
    const int gw = it0 + wv, NGW = nwv, lane = C.lane;
    bf16* WGU = WSP(bf16, WS_WGU); bf16* WD = WSP(bf16, WS_WD);
    const float* wg = (const float*)C.A->in[20]; const float* wu = (const float*)C.A->in[22]; const float* wd = (const float*)C.A->in[24];
    constexpr int NGU = NEXP * 64 * 32, NIT = NGU + NEXP * 32 * 32;
#define MOE_IT_LOAD(RR, it_) do { const int i_ = (it_); \
        if (i_ < NGU) { const int e = i_ >> 11, r = i_ & 2047, nb = r & 63, kb = r >> 6, n0 = nb * 64, which = (n0 >> 7) & 1, srcn = (n0 >> 8) * 128 + (n0 & 127) + 4 * (lane & 15); \
            tr_load(RR, (which ? wu : wg) + (size_t)e * DM * DFF, DFF, 64 * kb, srcn, lane); } \
        else { const int q_ = i_ - NGU, e = q_ >> 10, r = q_ & 1023, nb = r & 31, kb = r >> 5; tr_load(RR, wd + (size_t)e * DFF * DM, DM, 64 * kb, 64 * nb + 4 * (lane & 15), lane); } } while (0)
#define MOE_IT_STORE(RR, it_) do { const int i_ = (it_); \
        if (i_ < NGU) { const int e = i_ >> 11, r = i_ & 2047, nb = r & 63, kb = r >> 6; tr_store(RR, WGU + (size_t)e * 4096 * DM, DM, 64 * kb, nb * 64, scr, lane); } \
        else { const int q_ = i_ - NGU, e = q_ >> 10, r = q_ & 1023, nb = r & 31, kb = r >> 5; tr_store(RR, WD + (size_t)e * DM * DFF, DFF, 64 * kb, 64 * nb, scr, lane); } } while (0)
    const int NE = it1 < NIT ? it1 : NIT;
    TrRegs R; int it = gw;
    if (it < NE) MOE_IT_LOAD(R, it);
    while (it < NE) { const int nx = it + NGW; TrRegs N;
        if (nx < NE) MOE_IT_LOAD(N, nx);
        MOE_IT_STORE(R, it);
        R = N; it = nx; }
#undef MOE_IT_LOAD
#undef MOE_IT_STORE
}

constexpr size_t WS_RT = 12 * MiB + 524288;
constexpr size_t WS_WRH = 12 * MiB + 65536, WS_WRL = WS_WRH + 131072, WS_LIST = 13 * MiB;
typedef float f32x16r __attribute__((ext_vector_type(16)));
__device__ __forceinline__ void p7_norm_router(const Ctx& C) {
    if (C.wave >= 2) return;
    const float* X1 = WSP(float, WS_X1); bf16* HN = WSP(bf16, WS_HN);
    int* TOPE = WSP(int, WS_TOPE); float* TOPW = WSP(float, WS_TOPW); int* POS = WSP(int, WS_POS);
    const bf16* WRH = WSP(bf16, WS_WRH); const bf16* WRL = WSP(bf16, WS_WRL);
    unsigned* cnt = C.ctl + CW_CNT;
    LAS float* lg = (LAS float*)(C.lds + 133120 + C.wave * 4224);
    for (int tile = C.bid * 2 + C.wave; tile < T / 32; tile += C.G * 2) {
        int lane = C.lane; asm volatile("" : "+v"(lane));
        const int t = lane & 31, hf = lane >> 5, m0 = tile * 32;
        const float* xr = X1 + (size_t)(m0 + t) * DM + 8 * hf; const bf16* wh = WRH + (size_t)t * DM + 8 * hf; const bf16* wl = WRL + (size_t)t * DM + 8 * hf;
        f32x16r acc = {}; float ss = 0.f;
#pragma unroll 8
        for (int s = 0; s < 128; ++s) {
            const f32x4 xa = *(const f32x4*)(xr + 16 * s), xb = *(const f32x4*)(xr + 16 * s + 4);
            const bf16x8 bh = *(const bf16x8*)(wh + 16 * s), bl = *(const bf16x8*)(wl + 16 * s);
            ss += (xa.x * xa.x + xa.y * xa.y) + (xa.z * xa.z + xa.w * xa.w) + (xb.x * xb.x + xb.y * xb.y) + (xb.z * xb.z + xb.w * xb.w);
            v4u h; h.x = cvtpk_c(xa.x, xa.y); h.y = cvtpk_c(xa.z, xa.w); h.z = cvtpk_c(xb.x, xb.y); h.w = cvtpk_c(xb.z, xb.w);
            v4u l; l.x = cvtpk_c(xa.x - bflo(h.x), xa.y - bfhi(h.x)); l.y = cvtpk_c(xa.z - bflo(h.y), xa.w - bfhi(h.y)); l.z = cvtpk_c(xb.x - bflo(h.z), xb.y - bfhi(h.z)); l.w = cvtpk_c(xb.z - bflo(h.w), xb.w - bfhi(h.w));
            const bf16x8 ah = __builtin_bit_cast(bf16x8, h), al = __builtin_bit_cast(bf16x8, l);
            acc = __builtin_amdgcn_mfma_f32_32x32x16_bf16(ah, bh, acc, 0, 0, 0);
            acc = __builtin_amdgcn_mfma_f32_32x32x16_bf16(ah, bl, acc, 0, 0, 0);
            acc = __builtin_amdgcn_mfma_f32_32x32x16_bf16(al, bh, acc, 0, 0, 0);
        }
        ss += __shfl_xor(ss, 32);
        const float r = __builtin_amdgcn_rsqf(ss * (1.f / DM) + EPS);
        const float be = ((const float*)C.A->in[19])[t];
#pragma unroll
        for (int i = 0; i < 16; ++i) { const int tok = (i & 3) + 8 * (i >> 2) + 4 * hf; lg[tok * 33 + t] = acc[i] * __shfl(r, tok) + be; }
        LDS_WAIT();
        if (lane < 32) {
            float v[32];
#pragma unroll
            for (int e = 0; e < 32; ++e) v[e] = lg[lane * 33 + e];
            int te[4]; float tv[4];
#pragma unroll
            for (int k = 0; k < 4; ++k) { float best = -__builtin_inff(); int bi = 0;
#pragma unroll
                for (int e = 0; e < 32; ++e) if (v[e] > best) { best = v[e]; bi = e; }
                te[k] = bi; tv[k] = best;
#pragma unroll
                for (int e = 0; e < 32; ++e) if (e == bi) v[e] = -__builtin_inff(); }
            const float e1 = __expf(tv[1] - tv[0]), e2 = __expf(tv[2] - tv[0]), e3 = __expf(tv[3] - tv[0]), inv = 1.f / (1.f + e1 + e2 + e3);
            const int m = m0 + lane;
            const unsigned p0 = __hip_atomic_fetch_add(cnt + te[0], 1u, __ATOMIC_RELAXED, __HIP_MEMORY_SCOPE_AGENT), p1 = __hip_atomic_fetch_add(cnt + te[1], 1u, __ATOMIC_RELAXED, __HIP_MEMORY_SCOPE_AGENT);
            const unsigned p2 = __hip_atomic_fetch_add(cnt + te[2], 1u, __ATOMIC_RELAXED, __HIP_MEMORY_SCOPE_AGENT), p3 = __hip_atomic_fetch_add(cnt + te[3], 1u, __ATOMIC_RELAXED, __HIP_MEMORY_SCOPE_AGENT);
            *(int4*)(TOPE + m * 4) = make_int4(te[0], te[1], te[2], te[3]); *(float4*)(TOPW + m * 4) = make_float4(inv, e1 * inv, e2 * inv, e3 * inv); *(int4*)(POS + m * 4) = make_int4((int)p0, (int)p1, (int)p2, (int)p3);
        }
        if (lane < 32) WSP(float, WS_RT)[m0 + lane] = r;
        LDS_WAIT();
    }
}
__device__ __forceinline__ void moe_tables(const Ctx& C, int ntn, int& total) {
    LAS int* tab = (LAS int*)(C.lds + TAB_OFF);
    __syncthreads();
    if (C.tid == 0) { int up = 0, tb = 0;
        for (int e = 0; e < NEXP; ++e) { const int cn = (int)__hip_atomic_load(C.ctl + CW_CNT + e, __ATOMIC_RELAXED, __HIP_MEMORY_SCOPE_AGENT); const int mt = (cn + 255) >> 8;
            tab[e] = up; tab[64 + e] = mt; tab[96 + e] = cn; tab[128 + e] = tb; tab[192 + e] = tb * 256; up += mt * ntn; tb += mt; }
        tab[32] = up; }
    __syncthreads();
    total = tab[32];
}
__device__ __forceinline__ void p8_gather(const Ctx& C) {
    int total; moe_tables(C, 1, total);
    const LAS int* tab = (const LAS int*)(C.lds + TAB_OFF);
    const bf16* HN = WSP(bf16, WS_HN); bf16* XG = WSP(bf16, WS_XG);
    const int* TOPE = WSP(int, WS_TOPE); const int* POS = WSP(int, WS_POS);
    const int gw = C.bid * NWAVES + C.wave, NGW = C.G * NWAVES, lane = C.lane;
    for (int a = gw; a < T * TOPK; a += NGW) {
        const int m = a >> 2, e = TOPE[a], dest = tab[192 + e] + POS[a];
        const v4u* src = (const v4u*)(HN + (size_t)m * DM); v4u* dst = (v4u*)(XG + (size_t)dest * DM); const float rr = WSP(float, WS_RT)[m];
#pragma unroll
        for (int q = 0; q < 4; ++q) { const v4u w = src[lane + 64 * q]; v4u o;
            o.x = cvtpk_c(bflo(w.x) * rr, bfhi(w.x) * rr); o.y = cvtpk_c(bflo(w.y) * rr, bfhi(w.y) * rr); o.z = cvtpk_c(bflo(w.z) * rr, bfhi(w.z) * rr); o.w = cvtpk_c(bflo(w.w) * rr, bfhi(w.w) * rr);
            dst[lane + 64 * q] = o; }
    }
}
__device__ __forceinline__ void p11_final(const Ctx& C) {
    int total; moe_tables(C, 1, total); const LAS int* tab = (const LAS int*)(C.lds + TAB_OFF);
    const float* X1 = WSP(float, WS_X1); const bf16* Y = WSP(bf16, WS_Y); const int* TOPE = WSP(int, WS_TOPE); const int* POS = WSP(int, WS_POS); const float* TOPW = WSP(float, WS_TOPW);
    const int gw = C.bid * NWAVES + C.wave, NGW = C.G * NWAVES, lane = C.lane;
    for (int m = gw; m < T; m += NGW) {
        f32x4 v[8];
#pragma unroll
        for (int j = 0; j < 8; ++j) v[j] = *(const f32x4*)(X1 + (size_t)m * DM + 4 * lane + 256 * j);
#pragma unroll
        for (int k = 0; k < 4; ++k) { const float w = TOPW[m * 4 + k]; const bf16* yr = Y + (size_t)(tab[192 + TOPE[m * 4 + k]] + POS[m * 4 + k]) * DM;
#pragma unroll
            for (int j = 0; j < 8; ++j) { const v2u yw = *(const v2u*)(yr + 4 * lane + 256 * j);
                v[j].x += w * bflo(yw.x); v[j].y += w * bfhi(yw.x); v[j].z += w * bflo(yw.y); v[j].w += w * bfhi(yw.y); } }
        float s = 0.f;
#pragma unroll
        for (int j = 0; j < 8; ++j) s += (v[j].x * v[j].x + v[j].y * v[j].y) + (v[j].z * v[j].z + v[j].w * v[j].w);
        const float r = __builtin_amdgcn_rsqf(wave_sum(s) * (1.f / DM) + EPS);
#pragma unroll
        for (int j = 0; j < 8; ++j) { const f32x4 g = *(const f32x4*)(((const float*)C.A->in[26]) + 4 * lane + 256 * j);
            *(f32x4*)(C.out + (size_t)m * DM + 4 * lane + 256 * j) = (f32x4){v[j].x * r * g.x, v[j].y * r * g.y, v[j].z * r * g.z, v[j].w * r * g.w}; }
    }
}
constexpr size_t WS_REC = 792 * MiB, WS_VBC = 1048 * MiB, WS_EGL = 12 * MiB, WS_ORAWB = 1176 * MiB;
typedef float f32x16 __attribute__((ext_vector_type(16)));
typedef float f32x2_t __attribute__((ext_vector_type(2))); typedef __bf16 bf16x2_t __attribute__((ext_vector_type(2)));
__device__ __forceinline__ unsigned cvtpk(float lo, float hi) { f32x2_t v = {lo, hi}; bf16x2_t b = __builtin_convertvector(v, bf16x2_t); return __builtin_bit_cast(unsigned, b); }
__device__ __forceinline__ bf16x8 pack8f(const float* v) { v4u w = {cvtpk(v[0], v[1]), cvtpk(v[2], v[3]), cvtpk(v[4], v[5]), cvtpk(v[6], v[7])}; return __builtin_bit_cast(bf16x8, w); }
__device__ __forceinline__ int crow(int r, int hi) { return (r & 3) + 8 * (r >> 2) + 4 * hi; }
__device__ __forceinline__ void conv8(const bf16* P, const float* cw, int m, int sp, int col0, float (&y)[8]) {
#pragma unroll
    for (int j = 0; j < 8; ++j) y[j] = 0.f;
#pragma unroll
    for (int i = 0; i < 4; ++i) {
        if (sp - 3 + i >= 0) {
            const v4u w = *(const v4u*)(P + (size_t)(m - 3 + i) * NP + col0);
            const f32x4 c0 = *(const f32x4*)(cw + i * 6144 + col0), c1 = *(const f32x4*)(cw + i * 6144 + col0 + 4);
            y[0] += c0.x * bflo(w.x); y[1] += c0.y * bfhi(w.x); y[2] += c0.z * bflo(w.y); y[3] += c0.w * bfhi(w.y);
            y[4] += c1.x * bflo(w.z); y[5] += c1.y * bfhi(w.z); y[6] += c1.z * bflo(w.w); y[7] += c1.w * bfhi(w.w);
        }
    }
#pragma unroll
    for (int j = 0; j < 8; ++j) y[j] = y[j] * sigmoidf_(y[j]);
}
__device__ __forceinline__ void store_perm_frag(unsigned char* rec, int f, int lane16, const float* v) {
    v2u lo = {cvtpk(v[0], v[1]), cvtpk(v[2], v[3])}, hi = {cvtpk(v[4], v[5]), cvtpk(v[6], v[7])};
    const int o = (lane16 & 511) + ((lane16 >> 9) << 3);
    *(v2u*)(rec + (size_t)f * 1024 + o) = lo;
    *(v2u*)(rec + (size_t)f * 1024 + 512 + o) = hi;
}
template <class F>
__device__ __forceinline__ void conv_rows(const bf16* P, const float* cw, int m0, int sp0, int col0  , int lane, F f) {
    const int c16 = lane & 15, seg = lane >> 4, col = col0 + 8 * c16, row0 = 16 * seg;
    const bf16* pp = P + (size_t)(m0 + row0) * NP + col;
    const v4u z = {0u, 0u, 0u, 0u};
    v4u xa = (sp0 + row0 - 3 >= 0) ? *(const v4u*)(pp - 3 * (size_t)NP) : z, xb = (sp0 + row0 - 2 >= 0) ? *(const v4u*)(pp - 2 * (size_t)NP) : z, xc = (sp0 + row0 - 1 >= 0) ? *(const v4u*)(pp - (size_t)NP) : z;
    v4u xd = *(const v4u*)pp, xe = *(const v4u*)(pp + NP), xf = *(const v4u*)(pp + 2 * (size_t)NP);
    f32x4 w0[4], w1[4];
#pragma unroll
    for (int i = 0; i < 4; ++i) { w0[i] = *(const f32x4*)(cw + i * 6144 + col); w1[i] = *(const f32x4*)(cw + i * 6144 + col + 4); }
#pragma unroll 4
    for (int it = 0; it < 16; ++it) {
        const v4u xn = (it + 3 < 16) ? *(const v4u*)(pp + (size_t)(it + 3) * NP) : z;
        float y[8];
        y[0] = w0[0].x * bflo(xa.x) + w0[1].x * bflo(xb.x) + w0[2].x * bflo(xc.x) + w0[3].x * bflo(xd.x);
        y[1] = w0[0].y * bfhi(xa.x) + w0[1].y * bfhi(xb.x) + w0[2].y * bfhi(xc.x) + w0[3].y * bfhi(xd.x);
        y[2] = w0[0].z * bflo(xa.y) + w0[1].z * bflo(xb.y) + w0[2].z * bflo(xc.y) + w0[3].z * bflo(xd.y);
        y[3] = w0[0].w * bfhi(xa.y) + w0[1].w * bfhi(xb.y) + w0[2].w * bfhi(xc.y) + w0[3].w * bfhi(xd.y);
        y[4] = w1[0].x * bflo(xa.z) + w1[1].x * bflo(xb.z) + w1[2].x * bflo(xc.z) + w1[3].x * bflo(xd.z);
        y[5] = w1[0].y * bfhi(xa.z) + w1[1].y * bfhi(xb.z) + w1[2].y * bfhi(xc.z) + w1[3].y * bfhi(xd.z);
        y[6] = w1[0].z * bflo(xa.w) + w1[1].z * bflo(xb.w) + w1[2].z * bflo(xc.w) + w1[3].z * bflo(xd.w);
        y[7] = w1[0].w * bfhi(xa.w) + w1[1].w * bfhi(xb.w) + w1[2].w * bfhi(xc.w) + w1[3].w * bfhi(xd.w);
        float q = 0.f;
#pragma unroll
        for (int j = 0; j < 8; ++j) { y[j] = y[j] * sigmoidf_(y[j]); q += y[j] * y[j]; }
        q += __shfl_xor(q, 1); q += __shfl_xor(q, 2); q += __shfl_xor(q, 4); q += __shfl_xor(q, 8);
        f(row0 + it, c16, y, q);
        xa = xb; xb = xc; xc = xd; xd = xe; xe = xf; xf = xn; }
}
__device__ __forceinline__ int tile_off(int row, int chunk) { return row * 256 + ((chunk ^ (row & 15)) << 4); }
__device__ __forceinline__ void dn_chunk_prep(const Ctx& C, int u0, int ustride) {
    const bf16* P = WSP(bf16, WS_P); const float* cw = ((const float*)C.A->in[4]);
    LAS unsigned char* wl = C.lds + C.wave * 16384;
    LAS float* gcl = (LAS float*)(C.lds + XTRA_OFF + C.wave * 1024);
    LAS float* betal = gcl + 64; LAS float* ssl = gcl + 128;
    for (int u = u0; u < BATCH * HA * 32; u += ustride) {
        const int n = u & 31, h = (u >> 5) & 15, b = u >> 9, m0 = b * SEQ + n * CHUNK;
        int lane = C.lane; asm volatile("" : "+v"(lane));
        const int r = lane & 31, hf = lane >> 5, lane16 = lane * 16;
        unsigned char* rec = C.ws + WS_REC + (size_t)u * 65536;
        float gcv, betav;
        { const float aa = bf2f(P[(size_t)(m0 + lane) * NP + C_AA + h]), ba = bf2f(P[(size_t)(m0 + lane) * NP + C_BA + h]);
          const float xs = aa + ((const float*)C.A->in[6])[h]; const float sp = xs > 20.f ? xs : log1pf(__expf(xs));
          gcv = -__expf(((const float*)C.A->in[5])[h]) * sp; betav = sigmoidf_(ba);
#pragma unroll
          for (int o = 1; o < 64; o <<= 1) { const float t = __shfl_up(gcv, o); if (lane >= o) gcv += t; } }
        const float glast = __shfl(gcv, 63);
        gcl[lane] = gcv; betal[lane] = betav; LDS_WAIT();
        if (lane == 0) WSP(float, WS_EGL)[u] = __expf(glast);
        float gc_a[2], be_a[2];
#pragma unroll
        for (int a = 0; a < 2; ++a) { gc_a[a] = __shfl(gcv, r + 32 * a); be_a[a] = __shfl(betav, r + 32 * a); }
        bf16x8 kf[2][8];
        { conv_rows(P, cw, m0, n * CHUNK, C_KA + h * 128, lane, [&](int row, int c16, const float* y, float q) { *(LAS bf16x8*)(wl + tile_off(row, c16)) = pack8f(y); if (c16 == 0) ssl[row] = q; });
          LDS_WAIT();
          const float ss0 = ssl[r], ss1 = ssl[32 + r];
#pragma unroll 4
          for (int it = 0; it < 16; ++it) { const int a = it >> 3, s = it & 7;
              const float sc = __builtin_amdgcn_rsqf((a ? ss1 : ss0) + EPS), f1 = -(a ? be_a[1] : be_a[0]) * __expf(a ? gc_a[1] : gc_a[0]);
              LAS bf16x8* tp = (LAS bf16x8*)(wl + tile_off(32 * a + r, 2 * s + hf));
              const v4u w = __builtin_bit_cast(v4u, *tp);
              float y[8] = {bflo(w.x) * sc, bfhi(w.x) * sc, bflo(w.y) * sc, bfhi(w.y) * sc, bflo(w.z) * sc, bfhi(w.z) * sc, bflo(w.w) * sc, bfhi(w.w) * sc}, t[8];
#pragma unroll
              for (int j = 0; j < 8; ++j) t[j] = y[j] * f1;
              store_perm_frag(rec, a * 8 + s, lane16, t);
              *tp = pack8f(y); }
          LDS_WAIT(); }
#pragma unroll
        for (int a = 0; a < 2; ++a)
#pragma unroll
            for (int s = 0; s < 8; ++s) kf[a][s] = *(const LAS bf16x8*)(wl + tile_off(32 * a + r, 2 * s + hf));
        LDS_WAIT();
#pragma unroll 4
        for (int it = 0; it < 16; ++it) { const int a = it >> 3, s = it & 7; const float f2 = __expf(glast - (a ? gc_a[1] : gc_a[0]));
            LAS bf16x8* tp = (LAS bf16x8*)(wl + tile_off(32 * a + r, 2 * s + hf));
            const v4u w = __builtin_bit_cast(v4u, *tp);
            float t[8] = {bflo(w.x) * f2, bfhi(w.x) * f2, bflo(w.y) * f2, bfhi(w.y) * f2, bflo(w.z) * f2, bfhi(w.z) * f2, bflo(w.w) * f2, bfhi(w.w) * f2};
            *tp = pack8f(t); }
        LDS_WAIT();
#pragma unroll 2
        for (int f = 0; f < 16; ++f) { const int db = f >> 2, kst = f & 3; unsigned short e[8];
#pragma unroll
            for (int j = 0; j < 8; ++j) { const int tok = 16 * kst + 8 * (j >> 2) + 4 * hf + (j & 3); e[j] = *(const LAS unsigned short*)(wl + tile_off(tok, 4 * db + (r >> 3)) + (r & 7) * 2); }
            v4u w = {(unsigned)e[0] | ((unsigned)e[1] << 16), (unsigned)e[2] | ((unsigned)e[3] << 16), (unsigned)e[4] | ((unsigned)e[5] << 16), (unsigned)e[6] | ((unsigned)e[7] << 16)};
            *(v4u*)(rec + (size_t)(32 + f) * 1024 + lane16) = w; }
        LDS_WAIT();
        { conv_rows(P, cw, m0, n * CHUNK, C_QA + h * 128, lane, [&](int row, int c16, const float* y, float q) { *(LAS bf16x8*)(wl + tile_off(row, c16)) = pack8f(y); if (c16 == 0) ssl[row] = q; });
          LDS_WAIT();
          const float ss0 = ssl[r], ss1 = ssl[32 + r];
#pragma unroll 4
          for (int it = 0; it < 16; ++it) { const int a = it >> 3, s = it & 7;
              const float sc = 0.08838834764831845f / sqrtf((a ? ss1 : ss0) + EPS), eg = __expf(a ? gc_a[1] : gc_a[0]);
              LAS bf16x8* tp = (LAS bf16x8*)(wl + tile_off(32 * a + r, 2 * s + hf));
              const v4u w = __builtin_bit_cast(v4u, *tp);
              float y[8] = {bflo(w.x) * sc, bfhi(w.x) * sc, bflo(w.y) * sc, bfhi(w.y) * sc, bflo(w.z) * sc, bfhi(w.z) * sc, bflo(w.w) * sc, bfhi(w.w) * sc}, t[8];
#pragma unroll
              for (int j = 0; j < 8; ++j) t[j] = y[j] * eg;
              store_perm_frag(rec, 16 + a * 8 + s, lane16, t);
              *tp = pack8f(y); }
          LDS_WAIT(); }
        { const v4u z = {0u, 0u, 0u, 0u};
          *(v4u*)(rec + (size_t)(48 + 2) * 1024 + lane16) = z; *(v4u*)(rec + (size_t)(48 + 3) * 1024 + lane16) = z; }
#pragma unroll
        for (int tix = 0; tix < 3; ++tix) { const int jb = tix == 2 ? 1 : 0, ib = tix == 0 ? 0 : 1;
            f32x16 acc = {};
#pragma unroll
            for (int s = 0; s < 8; ++s) acc = __builtin_amdgcn_mfma_f32_32x32x16_bf16(kf[jb][s], *(const LAS bf16x8*)(wl + tile_off(32 * ib + r, 2 * s + hf)), acc, 0, 0, 0);
            const int i = 32 * ib + r; float t[16];
#pragma unroll
            for (int q = 0; q < 4; ++q) { const f32x4 gj = *(const LAS f32x4*)(gcl + 32 * jb + 8 * q + 4 * hf);
#pragma unroll
                for (int e = 0; e < 4; ++e) { const int j = 32 * jb + 8 * q + 4 * hf + e; t[4 * q + e] = (i >= j) ? acc[4 * q + e] * __expf(gc_a[ib] - gj[e]) : 0.f; } }
            *(bf16x8*)(rec + (size_t)(48 + ib * 4 + 2 * jb) * 1024 + lane16) = pack8f(t);
            *(bf16x8*)(rec + (size_t)(48 + ib * 4 + 2 * jb + 1) * 1024 + lane16) = pack8f(t + 8); }
        LDS_WAIT();
        { conv_rows(P, cw, m0, n * CHUNK, C_VA + h * 128, lane, [&](int row, int c16, const float* y, float q) { (void)q; const float bb = betal[row]; float t[8];
#pragma unroll
              for (int j = 0; j < 8; ++j) t[j] = y[j] * bb;
              *(LAS bf16x8*)(wl + tile_off(row, c16)) = pack8f(t); });
          LDS_WAIT();
          unsigned char* vbc = C.ws + WS_VBC + (size_t)u * 16384 + lane * 32;
#pragma unroll 2
          for (int q = 0; q < 8; ++q) { const int sl = q >> 1, rb = q & 1, ch = 32 * sl + r; unsigned short e[16];
#pragma unroll
              for (int i = 0; i < 16; ++i) e[i] = *(const LAS unsigned short*)(wl + tile_off(32 * rb + crow(i, hf), ch >> 3) + (ch & 7) * 2);
              v4u w0 = {(unsigned)e[0] | ((unsigned)e[1] << 16), (unsigned)e[2] | ((unsigned)e[3] << 16), (unsigned)e[4] | ((unsigned)e[5] << 16), (unsigned)e[6] | ((unsigned)e[7] << 16)};
              v4u w1 = {(unsigned)e[8] | ((unsigned)e[9] << 16), (unsigned)e[10] | ((unsigned)e[11] << 16), (unsigned)e[12] | ((unsigned)e[13] << 16), (unsigned)e[14] | ((unsigned)e[15] << 16)};
              *(v4u*)(vbc + sl * 4096 + rb * 2048) = w0; *(v4u*)(vbc + sl * 4096 + rb * 2048 + 16) = w1; }
          LDS_WAIT(); }
        LAS float* Lt = (LAS float*)wl;
#pragma unroll
        for (int tix = 0; tix < 3; ++tix) { const int jb = tix == 2 ? 1 : 0, ib = tix == 0 ? 0 : 1;
            f32x16 acc = {};
#pragma unroll
            for (int s = 0; s < 8; ++s) acc = __builtin_amdgcn_mfma_f32_32x32x16_bf16(kf[jb][s], kf[ib][s], acc, 0, 0, 0);
            const int i = 32 * ib + r;
#pragma unroll
            for (int q = 0; q < 4; ++q) { const f32x4 gj = *(const LAS f32x4*)(gcl + 32 * jb + 8 * q + 4 * hf);
#pragma unroll
                for (int e = 0; e < 4; ++e) { const int j = 32 * jb + 8 * q + 4 * hf + e;
                    Lt[j * 64 + i] = (i > j) ? be_a[ib] * acc[4 * q + e] * __expf(gc_a[ib] - gj[e]) : 0.f; } } }
        { const f32x4 z4 = {0.f, 0.f, 0.f, 0.f};
#pragma unroll
          for (int q = 0; q < 4; ++q) { const int idx = q * 64 + lane; *(LAS f32x4*)(Lt + (32 + (idx >> 3)) * 64 + (idx & 7) * 4) = z4; } }
        LDS_WAIT();
        { LAS float* Lb = Lt + hf * (32 * 64 + 32);
#pragma unroll 1
          for (int j = 31; j >= 0; --j) {
              float a0 = (r == j) ? 1.f : 0.f, a1 = 0.f, a2 = 0.f, a3 = 0.f;
#pragma unroll 4
              for (int q = (j + 1) >> 2; q < 8; ++q) { const f32x4 l4 = *(const LAS f32x4*)(Lb + j * 64 + 4 * q);
                  a0 -= Lb[(4 * q) * 64 + r] * l4.x; a1 -= Lb[(4 * q + 1) * 64 + r] * l4.y; a2 -= Lb[(4 * q + 2) * 64 + r] * l4.z; a3 -= Lb[(4 * q + 3) * 64 + r] * l4.w; }
              Lb[j * 64 + r] = (a0 + a1) + (a2 + a3);
          } }
        LDS_WAIT();
        { f32x16 W = {};
#pragma unroll
          for (int s2 = 0; s2 < 2; ++s2) { float ta[8], tb[8];
#pragma unroll
              for (int e = 0; e < 8; ++e) ta[e] = Lt[(16 * s2 + 8 * hf + e) * 64 + 32 + r];
              const f32x4 b0 = *(const LAS f32x4*)(Lt + r * 64 + 16 * s2 + 8 * hf), b1 = *(const LAS f32x4*)(Lt + r * 64 + 16 * s2 + 8 * hf + 4);
              tb[0] = b0.x; tb[1] = b0.y; tb[2] = b0.z; tb[3] = b0.w; tb[4] = b1.x; tb[5] = b1.y; tb[6] = b1.z; tb[7] = b1.w;
              W = __builtin_amdgcn_mfma_f32_32x32x16_bf16(pack8f(ta), pack8f(tb), W, 0, 0, 0); }
          f32x16 Z = {};
#pragma unroll
          for (int s2 = 0; s2 < 2; ++s2) { float ta[8], tw[8];
#pragma unroll
              for (int e = 0; e < 8; ++e) { const int k = 16 * s2 + 8 * (e >> 2) + 4 * hf + (e & 3); ta[e] = Lt[(32 + k) * 64 + 32 + r]; tw[e] = W[8 * s2 + e]; }
              Z = __builtin_amdgcn_mfma_f32_32x32x16_bf16(pack8f(ta), pack8f(tw), Z, 0, 0, 0); }
          LDS_WAIT();
#pragma unroll
          for (int i = 0; i < 16; ++i) Lt[r * 64 + 32 + crow(i, hf)] = -Z[i]; }
        LDS_WAIT();
#pragma unroll 1
        for (int s = 0; s < 4; ++s)
#pragma unroll
            for (int h2 = 0; h2 < 2; ++h2) { float t[8];
#pragma unroll
                for (int e = 0; e < 4; ++e) { t[e] = Lt[(16 * s + 4 * h2 + e) * 64 + lane]; t[4 + e] = Lt[(16 * s + 8 + 4 * h2 + e) * 64 + lane]; }
                *(bf16x8*)(rec + (size_t)(56 + (lane >> 5) * 4 + s) * 1024 + (lane16 & 511) + 512 * h2) = pack8f(t); }
        LDS_WAIT();
    }
}
__device__ __forceinline__ void dn_scan(const Ctx& C, int unit) {
    const int wave = C.wave, tid = C.tid, b = unit >> 4, h = unit & 15;
    int lane = C.lane; asm volatile("" : "+v"(lane));
    const unsigned char* recs = C.ws + WS_REC + (size_t)unit * 32 * 65536;
    bf16* OR = WSP(bf16, WS_ORAWB);
    f32x16 S[4];
#pragma unroll
    for (int d = 0; d < 4; ++d) S[d] = f32x16{};
    __syncthreads();
    if (wave >= 4) {
        unsigned t16 = (unsigned)(tid - 256) * 16u; asm volatile("" : "+v"(t16));
        v4u pre[16];
        { v4u tmp[16];
#pragma unroll
          for (int p = 0; p < 16; ++p) tmp[p] = *(const v4u*)(recs + p * 4096 + t16);
#pragma unroll
          for (int p = 0; p < 16; ++p) pre[p] = *(const v4u*)(recs + 65536 + p * 4096 + t16);
#pragma unroll
          for (int p = 0; p < 16; ++p) *(LAS v4u*)(C.lds + p * 4096 + t16) = tmp[p]; }
        for (int n = 0; n < 32; ++n) {
            asm volatile("s_waitcnt lgkmcnt(0)\n\ts_barrier" ::: "memory");
            if (n + 1 < 32) { LAS unsigned char* dst = C.lds + ((n + 1) & 1) * 65536;
#pragma unroll
                for (int p = 0; p < 16; ++p) *(LAS v4u*)(dst + p * 4096 + t16) = pre[p];
                if (n + 2 < 32) { const unsigned char* src = recs + (size_t)(n + 2) * 65536;
#pragma unroll
                    for (int p = 0; p < 16; ++p) pre[p] = *(const v4u*)(src + p * 4096 + t16); } }
        }
        __syncthreads();
        return;
    }
    v4u vb[4];
    { const unsigned char* vp = C.ws + WS_VBC + (size_t)(unit * 32) * 16384 + wave * 4096 + lane * 32;
      vb[0] = *(const v4u*)vp; vb[1] = *(const v4u*)(vp + 16); vb[2] = *(const v4u*)(vp + 2048); vb[3] = *(const v4u*)(vp + 2048 + 16); }
    for (int n = 0; n < 32; ++n) {
        asm volatile("s_waitcnt lgkmcnt(0)\n\ts_barrier" ::: "memory");
        {
            asm volatile("" : "+v"(lane));
            const int r = lane & 31, hf = lane >> 5;
            const LAS unsigned char* rb_ = C.lds + (n & 1) * 65536 + lane * 16;
#define FRAG(f) (*(const LAS bf16x8*)(rb_ + (f) * 1024))
            const float egl = WSP(float, WS_EGL)[unit * 32 + n];
            f32x16 X[2];
#pragma unroll
            for (int a = 0; a < 2; ++a) { const v4u w0 = vb[2 * a], w1 = vb[2 * a + 1];
                X[a][0] = bflo(w0.x); X[a][1] = bfhi(w0.x); X[a][2] = bflo(w0.y); X[a][3] = bfhi(w0.y); X[a][4] = bflo(w0.z); X[a][5] = bfhi(w0.z); X[a][6] = bflo(w0.w); X[a][7] = bfhi(w0.w);
                X[a][8] = bflo(w1.x); X[a][9] = bfhi(w1.x); X[a][10] = bflo(w1.y); X[a][11] = bfhi(w1.y); X[a][12] = bflo(w1.z); X[a][13] = bfhi(w1.z); X[a][14] = bflo(w1.w); X[a][15] = bfhi(w1.w); }
            if (n + 1 < 32) { const unsigned char* vp = C.ws + WS_VBC + (size_t)(unit * 32 + n + 1) * 16384 + wave * 4096 + lane * 32;
                vb[0] = *(const v4u*)vp; vb[1] = *(const v4u*)(vp + 16); vb[2] = *(const v4u*)(vp + 2048); vb[3] = *(const v4u*)(vp + 2048 + 16); }
            bf16x8 Sb[8];
#pragma unroll
            for (int d = 0; d < 4; ++d) { float t[16];
#pragma unroll
                for (int i = 0; i < 16; ++i) t[i] = S[d][i];
                Sb[2 * d] = pack8f(t); Sb[2 * d + 1] = pack8f(t + 8); }
            { bf16x8 f0 = FRAG(0), f1 = FRAG(8);
#pragma unroll
              for (int ks = 0; ks < 8; ++ks) { const bf16x8 g0 = f0, g1 = f1;
                  if (ks < 7) { f0 = FRAG(ks + 1); f1 = FRAG(8 + ks + 1); }
                  X[0] = __builtin_amdgcn_mfma_f32_32x32x16_bf16(g0, Sb[ks], X[0], 0, 0, 0); X[1] = __builtin_amdgcn_mfma_f32_32x32x16_bf16(g1, Sb[ks], X[1], 0, 0, 0); } }
            bf16x8 Xb[4];
#pragma unroll
            for (int a = 0; a < 2; ++a) { float t[16];
#pragma unroll
                for (int i = 0; i < 16; ++i) t[i] = X[a][i];
                Xb[2 * a] = pack8f(t); Xb[2 * a + 1] = pack8f(t + 8); }
            f32x16 V[2] = {f32x16{}, f32x16{}};
#pragma unroll
            for (int kst = 0; kst < 2; ++kst) { V[0] = __builtin_amdgcn_mfma_f32_32x32x16_bf16(FRAG(56 + kst), Xb[kst], V[0], 0, 0, 0); V[1] = __builtin_amdgcn_mfma_f32_32x32x16_bf16(FRAG(60 + kst), Xb[kst], V[1], 0, 0, 0); }
#pragma unroll
            for (int kst = 2; kst < 4; ++kst) V[1] = __builtin_amdgcn_mfma_f32_32x32x16_bf16(FRAG(60 + kst), Xb[kst], V[1], 0, 0, 0);
            bf16x8 Vb[4];
#pragma unroll
            for (int a = 0; a < 2; ++a) { float t[16];
#pragma unroll
                for (int i = 0; i < 16; ++i) t[i] = V[a][i];
                Vb[2 * a] = pack8f(t); Vb[2 * a + 1] = pack8f(t + 8); }
            f32x16 O[2] = {f32x16{}, f32x16{}};
            { bf16x8 f0 = FRAG(16), f1 = FRAG(24);
#pragma unroll
              for (int ks = 0; ks < 8; ++ks) { const bf16x8 g0 = f0, g1 = f1;
                  if (ks < 7) { f0 = FRAG(16 + ks + 1); f1 = FRAG(24 + ks + 1); }
                  O[0] = __builtin_amdgcn_mfma_f32_32x32x16_bf16(g0, Sb[ks], O[0], 0, 0, 0); O[1] = __builtin_amdgcn_mfma_f32_32x32x16_bf16(g1, Sb[ks], O[1], 0, 0, 0); } }
#pragma unroll
            for (int kst = 0; kst < 2; ++kst) { O[0] = __builtin_amdgcn_mfma_f32_32x32x16_bf16(FRAG(48 + kst), Vb[kst], O[0], 0, 0, 0); O[1] = __builtin_amdgcn_mfma_f32_32x32x16_bf16(FRAG(52 + kst), Vb[kst], O[1], 0, 0, 0); }
#pragma unroll
            for (int kst = 2; kst < 4; ++kst) O[1] = __builtin_amdgcn_mfma_f32_32x32x16_bf16(FRAG(52 + kst), Vb[kst], O[1], 0, 0, 0);
#pragma unroll
            for (int d = 0; d < 4; ++d) {
#pragma unroll
                for (int i = 0; i < 16; ++i) S[d][i] *= egl; }
#pragma unroll
            for (int kst = 0; kst < 4; ++kst) { const bf16x8 k0 = FRAG(32 + kst), k1 = FRAG(36 + kst), k2 = FRAG(40 + kst), k3 = FRAG(44 + kst);
                S[0] = __builtin_amdgcn_mfma_f32_32x32x16_bf16(k0, Vb[kst], S[0], 0, 0, 0); S[1] = __builtin_amdgcn_mfma_f32_32x32x16_bf16(k1, Vb[kst], S[1], 0, 0, 0);
                S[2] = __builtin_amdgcn_mfma_f32_32x32x16_bf16(k2, Vb[kst], S[2], 0, 0, 0); S[3] = __builtin_amdgcn_mfma_f32_32x32x16_bf16(k3, Vb[kst], S[3], 0, 0, 0); }
            bf16* op = OR + (size_t)(b * SEQ + n * CHUNK) * DM + h * 128 + wave * 32 + r;
            const int odd = r & 1; bf16* opl = op - odd;
#pragma unroll
            for (int a = 0; a < 2; ++a)
#pragma unroll
                for (int i = 0; i < 16; i += 2) { const float va = O[a][i], vb2 = O[a][i + 1], x = __shfl_xor(odd ? va : vb2, 1);
                    *(unsigned*)(opl + (size_t)(32 * a + crow(i, hf) + odd) * DM) = odd ? cvtpk(x, vb2) : cvtpk(va, x); }
#undef FRAG
        }
    }
    __syncthreads();
}
__device__ __forceinline__ void dn_post2(const Ctx& C) {
    const bf16* P = WSP(bf16, WS_P); const bf16* OR = WSP(bf16, WS_ORAWB); bf16* OA = WSP(bf16, WS_OA);
    const int gw = C.bid * NWAVES + C.wave, NGW = C.G * NWAVES, lane = C.lane;
    const float* ng = (const float*)C.A->in[7] + 8 * (lane & 15);
    const f32x4 n0 = *(const f32x4*)ng, n1 = *(const f32x4*)(ng + 4);
    for (int m = gw; m < T; m += NGW) {
        v4u ow[4], zw[4];
#pragma unroll
        for (int j = 0; j < 4; ++j) { ow[j] = *(const v4u*)(OR + (size_t)m * DM + 8 * (lane + 64 * j)); zw[j] = *(const v4u*)(P + (size_t)m * NP + C_ZA + 8 * (lane + 64 * j)); }
#pragma unroll
        for (int j = 0; j < 4; ++j) {
            float o[8] = {bflo(ow[j].x), bfhi(ow[j].x), bflo(ow[j].y), bfhi(ow[j].y), bflo(ow[j].z), bfhi(ow[j].z), bflo(ow[j].w), bfhi(ow[j].w)};
            const float z[8] = {bflo(zw[j].x), bfhi(zw[j].x), bflo(zw[j].y), bfhi(zw[j].y), bflo(zw[j].z), bfhi(zw[j].z), bflo(zw[j].w), bfhi(zw[j].w)};
            float q = 0.f;
#pragma unroll
            for (int e = 0; e < 8; ++e) q += o[e] * o[e];
            q += __shfl_xor(q, 1); q += __shfl_xor(q, 2); q += __shfl_xor(q, 4); q += __shfl_xor(q, 8);
            const float rr = __builtin_amdgcn_rsqf(q * (1.f / 128.f) + EPS);
            const float g[8] = {n0.x, n0.y, n0.z, n0.w, n1.x, n1.y, n1.z, n1.w};
#pragma unroll
            for (int e = 0; e < 8; ++e) o[e] = o[e] * rr * g[e] * z[e] * sigmoidf_(z[e]);
            v4u r; r.x = cvtpk(o[0], o[1]); r.y = cvtpk(o[2], o[3]); r.z = cvtpk(o[4], o[5]); r.w = cvtpk(o[6], o[7]);
            *(v4u*)(OA + (size_t)m * DM + 8 * (lane + 64 * j)) = r; }
    }
}
constexpr size_t WS_W1K = 109 * MiB, WS_W1V = 110 * MiB, WS_W2K = 111 * MiB, WS_W2V = 111 * MiB + 65536;
constexpr size_t WS_KT = 5 * MiB, WS_VTT = 7 * MiB;
__device__ __forceinline__ int ktile_off(int row, int chunk) { return row * 256 + ((chunk ^ (row & 15)) << 4); }
__device__ __forceinline__ int vtile_off(int dim, int key) { return dim * 256 + ((((key >> 2) ^ (dim & 31))) << 3) + (key & 3) * 2; }
__device__ __forceinline__ void nsa_compress2(const Ctx& C) {
    const bf16* P = WSP(bf16, WS_P);
    LAS float* red = (LAS float*)C.lds;
    LAS unsigned char* hid = C.lds + XTRA_OFF;
    for (int unit = C.bid; unit < 256; unit += C.G) {
        int lane = C.lane; asm volatile("" : "+v"(lane));
        const int r = lane & 31, hf = lane >> 5, w = C.wave;
        const int kv = unit >> 7, b = (unit >> 4) & 7, g = (unit >> 2) & 3, rbk = unit & 3;
        const bf16* W1T = WSP(bf16, kv ? WS_W1V : WS_W1K); const bf16* W2T = WSP(bf16, kv ? WS_W2V : WS_W2K);
        const float* pe = (const float*)C.A->in[kv ? 11 : 8];
        const int c = 32 * rbk + r; const bool valid = c < NCMP;
        const bf16* xrow = P + (size_t)(b * SEQ + (valid ? 16 * c : 0)) * NP + (kv ? C_VC : C_KC) + g * 128 + 8 * hf;
        f32x16 acc[4] = {f32x16{}, f32x16{}, f32x16{}, f32x16{}};
        __syncthreads();
#pragma unroll 1
        for (int l = 4 * w; l < 4 * w + 4; ++l) {
#pragma unroll 4
            for (int s = 0; s < 8; ++s) {
                const v4u xw = *(const v4u*)(xrow + (size_t)l * NP + 16 * s);
                const f32x4 p0 = *(const f32x4*)(pe + l * 128 + 16 * s + 8 * hf), p1 = *(const f32x4*)(pe + l * 128 + 16 * s + 8 * hf + 4);
                float t[8] = {bflo(xw.x) + p0.x, bfhi(xw.x) + p0.y, bflo(xw.y) + p0.z, bfhi(xw.y) + p0.w, bflo(xw.z) + p1.x, bfhi(xw.z) + p1.y, bflo(xw.w) + p1.z, bfhi(xw.w) + p1.w};
                const bf16x8 af = pack8f(t);
                const bf16* wp = W1T + ((size_t)(l * 8 + s) * 4 * 64 + lane) * 8;
#pragma unroll
                for (int nt = 0; nt < 4; ++nt) acc[nt] = __builtin_amdgcn_mfma_f32_32x32x16_bf16(af, *(const bf16x8*)(wp + nt * 512), acc[nt], 0, 0, 0);
            }
        }
#pragma unroll
        for (int nt = 0; nt < 4; ++nt)
#pragma unroll
            for (int i = 0; i < 16; ++i) red[(w * 32 + crow(i, hf)) * 128 + 32 * nt + r] = acc[nt][i];
        __syncthreads();
#pragma unroll
        for (int q = 0; q < 8; ++q) { const int e = C.tid + 512 * q; float sum = 0.f;
#pragma unroll
            for (int ww = 0; ww < 8; ++ww) sum += red[ww * 4096 + e];
            const float u2 = 1.5957691216057308f * (sum + 0.044715f * sum * sum * sum);
            const int row = e >> 7, col = e & 127;
            *(LAS unsigned short*)(hid + ktile_off(row, col >> 3) + (col & 7) * 2) = (unsigned short)f2bf(sum * sigmoidf_(u2)); }
        __syncthreads();
        if (w < 4) {
            f32x16 o = f32x16{};
#pragma unroll
            for (int s = 0; s < 8; ++s) o = __builtin_amdgcn_mfma_f32_32x32x16_bf16(*(const LAS bf16x8*)(hid + ktile_off(r, 2 * s + hf)), *(const bf16x8*)(W2T + (size_t)(32 * w + r) * 128 + 16 * s + 8 * hf), o, 0, 0, 0);
            const int bg = b * 4 + g, n = 32 * w + r;
#pragma unroll
            for (int i = 0; i < 16; ++i) { const int ci = 32 * rbk + crow(i, hf); const unsigned short v = ci < NCMP ? (unsigned short)f2bf(o[i]) : (unsigned short)0;
                if (kv == 0) WSP(unsigned short, WS_KT)[((size_t)bg * 128 + ci) * 128 + n] = v; else WSP(unsigned short, WS_VTT)[((size_t)bg * 128 + n) * 128 + ci] = v; }
        }
    }
    __syncthreads();
}
__device__ __forceinline__ void nsa_cmp_attn2(const Ctx& C, int wi, int nwg) {
    const bf16* P = WSP(bf16, WS_P); bf16* OC = WSP(bf16, WS_OCB); unsigned* SEL = WSP(unsigned, WS_SEL);
    LAS unsigned char* Kl = C.lds; LAS unsigned char* Vl = C.lds + 32768;
    const int per = 2048 / nwg;
    int cur_bg = -1;
    for (int j0 = 0; j0 < per; j0 += NWAVES) {
        const int job = wi * per + j0 + C.wave, bg = job >> 6, tb32 = job & 63, b = bg >> 2, g = bg & 3;
        if (((wi * per + j0) >> 6) != cur_bg) { cur_bg = (wi * per + j0) >> 6;
            __syncthreads();
            const v4u* ks = (const v4u*)(C.ws + WS_KT + (size_t)cur_bg * 32768); const v2u* vs = (const v2u*)(C.ws + WS_VTT + (size_t)cur_bg * 32768);
#pragma unroll
            for (int q = 0; q < 4; ++q) { const int idx = C.tid + 512 * q; *(LAS v4u*)(Kl + ktile_off(idx >> 4, idx & 15)) = ks[idx]; }
#pragma unroll
            for (int q = 0; q < 8; ++q) { const int idx = C.tid + 512 * q, dim = idx >> 5, gr = idx & 31; *(LAS v2u*)(Vl + vtile_off(dim, gr * 4)) = vs[idx]; }
            __syncthreads(); }
        int lane = C.lane; asm volatile("" : "+v"(lane));
        int r32 = lane & 31, hi = lane >> 5; const int t = 32 * tb32 + r32, m = b * SEQ + t;
        int nvalid = t >= 31 ? ((t - 31) >> 4) + 1 : 0;
        const int tmax = 32 * tb32 + 31, ntile = __builtin_amdgcn_readfirstlane((((tmax - 31) >> 4) + 1 + 31) >> 5);
        float imp[16];
#pragma unroll
        for (int sl = 0; sl < 16; ++sl) imp[sl] = 0.f;
#pragma unroll 1
        for (int rh = 0; rh < RG; ++rh) {
            asm volatile("" : "+v"(r32), "+v"(hi), "+v"(nvalid));
            f32x16 p[4];
            { bf16x8 qf[8];
#pragma unroll
              for (int s = 0; s < 8; ++s) qf[s] = *(const bf16x8*)(P + (size_t)m * NP + C_QB + (g * 4 + rh) * 128 + 16 * s + 8 * hi);
#pragma unroll
              for (int kt = 0; kt < 4; ++kt) { p[kt] = f32x16{};
                  if (kt < ntile) {
#pragma unroll
                      for (int s = 0; s < 8; ++s) p[kt] = __builtin_amdgcn_mfma_f32_32x32x16_bf16(*(const LAS bf16x8*)(Kl + ktile_off(32 * kt + r32, 2 * s + hi)), qf[s], p[kt], 0, 0, 0); } } }
            float mx = -1e30f;
#pragma unroll
            for (int kt = 0; kt < 4; ++kt)
#pragma unroll
                for (int i = 0; i < 16; ++i) { const bool ok = 32 * kt + crow(i, hi) < nvalid; p[kt][i] = ok ? p[kt][i] * 0.08838834764831845f : -1e30f; mx = fmaxf(mx, p[kt][i]); }
            mx = fmaxf(mx, __shfl_xor(mx, 32));
            float sum = 0.f;
#pragma unroll
            for (int kt = 0; kt < 4; ++kt)
#pragma unroll
                for (int i = 0; i < 16; ++i) { const float e = __expf(p[kt][i] - mx); p[kt][i] = e; sum += e; }
            sum += __shfl_xor(sum, 32);
            const float inv = nvalid > 0 ? __builtin_amdgcn_rcpf(sum) : 0.f;
#pragma unroll
            for (int kt = 0; kt < 4; ++kt)
#pragma unroll
                for (int i = 0; i < 16; ++i) p[kt][i] *= inv;
#pragma unroll
            for (int sl = 0; sl < 16; ++sl) { const int kt = sl >> 2, qg = sl & 3;
                const float G = (p[kt][4 * qg] + p[kt][4 * qg + 1]) + (p[kt][4 * qg + 2] + p[kt][4 * qg + 3]);
                const float same = __shfl_xor(p[kt][4 * qg + 3], 32);
                const float prev = sl > 0 ? __shfl_xor(p[(sl > 0 ? sl - 1 : 0) >> 2][4 * ((sl > 0 ? sl - 1 : 0) & 3) + 3], 32) : 0.f;
                imp[sl] += G + (hi ? same : prev); }
            { f32x16 o[4] = {f32x16{}, f32x16{}, f32x16{}, f32x16{}};
#pragma unroll
              for (int ks = 0; ks < 8; ++ks) { if ((ks >> 1) >= ntile) continue; float tt[8];
#pragma unroll
                  for (int j = 0; j < 8; ++j) tt[j] = p[ks >> 1][8 * (ks & 1) + j];
                  const bf16x8 pa = pack8f(tt);
#pragma unroll
                  for (int dt = 0; dt < 4; ++dt) { const int dim = 32 * dt + r32;
                      const v2u lo = *(const LAS v2u*)(Vl + vtile_off(dim, 16 * ks + 4 * hi)), hv = *(const LAS v2u*)(Vl + vtile_off(dim, 16 * ks + 8 + 4 * hi));
                      const v4u bw = {lo.x, lo.y, hv.x, hv.y};
                      o[dt] = __builtin_amdgcn_mfma_f32_32x32x16_bf16(pa, __builtin_bit_cast(bf16x8, bw), o[dt], 0, 0, 0); } }
              const int odd = r32 & 1; bf16* opl = OC + (size_t)(b * SEQ + 32 * tb32) * DM + (g * 4 + rh) * 128 + r32 - odd;
#pragma unroll
              for (int dt = 0; dt < 4; ++dt)
#pragma unroll
                  for (int i = 0; i < 16; i += 2) { const float a = o[dt][i], b2 = o[dt][i + 1], x = __shfl_xor(odd ? a : b2, 1);
                      *(unsigned*)(opl + (size_t)(crow(i, hi) + odd) * DM + 32 * dt) = odd ? cvtpk(x, b2) : cvtpk(a, x); } }
        }
        { const int cur = t >> 6; const float INF = __builtin_inff();
          float oth[16];
#pragma unroll
          for (int sl = 0; sl < 16; ++sl) { const int j = 2 * sl + hi, jo = 2 * sl + (1 - hi);
              float v = imp[sl]; if (j == 0 || j == cur) v = INF; else if (j > cur) v = -INF; imp[sl] = v;
              (void)jo; }
#pragma unroll
          for (int sl = 0; sl < 16; ++sl) oth[sl] = __shfl_xor(imp[sl], 32);
          unsigned bits = 0u;
#pragma unroll
          for (int sl = 0; sl < 16; ++sl) { const int j = 2 * sl + hi; const float v = imp[sl]; int rank = 0;
#pragma unroll
              for (int q = 0; q < 16; ++q) { const int jm = 2 * q + hi, jo = 2 * q + (1 - hi);
                  rank += (imp[q] > v || (imp[q] == v && jm < j)) ? 1 : 0;
                  rank += (oth[q] > v || (oth[q] == v && jo < j)) ? 1 : 0; }
              if (rank < 8 && j <= cur) bits |= 1u << j; }
          bits |= __shfl_xor(bits, 32);
          if (hi == 0) SEL[(size_t)m * GKV + g] = bits; }
    }
    __syncthreads();
}
namespace fa {
constexpr float SCALE = 0.08838834764831845f; constexpr int D = 128;
constexpr int NW = 8, QBLK = 32, KVBLK = 64, QB = NW * QBLK, PB = 64  ; constexpr int SHM_V = KVBLK * D * 2, SHM_K = KVBLK * D * 2; constexpr int LDS_BYTES = 2 * SHM_V + 2 * SHM_K + NW * 64 * 4; constexpr float THR = 8.f;
constexpr int QSTR = NP, KSTR = NP, OSTR = DM;
enum { ORDER_NATURAL = 0, ORDER_REVERSED = 1, ORDER_PAIRED = 2, ORDER_XCD = 4 };

typedef short bf16x8 __attribute__((ext_vector_type(8)));
typedef short s16x4 __attribute__((ext_vector_type(4)));
typedef float f32x16 __attribute__((ext_vector_type(16)));
typedef float f32x4 __attribute__((ext_vector_type(4)));
typedef unsigned u32x4 __attribute__((ext_vector_type(4)));
template <class A, class Bt> struct same_t { static constexpr bool v = false; };
template <class A> struct same_t<A, A> { static constexpr bool v = true; };
#define TOKOFF(w) (((w) & 1) * QBLK)
#define HEADOFF(w) (((w) >> 1) * D)
#define KSWZ(row, colB) ((row) * 256 + ((colB) ^ (((row) & 7) << 4)))
#define SBAR() __builtin_amdgcn_sched_barrier(0)
__device__ __forceinline__ int v_st(int k, int c) { const int kk = (k & ~0xC) | ((k & 4) << 1) | ((k & 8) >> 1); return ((kk >> 3) * 4 + (c >> 5)) * 512 + ((kk & 7) * 32 + (c & 31)) * 2; }
__device__ __forceinline__ int v_rd_base(int lane) { return ((lane & 3) << 3) | (((lane >> 2) & 3) << 6) | (((lane >> 4) & 1) << 5) | (((lane >> 5) & 1) << 8); }
constexpr int v_rd_off(int d0, int ks, int half) { return d0 * 512 + ks * 4096 + half * 2048; }
__device__ __forceinline__ int crow(int r, int hi) { return (r & 3) + 8 * (r >> 2) + 4 * hi; }
__device__ __forceinline__ unsigned cvtpk(float lo, float hi) {
    unsigned r; asm volatile("v_cvt_pk_bf16_f32 %0, %1, %2" : "=v"(r) : "v"(lo), "v"(hi)); return r;
}
__device__ __forceinline__ bf16x8 pack8(f32x4 a, f32x4 b) {
    u32x4 w = {cvtpk(a[0], a[1]), cvtpk(a[2], a[3]), cvtpk(b[0], b[1]), cvtpk(b[2], b[3])};
    return *reinterpret_cast<bf16x8*>(&w);
}
template <class T> __device__ __forceinline__ bf16x8 load8(const T* p) {
    if constexpr (same_t<T, float>::v) { return pack8(*(const f32x4*)p, *(const f32x4*)(p + 4)); }
    else { return *reinterpret_cast<const bf16x8*>(p); }
}
__device__ __forceinline__ void mask_tile(f32x16& p0, f32x16& p1, int dq, unsigned W) {
    const float NEG = -__builtin_inff();
#pragma unroll
    for (int r = 0; r < 16; ++r) {
        const int c = (r & 3) + 8 * (r >> 2);
        if ((unsigned)(dq - c) >= W) p0[r] = NEG;
        if ((unsigned)(dq - c - 32) >= W) p1[r] = NEG;
    }
}
__device__ __forceinline__ void mask_tile_sel(f32x16& p0, f32x16& p1, int dq, bool sel) {
    const float NEG = -__builtin_inff();
#pragma unroll
    for (int r = 0; r < 16; ++r) {
        const int c = (r & 3) + 8 * (r >> 2);
        if (!sel || dq - c < 0) p0[r] = NEG;
        if (!sel || dq - c - 32 < 0) p1[r] = NEG;
    }
}
__device__ __forceinline__ void partialSM(f32x16& p0, f32x16& p1, float& m_reg, float& mn, float& alpha) {
    float pmax = p0[0]; for (int r = 1; r < 16; ++r) pmax = fmaxf(pmax, p0[r]); for (int r = 0; r < 16; ++r) pmax = fmaxf(pmax, p1[r]);
    { auto rr = __builtin_amdgcn_permlane32_swap(__float_as_uint(pmax), __float_as_uint(pmax), false, false);
      pmax = fmaxf(__uint_as_float(rr[0]), __uint_as_float(rr[1])); }
    constexpr float C2 = 1.4426950408889634f * SCALE;
    if (__builtin_expect(__all((pmax - m_reg) * SCALE <= THR), 1)) { mn = m_reg; alpha = 1.f; }
    else { mn = fmaxf(m_reg, pmax); alpha = __builtin_amdgcn_exp2f((m_reg - mn) * C2); m_reg = mn; }
    const float mnL = -mn * C2;
    for (int r = 0; r < 16; ++r) p0[r] = fmaf(p0[r], C2, mnL); for (int r = 0; r < 16; ++r) p1[r] = fmaf(p1[r], C2, mnL);
    for (int r = 0; r < 16; ++r) p0[r] = __builtin_amdgcn_exp2f(p0[r]);
}
__device__ __forceinline__ void finishSM(f32x16& p0, f32x16& p1, float alpha, float& l_reg, bf16x8& pa0, bf16x8& pa1, bf16x8& pa2, bf16x8& pa3) {
    for (int r = 0; r < 16; ++r) p1[r] = __builtin_amdgcn_exp2f(p1[r]);
    float ps = 0; for (int r = 0; r < 16; ++r) ps += p0[r]; for (int r = 0; r < 16; ++r) ps += p1[r];
    { auto rr = __builtin_amdgcn_permlane32_swap(__float_as_uint(ps), __float_as_uint(ps), false, false);
      ps = __uint_as_float(rr[0]) + __uint_as_float(rr[1]); }
    l_reg = l_reg * alpha + ps;
#define PK4(P, B_, OUT) do { unsigned a0 = cvtpk(P[B_+0], P[B_+1]), a1 = cvtpk(P[B_+2], P[B_+3]);                          \
        unsigned b0 = cvtpk(P[B_+4], P[B_+5]), b1 = cvtpk(P[B_+6], P[B_+7]);                                             \
        auto r0 = __builtin_amdgcn_permlane32_swap(a0, b0, false, false); auto r1 = __builtin_amdgcn_permlane32_swap(a1, b1, false, false); \
        u32x4 w = {r0[0], r1[0], r0[1], r1[1]}; OUT = *reinterpret_cast<bf16x8*>(&w); } while (0)
    PK4(p0, 0, pa0); PK4(p0, 8, pa1); PK4(p1, 0, pa2); PK4(p1, 8, pa3);
#undef PK4
}
template <int KB, bool SK>
__device__ __forceinline__ void qkt(f32x16& p0, f32x16& p1, const char* K_lds, int r32, int hi, const bf16x8* qr, bool act) {
    if (SK && !act) { const float NEG = -__builtin_inff();
#pragma unroll
        for (int r = 0; r < 16; ++r) { p0[r] = NEG; p1[r] = NEG; } return; }
    p0 = f32x16{}; p1 = f32x16{};
    const char* kb[4];
#pragma unroll
    for (int dd = 0; dd < 4; ++dd) kb[dd] = K_lds + KB * SHM_K + KSWZ(r32, (dd * 16 + hi * 8) * 2);
#pragma unroll
    for (int d0 = 0; d0 < 8; ++d0) { const char* a = kb[d0 & 3] + (d0 >> 2) * 128;
        bf16x8 b0 = *reinterpret_cast<const bf16x8*>(a);
        bf16x8 b1 = *reinterpret_cast<const bf16x8*>(a + 32 * 256);
        p0 = __builtin_amdgcn_mfma_f32_32x32x16_bf16(b0, qr[d0], p0, 0, 0, 0);
        p1 = __builtin_amdgcn_mfma_f32_32x32x16_bf16(b1, qr[d0], p1, 0, 0, 0); }
}
template <int VB, bool SK>
__device__ __forceinline__ void pv_tile(f32x16* o, int vb0, bf16x8 pa0, bf16x8 pa1, bf16x8 pa2, bf16x8 pa3, bool act) {
    if (SK && !act) return;
#define TRRD(dst, off) asm volatile("ds_read_b64_tr_b16 %0, %1 offset:%2" : "=&v"(dst) : "v"(vb0), "i"(off) : "memory")
#define PV_D0(d0) do { s16x4 l0, l1, l2, l3, h0, h1, h2, h3; constexpr int b_ = VB * SHM_V + v_rd_off(d0, 0, 0);     \
        TRRD(l0, b_); TRRD(h0, b_ + 2048); TRRD(l1, b_ + 4096); TRRD(h1, b_ + 6144); TRRD(l2, b_ + 8192); TRRD(h2, b_ + 10240); TRRD(l3, b_ + 12288); TRRD(h3, b_ + 14336); \
        asm volatile("s_waitcnt lgkmcnt(0)" ::: "memory"); SBAR();                 \
        o[d0] = __builtin_amdgcn_mfma_f32_32x32x16_bf16(pa0, (bf16x8){l0[0], l0[1], l0[2], l0[3], h0[0], h0[1], h0[2], h0[3]}, o[d0], 0, 0, 0);   \
        o[d0] = __builtin_amdgcn_mfma_f32_32x32x16_bf16(pa1, (bf16x8){l1[0], l1[1], l1[2], l1[3], h1[0], h1[1], h1[2], h1[3]}, o[d0], 0, 0, 0);   \
        o[d0] = __builtin_amdgcn_mfma_f32_32x32x16_bf16(pa2, (bf16x8){l2[0], l2[1], l2[2], l2[3], h2[0], h2[1], h2[2], h2[3]}, o[d0], 0, 0, 0);   \
        o[d0] = __builtin_amdgcn_mfma_f32_32x32x16_bf16(pa3, (bf16x8){l3[0], l3[1], l3[2], l3[3], h3[0], h3[1], h3[2], h3[3]}, o[d0], 0, 0, 0); } while (0)
    PV_D0(0); PV_D0(1); PV_D0(2); PV_D0(3);
#undef PV_D0
#undef TRRD
}

template <class TIn, class TOut> struct BlockRef { const TIn* Q; const TIn* K; const TIn* V; TOut* O; const unsigned* SELP; int P0; };
template <class TIn> struct Seam {
    bf16x8 qr[8];
    bf16x8 st_v0, st_v1, st_k0, st_k1; f32x4 sf0, sf1, sf2, sf3;
    f32x4 tq[16];
};
__device__ __forceinline__ int swa_jlo(int P0, int W) { const int lowk = P0 - W + 1; return lowk > 0 ? lowk / KVBLK : 0; }
#define ROW(p, k0, rr) ((p) + (size_t)((k0) + (rr)) * KSTR + sc)
#define VMW() asm volatile("s_waitcnt vmcnt(0)" ::: "memory")
#define VMWN(n) asm volatile("s_waitcnt vmcnt(%0)" :: "i"(n) : "memory")
#define SLOAD_H(Kp, Vp, k0) do { S.st_v0 = load8<TIn>(ROW(Vp, k0, sr)); S.st_v1 = load8<TIn>(ROW(Vp, k0, 32 + sr));              \
                         S.st_k0 = load8<TIn>(ROW(Kp, k0, sr)); S.st_k1 = load8<TIn>(ROW(Kp, k0, 32 + sr)); } while (0)
#define SWRITE_HK(bf) do { *(bf16x8*)(K_lds + (bf) * SHM_K + kws) = S.st_k0; *(bf16x8*)(K_lds + (bf) * SHM_K + kws + 32 * 256) = S.st_k1; } while (0)
#define SWRITE_HV(bf) do { *(bf16x8*)(V_lds + (bf) * SHM_V + vst0) = S.st_v0; *(bf16x8*)(V_lds + (bf) * SHM_V + vst1) = S.st_v1; } while (0)
#define SWRITE_H(bf) do { SWRITE_HV(bf); SWRITE_HK(bf); } while (0)
#define SLOAD_F(p, k0) do { S.sf0 = *(const f32x4*)ROW(p, k0, sr); S.sf1 = *(const f32x4*)(ROW(p, k0, sr) + 4);                \
                            S.sf2 = *(const f32x4*)ROW(p, k0, 32 + sr); S.sf3 = *(const f32x4*)(ROW(p, k0, 32 + sr) + 4); } while (0)
#define SWRITE_KF(bf) do { *(bf16x8*)(K_lds + (bf) * SHM_K + kws) = pack8(S.sf0, S.sf1); *(bf16x8*)(K_lds + (bf) * SHM_K + kws + 32 * 256) = pack8(S.sf2, S.sf3); } while (0)
#define SWRITE_VF(bf) do { *(bf16x8*)(V_lds + (bf) * SHM_V + vst0) = pack8(S.sf0, S.sf1); *(bf16x8*)(V_lds + (bf) * SHM_V + vst1) = pack8(S.sf2, S.sf3); } while (0)
template <class TIn, class TOut>
__device__ __forceinline__ void causal_swa_prime(const BlockRef<TIn, TOut>& cur, int W, char* lds, Seam<TIn>& S) {
    constexpr bool F32 = same_t<TIn, float>::v;
    const int tid = threadIdx.x, wid = __builtin_amdgcn_readfirstlane(tid >> 6), lane = tid & 63, r32 = lane & 31, hi = lane >> 5;
    const int sr = tid >> 4, sc = (tid & 15) * 8, kws = KSWZ(sr, sc * 2); char* K_lds = lds + 2 * SHM_V;
    const int kb0 = swa_jlo(cur.P0, W) * KVBLK;
    for (int d0 = 0; d0 < 8; ++d0) S.qr[d0] = load8<TIn>(cur.Q + HEADOFF(wid) + (size_t)(TOKOFF(wid) + r32) * QSTR + d0 * 16 + hi * 8);
    if constexpr (F32) { SLOAD_F((const float*)cur.K, kb0); VMW(); SWRITE_KF(0); SBAR(); SLOAD_F((const float*)cur.V, kb0); }
    else { SLOAD_H(cur.K, cur.V, kb0); VMW(); SWRITE_HK(0); }
    __syncthreads();
}
template <int MODE, class TIn, class TOut>
__device__ __forceinline__ void causal_swa_block(const BlockRef<TIn, TOut>& cur, const BlockRef<TIn, TOut>& nxt, int skv, int W, char* lds, Seam<TIn>& S) {
    constexpr bool F32 = same_t<TIn, float>::v;
    const int tid = threadIdx.x, wid = __builtin_amdgcn_readfirstlane(tid >> 6), lane = tid & 63, r32 = lane & 31, hi = lane >> 5;
    const int j_lo = swa_jlo(cur.P0, W);
    int j_hi = (cur.P0 + PB - 1) / KVBLK + 1; if (j_hi > skv / KVBLK) j_hi = skv / KVBLK;
    const int NT = j_hi - j_lo;
    const int kbn = swa_jlo(nxt.P0, W) * KVBLK;
    const int qlo = cur.P0 + TOKOFF(wid), qm = qlo + r32 - 4 * hi;
    unsigned selrow = 0xffffffffu; if constexpr (MODE == 1) selrow = cur.SELP[(size_t)(TOKOFF(wid) + r32) * GKV];
    char* V_lds = lds; char* K_lds = lds + 2 * SHM_V;
    float* ws = (float*)(lds + 2 * SHM_V + 2 * SHM_K) + wid * 64; float* li_l = ws, * al_l = ws + 32;
    float m_reg = -1e30f, l_reg = 0; f32x16 o[4] = {};
    const int sr = tid >> 4, sc = (tid & 15) * 8, vst0 = v_st(sr, sc), vst1 = v_st(32 + sr, sc), kws = KSWZ(sr, sc * 2);
    const int vb0 = (int)(uintptr_t)V_lds + v_rd_base(lane);
    const TIn* Kh = cur.K; const TIn* Vh = cur.V;
#define RESC(a) do { if (__any((a) < 1.f)) { if (hi == 0) al_l[r32] = (a); asm volatile("s_waitcnt lgkmcnt(0)" ::: "memory");              \
                     for (int d_ = 0; d_ < 4; ++d_) for (int r = 0; r < 16; ++r) o[d_][r] *= al_l[crow(r, hi)]; } } while (0)
#define KBASE(t) ((j_lo + (t)) * KVBLK)
#define ACT(t) (KBASE(t) <= qlo + QBLK - 1 && KBASE(t) + KVBLK - 1 >= qlo - W + 1)
#define MASKT(P0_, P1_, t) do { const int kb_ = KBASE(t); if constexpr (MODE == 1) { const bool sb_ = (selrow >> (kb_ >> 6)) & 1u; if (__any(!sb_) || kb_ + KVBLK - 1 > qlo) mask_tile_sel(P0_, P1_, qm - kb_, sb_); } else { if ((!SK || ACT(t)) && (kb_ + KVBLK - 1 > qlo || kb_ <= qlo + QBLK - 1 - W)) mask_tile(P0_, P1_, qm - kb_, (unsigned)W); } } while (0)
    constexpr int NQL = F32 ? 16 : 8;
    constexpr bool SK = false;
#define SEAM_K0() do { VMWN(NQL); if constexpr (F32) { SWRITE_KF(0); SBAR(); SLOAD_F((const float*)nxt.V, kbn); } else { SWRITE_HK(0); } SBAR(); } while (0)
    f32x16 pA0, pA1, pB0, pB1; float mnA, mnB, alA, alB; bf16x8 pa0, pa1, pa2, pa3;
    if constexpr (F32) { VMW(); SWRITE_VF(0); SBAR(); } else { SWRITE_HV(0); SBAR(); }
    if (NT > 1) { if constexpr (F32) SLOAD_F((const float*)Kh, KBASE(1)); else SLOAD_H(Kh, Vh, KBASE(1)); }
    SBAR(); qkt<0, SK>(pA0, pA1, K_lds, r32, hi, S.qr, ACT(0));
    if constexpr (F32) { if (NT > 1) { VMW(); SWRITE_KF(1); SBAR(); SLOAD_F((const float*)Vh, KBASE(1)); } }
    MASKT(pA0, pA1, 0); partialSM(pA0, pA1, m_reg, mnA, alA);
    if (NT > 1) { VMW(); if constexpr (F32) { SWRITE_VF(1); SBAR(); if (NT > 2) SLOAD_F((const float*)Kh, KBASE(2)); } else SWRITE_H(1); }
    __syncthreads();
#define HALF_STEP(PX0, PX1, mnX, alX, PY0, PY1, alY, t, KB, VB, SB) do {                                                      \
        SBAR(); qkt<KB, SK>(PX0, PX1, K_lds, r32, hi, S.qr, ACT(t));                                             \
        finishSM(PY0, PY1, alY, l_reg, pa0, pa1, pa2, pa3); SBAR();                                                           \
        if ((t) + 1 < NT) { if constexpr (F32) { VMW(); SWRITE_KF(SB); SBAR(); SLOAD_F((const float*)Vh, KBASE((t) + 1)); }  \
                            else { SLOAD_H(Kh, Vh, KBASE((t) + 1)); } SBAR(); }                                               \
        pv_tile<VB, SK>(o, vb0, pa0, pa1, pa2, pa3, ACT((t) - 1)); MASKT(PX0, PX1, (t)); partialSM(PX0, PX1, m_reg, mnX, alX);                                        \
        __syncthreads();                                                                                                      \
        if ((t) + 1 < NT) { VMW(); if constexpr (F32) { SWRITE_VF(SB); SBAR(); if ((t) + 2 < NT) SLOAD_F((const float*)Kh, KBASE((t) + 2)); } \
                            else { SWRITE_H(SB); } }                                                                          \
        RESC(alX); __syncthreads(); } while (0)
    for (int t = 1; t + 1 < NT; t += 2) {
        HALF_STEP(pB0, pB1, mnB, alB, pA0, pA1, alA, t, 1, 0, 0);
        HALF_STEP(pA0, pA1, mnA, alA, pB0, pB1, alB, t + 1, 0, 1, 1);
    }
    const bool even = (NT & 1) == 0;
    if (even) { SBAR(); qkt<1, SK>(pB0, pB1, K_lds, r32, hi, S.qr, ACT(NT - 1)); SBAR(); }
#define QROW(e) (nxt.Q + HEADOFF(wid) + (size_t)(TOKOFF(wid) + r32) * QSTR + ((e) >> 1) * 16 + hi * 8 + ((e) & 1) * 4)
    if constexpr (F32) { SLOAD_F((const float*)nxt.K, kbn); SBAR();
#pragma unroll
        for (int e = 0; e < 8; ++e) S.tq[e] = *(const f32x4*)QROW(e); }
    else { SLOAD_H(nxt.K, nxt.V, kbn); SBAR();
#pragma unroll
        for (int d0 = 0; d0 < 8; ++d0) S.qr[d0] = load8<TIn>(nxt.Q + HEADOFF(wid) + (size_t)(TOKOFF(wid) + r32) * QSTR + d0 * 16 + hi * 8); }
    SBAR();
    finishSM(pA0, pA1, alA, l_reg, pa0, pa1, pa2, pa3); SBAR();
    if constexpr (F32) {
#pragma unroll
        for (int e = 8; e < 16; ++e) S.tq[e] = *(const f32x4*)QROW(e); SBAR(); }
#undef QROW
    pv_tile<0, SK>(o, vb0, pa0, pa1, pa2, pa3, ACT(even ? NT - 2 : NT - 1));
    if (even) { MASKT(pB0, pB1, NT - 1); partialSM(pB0, pB1, m_reg, mnB, alB); __syncthreads(); RESC(alB);
        finishSM(pB0, pB1, alB, l_reg, pa0, pa1, pa2, pa3); SBAR(); pv_tile<1, SK>(o, vb0, pa0, pa1, pa2, pa3, ACT(NT - 1)); }
    SBAR(); SEAM_K0();
    if (hi == 0) li_l[r32] = l_reg; asm volatile("s_waitcnt lgkmcnt(0)" ::: "memory");
    float rli[16];
#pragma unroll
    for (int r = 0; r < 16; ++r) rli[r] = __builtin_amdgcn_rcpf(li_l[crow(r, hi)]);
    TOut* Ow = cur.O + HEADOFF(wid) + (size_t)TOKOFF(wid) * OSTR;
#pragma unroll
    for (int r = 0; r < 16; ++r) { const int orow = crow(r, hi);
#pragma unroll
        for (int d0 = 0; d0 < 4; ++d0) { const float v = o[d0][r] * rli[r];
            if constexpr (same_t<TOut, float>::v) { Ow[(size_t)orow * OSTR + d0 * 32 + r32] = v; }
            else { const float vn = __shfl_xor(v, 1);
                   if ((r32 & 1) == 0) *(unsigned*)(Ow + (size_t)orow * OSTR + d0 * 32 + r32) = cvtpk(v, vn); } } }
    if constexpr (F32) {
#pragma unroll
        for (int d0 = 0; d0 < 8; ++d0) S.qr[d0] = pack8(S.tq[2 * d0], S.tq[2 * d0 + 1]); }
    __syncthreads();
#undef RESC
#undef KBASE
#undef ACT
#undef MASKT
#undef SEAM_K0
#undef HALF_STEP
}
#undef ROW
#undef VMW
#undef VMWN
#undef SLOAD_H
#undef SWRITE_HK
#undef SWRITE_HV
#undef SWRITE_H
#undef SLOAD_F
#undef SWRITE_KF
#undef SWRITE_VF
__host__ __device__ inline int swa_nramp(int nqb, int W, int qoff) { const int t = W - 1 - qoff; const int n = t < 0 ? 0 : t / PB + 1; return n > nqb ? nqb : n; }
__host__ __device__ inline int swa_nx(int nqb, int nramp, int order) { return (order & ORDER_PAIRED) ? (nramp + 1) / 2 + (nqb - nramp) : nqb; }
struct SwaItem { int bh, qb0, qb1; };
__device__ __forceinline__ SwaItem swa_decode(int L, int nb, int nh, int nhkv, int nqb, int nx, int nramp, int order) {
    const int G = nh / nhkv; SwaItem it; int x;
    if ((order & ORDER_XCD) && (nb * nhkv) % 8 == 0) { const int xcd = L & 7, k = L >> 3, per = G * nx, gi = k / per, r = k - gi * per;
        it.bh = (gi * 8 + xcd) * G + r / nx; x = r % nx; }
    else { it.bh = L / nx; x = L - it.bh * nx; }
    if (order & ORDER_PAIRED) { const int ns = nqb - nramp;
        if (x < ns) { it.qb0 = it.qb1 = nqb - 1 - x; } else { it.qb0 = x - ns; it.qb1 = nramp - 1 - it.qb0; } }
    else { it.qb0 = it.qb1 = ((order & 3) == ORDER_REVERSED) ? nqb - 1 - x : x; }
    return it;
}
}
template <int MODE>
__device__ __forceinline__ fa::BlockRef<bf16, bf16> fa_ref(unsigned char* ws, const fa::SwaItem& it, int pass) {
    const int tb = pass ? it.qb1 : it.qb0, b = it.bh >> 2, g = it.bh & 3;
    const bf16* P = (const bf16*)(ws + WS_P);
    fa::BlockRef<bf16, bf16> r;
    const size_t m0 = (size_t)b * SEQ + (size_t)tb * fa::PB;
    r.Q = P + m0 * NP + C_QB + g * RG * 128;
    r.K = P + (size_t)b * SEQ * NP + (MODE ? C_KS : C_KW) + g * 128;
    r.V = P + (size_t)b * SEQ * NP + (MODE ? C_VS : C_VW) + g * 128;
    r.O = (bf16*)(ws + (MODE ? WS_OSB : WS_OWB)) + m0 * DM + g * RG * 128;
    r.SELP = (const unsigned*)(ws + WS_SEL) + m0 * GKV + g;
    r.P0 = tb * fa::PB;
    return r;
}
template <int MODE>
__device__ __forceinline__ void fa_phase(const Ctx& C, char* lds, int nwg  ) {
    using namespace fa;
    constexpr int W = MODE == 0 ? WIN : SEQ;
    constexpr int nqb = SEQ / PB, order = ORDER_PAIRED | ORDER_XCD;
    const int nramp = swa_nramp(nqb, W, 0), nx = swa_nx(nqb, nramp, order), total = nx * BATCH * GKV, stride = nwg;
    int L = (MODE == 0 && nwg == C.G) ? (C.bid + C.G / 2) % C.G : C.bid;
    if (L >= total || C.bid >= nwg) return;
    SwaItem it = swa_decode(L, BATCH, GKV, GKV, nqb, nx, nramp, order); int pass = 0;
    BlockRef<bf16, bf16> cur = fa_ref<MODE>(C.ws, it, 0);
    Seam<bf16> S;
    causal_swa_prime<bf16, bf16>(cur, W, lds, S);
    for (;;) {
        const bool more_pass = pass == 0 && it.qb1 != it.qb0, more_item = L + stride < total, last = !more_pass && !more_item;
        SwaItem itn = it; int passn = pass + 1, Ln = L;
        if (!more_pass) { passn = 0; Ln = more_item ? L + stride : L; itn = swa_decode(Ln, BATCH, GKV, GKV, nqb, nx, nramp, order); }
        const BlockRef<bf16, bf16> nxt = last ? cur : fa_ref<MODE>(C.ws, itn, passn);
        causal_swa_block<MODE, bf16, bf16>(cur, nxt, SEQ, W, lds, S);
        if (last) break;
        cur = nxt; it = itn; pass = passn; L = Ln;
    }
}
__device__ __forceinline__ void nsa_combine(const Ctx& C) {
    const bf16* P = WSP(bf16, WS_P); const bf16* OC = WSP(bf16, WS_OCB); const bf16* OS = WSP(bf16, WS_OSB); const bf16* OW = WSP(bf16, WS_OWB); bf16* OB = WSP(bf16, WS_OB);
    for (int idx = C.bid * NTHR + C.tid; idx < T * 256; idx += C.G * NTHR) {
        const int m = idx >> 8, col = (idx & 255) * 8, hb = col >> 7;
        const bf16* gp = P + (size_t)m * NP + C_GB + hb * 3;
        const float g0 = sigmoidf_(bf2f(gp[0])), g1 = sigmoidf_(bf2f(gp[1])), g2 = sigmoidf_(bf2f(gp[2]));
        const size_t o = (size_t)m * DM + col;
        const v4u cw = *(const v4u*)(OC + o);
        const f32x4 c0 = {bflo(cw.x), bfhi(cw.x), bflo(cw.y), bfhi(cw.y)}, c1 = {bflo(cw.z), bfhi(cw.z), bflo(cw.w), bfhi(cw.w)};
        const v4u sw = *(const v4u*)(OS + o), ww = *(const v4u*)(OW + o);
        v4u r;
        r.x = pk2(g0 * c0.x + g1 * bflo(sw.x) + g2 * bflo(ww.x), g0 * c0.y + g1 * bfhi(sw.x) + g2 * bfhi(ww.x));
        r.y = pk2(g0 * c0.z + g1 * bflo(sw.y) + g2 * bflo(ww.y), g0 * c0.w + g1 * bfhi(sw.y) + g2 * bfhi(ww.y));
        r.z = pk2(g0 * c1.x + g1 * bflo(sw.z) + g2 * bflo(ww.z), g0 * c1.y + g1 * bfhi(sw.z) + g2 * bfhi(ww.z));
        r.w = pk2(g0 * c1.z + g1 * bflo(sw.w) + g2 * bflo(ww.w), g0 * c1.w + g1 * bfhi(sw.w) + g2 * bfhi(ww.w));
        *(v4u*)(OB + o) = r;
    }
}
#ifndef MK_N_LAUNCHES
#define MK_N_LAUNCHES 1
#endif
constexpr int N_PHASES = 13;
#ifndef FA1_WGS
#define FA1_WGS 171
#endif
#ifndef CONV_P4
#define CONV_P4 40000
#endif

__global__ void __launch_bounds__(NTHR, 2) fwd(Args args) {
    extern __shared__ __attribute__((aligned(16))) unsigned char lds_raw[];
    Ctx C;
    C.lds = (LAS unsigned char*)lds_raw; C.tid = threadIdx.x; C.lane = C.tid & 63; C.wave = __builtin_amdgcn_readfirstlane(C.tid >> 6); C.G = gridDim.x; C.bid = blockIdx.x;
    C.A = &args;
    C.out = args.out; C.ws = args.ws; C.ctl = (unsigned*)(args.ws + WS_CTL);
    volatile LAS unsigned* MISC = (volatile LAS unsigned*)(C.lds + MISC_OFF);
    if (C.tid < 32) MISC[C.tid] = 0u;
    __syncthreads();
    const int lo = args.ph_lo, hi = args.ph_hi;
    XcdBarrier bar; bar.bar = C.ctl + CW_BAR + args.li * 4096; bar.x = 0; bar.st = nullptr;
    if (hi - lo > 1) bar = xcd_barrier_post(C.ctl + CW_BAR + args.li * 4096, MISC + 8);
#ifndef PH_MASK
#define PH_MASK 0x1FFF
#endif
#define IN(k) (((PH_MASK >> (k)) & 1) && lo <= (k) && (k) < hi)
#define PH_BEGIN() do { int t_ = threadIdx.x; asm volatile("" : "+v"(t_)); C.tid = t_; C.lane = t_ & 63; } while (0)
#define SEAM(k) do { if (IN(k) && IN((k) + 1)) xcd_barrier(bar); } while (0)
    bf16* P = WSP(bf16, WS_P);
    if (IN(0)) { PH_BEGIN(); p0_prologue(C); SEAM(0); }
    if (IN(1)) { PH_BEGIN();
        pg8::Gemm g{WSP(bf16, WS_H), WSP(bf16, WS_WINT), T, 17408, DM}; pg8::StaticOrder S; S.init(T, 17408, C.G, C.bid);
        EpiP1 E{P, WSP(float, WS_RC), WSP(float, WS_RS)};
        pg8::gemm_phase<EpiP1, pg8::StaticOrder, PG8_ALIGN, PG8_SP2>(C.lds + RING_OFF, g, S, E);
        small_proj(C);
        SEAM(1);
    }
    const int sub = args.pad;
    if (IN(2)) { PH_BEGIN(); if (sub != 2) dn_chunk_prep(C, C.bid * NWAVES + C.wave, C.G * NWAVES); if (sub != 1) nsa_compress2(C); SEAM(2); }
    if (IN(3)) { PH_BEGIN();
        const int half = C.G / 2;
#ifndef X_NO_SCAN
        if (C.bid < half && sub != 2 && sub != 4) { for (int u = C.bid; u < BATCH * HA; u += half) dn_scan(C, u); }
#endif
#ifndef X_NO_CMP
        if (C.bid >= half && sub != 2 && sub != 3) nsa_cmp_attn2(C, C.bid - half, C.G - half);
#endif
        __syncthreads();
#ifndef X_NO_FA0
        if (sub != 1) fa_phase<0>(C, (char*)lds_raw + RING_OFF, C.G);
#endif
        SEAM(3);
    }
    if (IN(4)) { PH_BEGIN();
        const int nfa = C.G > FA1_WGS ? FA1_WGS : C.G;
        if (sub != 2) fa_phase<1>(C, (char*)lds_raw + RING_OFF, nfa);
        if (sub == 0 && C.bid >= nfa) moe_weight_convert(C, 0, CONV_P4, (C.bid - nfa) * NWAVES + C.wave, (C.G - nfa) * NWAVES);
        if (sub != 1) dn_post2(C); SEAM(4); }
    if (IN(5)) { PH_BEGIN(); nsa_combine(C); SEAM(5); }
    if (IN(6)) { PH_BEGIN();
        { pg8::Gemm g{WSP(bf16, WS_OA), WSP(bf16, WS_WPA), T, DM, DM}; pg8::StaticOrder S; S.init(T, DM, C.G, C.bid);
          EpiProj<0> E{P, WSP(bf16, WS_M1), WSP(bf16, WS_MERGED)};
          pg8::gemm_phase<EpiProj<0>, pg8::StaticOrder, PG8_ALIGN, PG8_SP2>(C.lds + RING_OFF, g, S, E); }
        { pg8::Gemm g{WSP(bf16, WS_OB), WSP(bf16, WS_WPB), T, DM, DM}; pg8::StaticOrder S; S.init(T, DM, C.G, C.bid);
          EpiProj<1> E{P, WSP(bf16, WS_M1), WSP(bf16, WS_MERGED)};
          pg8::gemm_phase<EpiProj<1>, pg8::StaticOrder, PG8_ALIGN, PG8_SP2>(C.lds + RING_OFF, g, S, E); }
        SEAM(6);
    }
    if (IN(7)) { PH_BEGIN();
        pg8::Gemm g{WSP(bf16, WS_MERGED), WSP(bf16, WS_WOT), T, DM, DM}; pg8::StaticOrder S; S.init(T, DM, C.G, C.bid);
        EpiOut E{((const float*)C.A->in[0]), WSP(float, WS_X1), WSP(bf16, WS_HN), ((const float*)C.A->in[17])};
        pg8::gemm_phase<EpiOut, pg8::StaticOrder, PG8_ALIGN, PG8_SP2>(C.lds + RING_OFF, g, S, E);
        SEAM(7);
    }
    if (IN(8)) { PH_BEGIN(); p7_norm_router(C); moe_weight_convert(C, (C.G > FA1_WGS) ? CONV_P4 : 0, 1 << 30, C.wave < 2 ? -1 : C.bid * (NWAVES - 2) + C.wave - 2, C.G * (NWAVES - 2)); SEAM(8); }
    if (IN(9)) { PH_BEGIN(); p8_gather(C); SEAM(9); }
    if (IN(10)) { PH_BEGIN();
        int total; moe_tables(C, 16, total);
        pg8::Gemm g{WSP(bf16, WS_XG), WSP(bf16, WS_WGU), MOE_ROWS, NEXP * 4096, DM};
        MoeOrder<false> S{(const LAS int*)(C.lds + TAB_OFF), 16, C.G, C.bid, total, nullptr};
        EpiMoe1 E{WSP(bf16, WS_ACT), ((const float*)C.A->in[21]), ((const float*)C.A->in[23])};
        pg8::gemm_phase<EpiMoe1, MoeOrder<false>, PG8_ALIGN, PG8_SP2>(C.lds + RING_OFF, g, S, E);
        SEAM(10);
    }
    if (IN(11)) { PH_BEGIN();
        int total; moe_tables(C, 8, total);
        pg8::Gemm g{WSP(bf16, WS_ACT), WSP(bf16, WS_WD), MOE_ROWS, NEXP * DM, DFF};
        MoeOrder<false> S{(const LAS int*)(C.lds + TAB_OFF), 8, C.G, C.bid, total, nullptr};
        EpiMoe2 E{WSP(bf16, WS_Y), ((const float*)C.A->in[25])};
        pg8::gemm_phase<EpiMoe2, MoeOrder<false>, PG8_ALIGN, PG8_SP2>(C.lds + RING_OFF, g, S, E);
        SEAM(11);
    }
    if (IN(12)) { PH_BEGIN(); p11_final(C); }
}

extern "C" void kernel_launch(void* const* d_in, const int* in_sizes, int n_in, void* d_out, int out_size, void* d_ws, size_t ws_size, hipStream_t stream) {
    static int grid = 0;
    if (grid == 0) {
        if (n_in != 27 || out_size != T * DM || ws_size < WS_END) { fprintf(stderr, "kernel_launch: unexpected shapes (n_in %d out %d ws %zu)\n", n_in, out_size, ws_size); grid = -1; return; }
        int dev = 0, cus = 0, per_cu = 0;
        if (hipGetDevice(&dev) != hipSuccess || hipDeviceGetAttribute(&cus, hipDeviceAttributeMultiprocessorCount, dev) != hipSuccess) { grid = -1; return; }
        if (hipFuncSetAttribute((const void*)fwd, hipFuncAttributeMaxDynamicSharedMemorySize, LDS_BYTES) != hipSuccess) { fprintf(stderr, "kernel_launch: hipFuncSetAttribute failed\n"); grid = -1; return; }
        if (hipOccupancyMaxActiveBlocksPerMultiprocessor(&per_cu, (const void*)fwd, NTHR, LDS_BYTES) != hipSuccess || per_cu < 1) fprintf(stderr, "kernel_launch: occupancy query says %d\n", per_cu);
        (void)hipGetLastError();
        grid = cus;
    }
    if (grid < 0) return;
    if (hipMemsetAsync((char*)d_ws + WS_CTL, 0, CTL_ZERO_BYTES, stream) != hipSuccess) return;
    Args a{};
    for (int i = 0; i < 27; ++i) a.in[i] = d_in[i];
    a.out = (float*)d_out; a.ws = (unsigned char*)d_ws;
#if MK_N_LAUNCHES == 1
    const int cuts[2] = {0, N_PHASES}; const int nl = 1;
#else
    int cuts[N_PHASES + 1]; for (int i = 0; i <= N_PHASES; ++i) cuts[i] = i; const int nl = N_PHASES;
#endif
    for (int li = 0; li < nl; ++li) {
        a.ph_lo = cuts[li]; a.ph_hi = cuts[li + 1]; a.li = li; a.pad = 0;
        hipLaunchKernelGGL(fwd, dim3(grid), dim3(NTHR), LDS_BYTES, stream, a);
        const hipError_t le = hipPeekAtLastError();
        if (le != hipSuccess) { fprintf(stderr, "kernel_launch: launch %d failed: %s\n", li, hipGetErrorName(le)); break; }
    }
#if defined(PROBE_LO)
    { a.ph_lo = PROBE_LO; a.ph_hi = PROBE_HI; a.li = 1;
#if defined(PROBE_SUB)
      a.pad = PROBE_SUB;
#else
      a.pad = 0;
#endif
 hipLaunchKernelGGL(fwd, dim3(grid), dim3(NTHR), LDS_BYTES, stream, a); }
#endif
}
```

```cpp
#include <hip/hip_runtime.h>
#include <cstdio>
#include <cstdint>
namespace pg8 {
#define PG8_LAS __attribute__((address_space(3)))
typedef unsigned short bf16_t;
typedef short bf16x8 __attribute__((ext_vector_type(8)));
typedef float f32x4 __attribute__((ext_vector_type(4)));
typedef unsigned u32x4 __attribute__((ext_vector_type(4)));
constexpr int BM = 256, BK = 64, HALF = 128, HTB = HALF * BK * 2  , STAGE_BYTES = 8 * HTB, NXCD = 8, WGM = 8;

__host__ __device__ __forceinline__ int lds_byte(int r, int c) { const int st = (r >> 4) * 2 + (c >> 5), rr = r & 15, cc = c & 31, ob = rr * 64 + cc * 2; return st * 1024 + (ob ^ (((ob >> 9) & 1) << 5)); }
__host__ __device__ __forceinline__ void stage_rc(int b, int& R, int& C) { const int st = b / 1024, sb = b % 1024, swz = sb ^ (((sb >> 9) & 1) << 5); R = (st >> 1) * 16 + swz / 64; C = (st & 1) * 32 + (swz % 64) / 2; }
__host__ __device__ __forceinline__ int perm32(int rho) { const int n = rho >> 4, i = rho & 15; return 8 * (i >> 2) + 4 * n + (i & 3); }

struct Unit { int pm, pn; };
struct Gemm { const bf16_t* A; const bf16_t* Bt; int M, N, K; };

struct StaticOrder {
    static constexpr bool GATHER = false;
    static constexpr int B_AUX = 0;
    __device__ __forceinline__ bool upper_half_empty(const Unit&) const { return false; }
    int nM, nN, nwg, G, c;
    __host__ __device__ void init(int M, int N, int G_, int c_) { nM = M / BM; nN = N / BM; nwg = nM * nN; G = G_; c = c_; }
    __host__ __device__ bool next(int i, Unit& u) const {
        const long L = (long)i * G + c; if (L >= nwg) return false;
        int wgid = (int)L; { const int q = nwg / NXCD, r = nwg % NXCD, xcd = wgid % NXCD, off = wgid / NXCD; wgid = (xcd < r ? xcd * (q + 1) : r * (q + 1) + (xcd - r) * q) + off; }
        const int nig = WGM * nN, gid = wgid / nig, fm = gid * WGM, gsz = (nM - fm) < WGM ? (nM - fm) : WGM;
        u.pm = fm + ((wgid % nig) % gsz); u.pn = (wgid % nig) / gsz; return true;
    }
    __device__ __forceinline__ void a_ready(const Unit&) const {}
    __device__ __forceinline__ void done(const Unit&) const {}
};

__device__ __forceinline__ unsigned cvt_pk_bf16(float lo, float hi) { unsigned r; asm volatile("v_cvt_pk_bf16_f32 %0, %1, %2" : "=v"(r) : "v"(lo), "v"(hi)); return r; }
typedef float f32x2 __attribute__((ext_vector_type(2)));

template <class Epi, class Sched, bool ALIGN_EPI = false, bool SP2 = false>
__device__ __forceinline__ void gemm_phase(PG8_LAS unsigned char* lds, const Gemm g, const Sched& S, const Epi& E) {
    const int tid = threadIdx.x, wid = __builtin_amdgcn_readfirstlane(tid >> 6), lane = tid & 63, wr = wid >> 2, wc = wid & 3, fr = lane & 15, fq = lane >> 4;
    const int K = g.K, nt = K / BK;
    unsigned voffA[2], voffB[2];
#pragma unroll
    for (int i = 0; i < 2; ++i) { int R, C; stage_rc(tid * 16 + i * 8192, R, C); const int Rb = Epi::PERM ? ((R & ~31) + perm32(R & 31)) : R;
        voffA[i] = (unsigned)(R * K + C) * 2u; voffB[i] = (unsigned)(Rb * K + C) * 2u; }
    const size_t kstep = (size_t)(BK * 2);
    const size_t hstep = (size_t)HALF * K * 2;
    const size_t tstep = 2 * hstep;
    const unsigned ldsw = (unsigned)wid * 1024u;
    const int aoff = lds_byte(wr * 64 + fr, fq * 8), boff = lds_byte(wc * 32 + fr, fq * 8);
#define PG8_SA(b, h) (((b) * 2 + (h)) * HTB)
#define PG8_SB(b, h) ((4 + (b) * 2 + (h)) * HTB)
#define PG8_STAGE(bufoff, gbase, voff) do { _Pragma("unroll") for (int _i = 0; _i < 2; ++_i) \
        __builtin_amdgcn_global_load_lds((const unsigned*)((const char*)(gbase) + (voff)[_i]), (PG8_LAS unsigned*)(lds + (bufoff) + ldsw + _i * 8192), 16, 0, 0); } while (0)
#define PG8_STAGE_BW(bufoff, gbase, voff) do { _Pragma("unroll") for (int _i = 0; _i < 2; ++_i) \
        __builtin_amdgcn_global_load_lds((const unsigned*)((const char*)(gbase) + (voff)[_i]), (PG8_LAS unsigned*)(lds + (bufoff) + ldsw + _i * 8192), 16, 0, Sched::B_AUX); } while (0)
#define PG8_LDA(dst, b, h) do { _Pragma("unroll") for (int m = 0; m < 4; ++m) _Pragma("unroll") for (int k = 0; k < 2; ++k) dst[m][k] = *(const PG8_LAS bf16x8*)(lds + PG8_SA(b, h) + aoff + m * 2048 + k * 1024); } while (0)
#define PG8_LDB(dst, b, h) do { _Pragma("unroll") for (int n = 0; n < 2; ++n) _Pragma("unroll") for (int k = 0; k < 2; ++k) dst[n][k] = *(const PG8_LAS bf16x8*)(lds + PG8_SB(b, h) + boff + n * 2048 + k * 1024); } while (0)
#define PG8_MMA(ai, bj, At, Bt) do { __builtin_amdgcn_s_setprio(1); _Pragma("unroll") for (int m = 0; m < 4; ++m) _Pragma("unroll") for (int n = 0; n < 2; ++n) _Pragma("unroll") for (int k = 0; k < 2; ++k) \
        acc[ai][bj][m][n] = __builtin_amdgcn_mfma_f32_16x16x32_bf16(Bt[n][k], At[m][k], acc[ai][bj][m][n], 0, 0, 0); __builtin_amdgcn_s_setprio(0); } while (0)
#define PG8_WAIT_V(n) asm volatile("s_waitcnt vmcnt(" #n ")" ::: "memory")
#define PG8_WAIT_L(n) asm volatile("s_waitcnt lgkmcnt(" #n ")" ::: "memory")
#define PG8_BAR __builtin_amdgcn_s_barrier()
#define PG8_SCHED __builtin_amdgcn_sched_barrier(0)
    Unit cur, nxt; int ui = 0;
    if (!S.next(0, cur)) return;
    unsigned vGc[2][2] = {{0u, 0u}, {0u, 0u}}, vGn[2][2] = {{0u, 0u}, {0u, 0u}};
    if constexpr (Sched::GATHER) {
#pragma unroll
        for (int h = 0; h < 2; ++h)
#pragma unroll
            for (int i = 0; i < 2; ++i) { int R, Cc; stage_rc(tid * 16 + i * 8192, R, Cc); vGc[h][i] = S.row_of(cur, h * HALF + R) * (unsigned)(K * 2) + (unsigned)(Cc * 2); }
    }
#define PG8_STAGE_A(bufoff, aptr, half, nx) do { if constexpr (Sched::GATHER) { _Pragma("unroll") for (int _i = 0; _i < 2; ++_i) { const unsigned _vo = (nx) ? vGn[half][_i] : vGc[half][_i]; \
        __builtin_amdgcn_global_load_lds((const unsigned*)((const char*)(aptr) + _vo), (PG8_LAS unsigned*)(lds + (bufoff) + ldsw + _i * 8192), 16, 0, 0); } } \
        else { PG8_STAGE(bufoff, (aptr) + ((half) ? hstep : 0), voffA); } } while (0)
    f32x4 acc[2][2][4][2];
#pragma unroll
    for (int a = 0; a < 2; ++a)
#pragma unroll
        for (int b = 0; b < 2; ++b)
#pragma unroll
            for (int m = 0; m < 4; ++m)
#pragma unroll
                for (int n = 0; n < 2; ++n) acc[a][b][m][n] = (f32x4){0.f, 0.f, 0.f, 0.f};
    bf16x8 At[4][2], B0[2][2], B1[2][2];
    const char* cA = (const char*)g.A + (Sched::GATHER ? (size_t)0 : (size_t)cur.pm * tstep); const char* cB = (const char*)g.Bt + (size_t)cur.pn * tstep;
    S.a_ready(cur);
    if constexpr (SP2) {
        PG8_STAGE_BW(PG8_SB(0, 0), cB, voffB); PG8_STAGE_BW(PG8_SB(0, 1), cB + hstep, voffB); PG8_STAGE_A(PG8_SA(0, 0), cA, 0, false); PG8_STAGE_A(PG8_SA(0, 1), cA, 1, false);
        if (wr == 1) PG8_BAR;
        PG8_WAIT_V(2); PG8_BAR;
        PG8_STAGE_BW(PG8_SB(1, 0), cB + kstep, voffB); PG8_STAGE_A(PG8_SA(1, 0), cA + kstep, 0, false); PG8_STAGE_BW(PG8_SB(1, 1), cB + hstep + kstep, voffB);
        PG8_WAIT_V(6); PG8_BAR;
    } else {
        PG8_STAGE_BW(PG8_SB(0, 0), cB, voffB); PG8_STAGE_A(PG8_SA(0, 0), cA, 0, false); PG8_STAGE_BW(PG8_SB(0, 1), cB + hstep, voffB); PG8_STAGE_A(PG8_SA(0, 1), cA, 1, false);
        if (wr == 1) PG8_BAR;
        PG8_WAIT_V(4); PG8_BAR;
        PG8_STAGE_BW(PG8_SB(1, 0), cB + kstep, voffB); PG8_STAGE_A(PG8_SA(1, 0), cA + kstep, 0, false); PG8_STAGE_BW(PG8_SB(1, 1), cB + hstep + kstep, voffB);
        PG8_WAIT_V(6); PG8_BAR;
    }
    for (;;) {
        const bool has_next = S.next(ui + 1, nxt);
        if constexpr (Sched::GATHER) { if (has_next) {
#pragma unroll
            for (int h = 0; h < 2; ++h)
#pragma unroll
                for (int i = 0; i < 2; ++i) { int R, Cc; stage_rc(tid * 16 + i * 8192, R, Cc); vGn[h][i] = S.row_of(nxt, h * HALF + R) * (unsigned)(K * 2) + (unsigned)(Cc * 2); } }
            else { vGn[0][0] = vGc[0][0]; vGn[0][1] = vGc[0][1]; vGn[1][0] = vGc[1][0]; vGn[1][1] = vGc[1][1]; } }
        const char* nA = (has_next && !Sched::GATHER) ? (const char*)g.A + (size_t)nxt.pm * tstep : cA; const char* nB = has_next ? (const char*)g.Bt + (size_t)nxt.pn * tstep : cB;
        for (int t = 0; t < nt; t += 2) {
            const bool last = (t == nt - 2);
            const char* a1 = cA + (size_t)(t + 1) * kstep;
            const char* a2 = last ? nA : cA + (size_t)(t + 2) * kstep; const char* b2 = last ? nB : cB + (size_t)(t + 2) * kstep;
            const char* a3 = a2 + kstep; const char* b3 = b2 + kstep;
            if (last && has_next) S.a_ready(nxt);
            if constexpr (SP2) {
            PG8_LDB(B0, 0, 0); PG8_LDB(B1, 0, 1); PG8_SCHED; PG8_LDA(At, 0, 0); PG8_STAGE_A(PG8_SA(1, 1), a1, 1, false);
            PG8_WAIT_V(8); PG8_WAIT_L(0); PG8_BAR; PG8_MMA(0, 0, At, B0); PG8_MMA(0, 1, At, B1); PG8_BAR; PG8_SCHED;
            PG8_LDA(At, 0, 1); PG8_STAGE_BW(PG8_SB(0, 0), b2, voffB); PG8_STAGE_BW(PG8_SB(0, 1), b2 + hstep, voffB); PG8_STAGE_A(PG8_SA(0, 0), a2, 0, last);
            PG8_WAIT_V(8); PG8_WAIT_L(0); PG8_BAR; PG8_MMA(1, 0, At, B0); PG8_MMA(1, 1, At, B1); PG8_BAR; PG8_SCHED;
            PG8_LDB(B0, 1, 0); PG8_LDB(B1, 1, 1); PG8_SCHED; PG8_LDA(At, 1, 0); PG8_STAGE_A(PG8_SA(0, 1), a2, 1, last);
            PG8_WAIT_V(8); PG8_WAIT_L(0); PG8_BAR; PG8_MMA(0, 0, At, B0); PG8_MMA(0, 1, At, B1); PG8_BAR; PG8_SCHED;
            PG8_LDA(At, 1, 1); PG8_STAGE_BW(PG8_SB(1, 0), b3, voffB); PG8_STAGE_BW(PG8_SB(1, 1), b3 + hstep, voffB); PG8_STAGE_A(PG8_SA(1, 0), a3, 0, last);
            PG8_WAIT_V(8); PG8_WAIT_L(0); PG8_BAR; PG8_MMA(1, 0, At, B0); PG8_MMA(1, 1, At, B1); PG8_BAR; PG8_SCHED;
            } else {
            PG8_LDB(B0, 0, 0); PG8_SCHED; PG8_LDA(At, 0, 0); PG8_STAGE_A(PG8_SA(1, 1), a1, 1, false);
            PG8_WAIT_L(8); PG8_BAR; PG8_WAIT_L(0); PG8_MMA(0, 0, At, B0); PG8_BAR; PG8_SCHED;
            PG8_LDB(B1, 0, 1); PG8_STAGE_BW(PG8_SB(0, 0), b2, voffB);
            PG8_BAR; PG8_WAIT_L(0); PG8_MMA(0, 1, At, B1); PG8_BAR;
            PG8_LDA(At, 0, 1); PG8_STAGE_A(PG8_SA(0, 0), a2, 0, last);
            PG8_BAR; PG8_WAIT_L(0); PG8_MMA(1, 0, At, B0); PG8_BAR; PG8_SCHED;
            PG8_STAGE_BW(PG8_SB(0, 1), b2 + hstep, voffB);
            PG8_WAIT_V(6); PG8_BAR; PG8_MMA(1, 1, At, B1); PG8_BAR;
            PG8_LDB(B0, 1, 0); PG8_SCHED; PG8_LDA(At, 1, 0); PG8_STAGE_A(PG8_SA(0, 1), a2, 1, last);
            PG8_WAIT_L(8); PG8_BAR; PG8_WAIT_L(0); PG8_MMA(0, 0, At, B0); PG8_BAR; PG8_SCHED;
            PG8_LDB(B1, 1, 1); PG8_STAGE_BW(PG8_SB(1, 0), b3, voffB);
            PG8_BAR; PG8_WAIT_L(0); PG8_MMA(0, 1, At, B1); PG8_BAR;
            PG8_LDA(At, 1, 1); PG8_STAGE_A(PG8_SA(1, 0), a3, 0, last);
            PG8_BAR; PG8_WAIT_L(0); PG8_MMA(1, 0, At, B0); PG8_BAR; PG8_SCHED;
            PG8_STAGE_BW(PG8_SB(1, 1), b3 + hstep, voffB);
            PG8_WAIT_V(6); PG8_BAR; PG8_MMA(1, 1, At, B1); PG8_BAR;
            }
        }
        if constexpr (ALIGN_EPI) { if (wr == 0) PG8_BAR; }
        if constexpr (!Epi::AFTER_DRAIN) { E(acc, cur, wr, wc, fr, fq); S.done(cur); }
        if (!has_next) break;
#pragma unroll
        for (int a = 0; a < 2; ++a)
#pragma unroll
            for (int b = 0; b < 2; ++b)
#pragma unroll
                for (int m = 0; m < 4; ++m)
#pragma unroll
                    for (int n = 0; n < 2; ++n) acc[a][b][m][n] = (f32x4){0.f, 0.f, 0.f, 0.f};
        cur = nxt; cA = nA; cB = nB; ++ui;
        if constexpr (Sched::GATHER) { vGc[0][0] = vGn[0][0]; vGc[0][1] = vGn[0][1]; vGc[1][0] = vGn[1][0]; vGc[1][1] = vGn[1][1]; }
        if constexpr (ALIGN_EPI) { if (wr == 1) PG8_BAR; }
    }
    PG8_WAIT_V(0);
    if constexpr (!ALIGN_EPI) { if (wr == 0) PG8_BAR; }
    PG8_BAR;
    if constexpr (Epi::AFTER_DRAIN) { E.fused(acc, cur, wr, wc, fr, fq, lds, wid, lane); S.done(cur); }
#undef PG8_SA
#undef PG8_SB
#undef PG8_STAGE
#undef PG8_STAGE_BW
#undef PG8_STAGE_A
#undef PG8_LDA
#undef PG8_LDB
#undef PG8_MMA
#undef PG8_WAIT_V
#undef PG8_WAIT_L
#undef PG8_BAR
#undef PG8_SCHED
}
}
#ifndef PG8_SP2
#define PG8_SP2 true
#endif
#ifndef PG8_ALIGN
#define PG8_ALIGN true
#endif
constexpr int NWAVES = 8, NTHR = 512;
constexpr int BATCH = 8, SEQ = 2048, DM = 2048, T = BATCH * SEQ;
constexpr int HA = 16, DKA = 128, CHUNK = 64;
constexpr int HB = 16, GKV = 4, RG = 4, DH = 128;
constexpr int NCMP = 127, NSLC = 32, WIN = 512;
constexpr int NEXP = 32, TOPK = 4, DFF = 2048;
constexpr int DIN = 17488, NP = 17664;
constexpr int C_QA = 0, C_KA = 2048, C_VA = 4096, C_ZA = 6144, C_QB = 8192, C_KC = 10240, C_VC = 10752, C_KS = 11264, C_VS = 11776,
              C_KW = 12288, C_VW = 12800, C_GM = 13312, C_AA = 17408, C_BA = 17424, C_GB = 17440;
constexpr unsigned long long ROTMASK = (0x3FFull << 32) | (3ull << 44) | (3ull << 48);
constexpr float EPS = 1e-6f;
constexpr int MOE_ROWS = T * TOPK + NEXP * 256;

constexpr size_t MiB = 1u << 20;
constexpr size_t WS_CTL = 0, CTL_ZERO_BYTES = 1 * MiB;
constexpr size_t WS_RC = 1 * MiB, WS_RS = 2 * MiB, WS_G = 3 * MiB, WS_BETA = 4 * MiB, WS_KCMP = 5 * MiB, WS_VCMP = 7 * MiB, WS_SEL = 9 * MiB;
constexpr size_t WS_TOPE = 10 * MiB, WS_TOPW = WS_TOPE + 256 * 1024, WS_POS = WS_TOPW + 256 * 1024, WS_DEST = WS_POS + 256 * 1024;
constexpr size_t WS_WINT = 16 * MiB, WS_WPA = 85 * MiB, WS_WPB = 93 * MiB, WS_WOT = 101 * MiB;
constexpr size_t WS_H = 112 * MiB, WS_OWB = 112 * MiB, WS_OB = 176 * MiB, WS_P = 240 * MiB;
constexpr size_t WS_OSB = 792 * MiB, WS_OA = 856 * MiB, WS_M1 = 920 * MiB, WS_MERGED = 984 * MiB, WS_OCB = 1112 * MiB;
constexpr size_t WS_WGU = 1280 * MiB, WS_WD = 1792 * MiB, WS_END = 2048 * MiB;
constexpr size_t WS_X1 = 240 * MiB, WS_HN = 368 * MiB, WS_XG = 432 * MiB, WS_ACT = 720 * MiB, WS_Y = 432 * MiB;
static_assert(WS_P + (size_t)T * NP * 2 <= WS_OSB && WS_ACT + (size_t)MOE_ROWS * DFF * 2 <= WS_WGU && WS_WINT + (size_t)NP * DM * 2 <= WS_WPA, "ws map");
constexpr int CW_BAR = 4096;
constexpr int CW_CNT = 2048;
constexpr int CW_CQ = 2304;

constexpr int RING_OFF = 0, RING_BYTES = 131072;
constexpr int XTRA_OFF = RING_BYTES;
constexpr int TAB_OFF = 145920;
constexpr int MISC_OFF = 146944;
constexpr int LDS_BYTES = 147456;

#define GAS __attribute__((address_space(1)))
#define LAS __attribute__((address_space(3)))
typedef unsigned short bf16;
typedef unsigned v4u __attribute__((ext_vector_type(4)));
typedef unsigned v2u __attribute__((ext_vector_type(2)));
typedef float f32x4 __attribute__((ext_vector_type(4)));
typedef short bf16x8 __attribute__((ext_vector_type(8)));
#define LDS_WAIT() asm volatile("s_waitcnt lgkmcnt(0)" ::: "memory")
#define VM_WAIT() asm volatile("s_waitcnt vmcnt(0)" ::: "memory")
__device__ __forceinline__ unsigned f2bf(float f) { unsigned u = __builtin_bit_cast(unsigned, f); return (u + 0x7fffu + ((u >> 16) & 1u)) >> 16; }
__device__ __forceinline__ unsigned pk2(float lo, float hi) { return f2bf(lo) | (f2bf(hi) << 16); }
__device__ __forceinline__ float bf2f(unsigned short b) { return __builtin_bit_cast(float, ((unsigned)b) << 16); }
__device__ __forceinline__ float bflo(unsigned w) { return __builtin_bit_cast(float, w << 16); }
__device__ __forceinline__ float bfhi(unsigned w) { return __builtin_bit_cast(float, w & 0xffff0000u); }
__device__ __forceinline__ float sigmoidf_(float x) { return __builtin_amdgcn_rcpf(1.f + __expf(-x)); }
__device__ __forceinline__ float wave_sum(float v) {
#pragma unroll
    for (int o = 1; o < 64; o <<= 1) v += __shfl_xor(v, o);
    return v;
}
__device__ __forceinline__ float wave_max(float v) {
#pragma unroll
    for (int o = 1; o < 64; o <<= 1) v = fmaxf(v, __shfl_xor(v, o));
    return v;
}
#define XB_TMO      128
#define XB_XCNT(j)  (256  + 64 * (j))
#define XB_XSUB(j)  (1280 + 64 * (j))
#define XB_XGEN(j)  (2304 + 64 * (j))
#define XB_TOP      3328
#define XB_TOPGEN   3392
#define XCD_BAR_WORDS 3456
#define XB_SPIN_CAP (1u << 18)

__device__ __forceinline__ unsigned xb_ld(unsigned* p)              { return __hip_atomic_load(p, __ATOMIC_RELAXED, __HIP_MEMORY_SCOPE_AGENT); }
__device__ __forceinline__ unsigned xb_add(unsigned* p, unsigned v) { return __hip_atomic_fetch_add(p, v, __ATOMIC_RELAXED, __HIP_MEMORY_SCOPE_AGENT); }
__device__ __forceinline__ unsigned xb_xcc_id() { return (unsigned)__builtin_amdgcn_s_getreg((3 << 11) | 20) & 0xFu; }
#define XB_SPIN(cond, bar) do { unsigned _sp = 0; while (cond) { __builtin_amdgcn_s_sleep(1); \
    if ((++_sp & 255u) == 0u) { if (xb_ld(&(bar)[XB_TMO])) break; if (_sp > XB_SPIN_CAP) { atomicAdd(&(bar)[XB_TMO], 1u); break; } } } } while (0)

struct XcdBarrier {
    unsigned* bar; unsigned x;
    volatile LAS unsigned* st;
};

__device__ __forceinline__ XcdBarrier xcd_barrier_post(unsigned* bar, volatile LAS unsigned* st) {
    XcdBarrier b; b.bar = bar; b.x = xb_xcc_id(); b.st = st;
    if (threadIdx.x == 0) (void)xb_add(&bar[XB_XCNT(b.x)], 1u);
    return b;
}
__device__ __forceinline__ void xcd_barrier_complete(unsigned* bar, unsigned x, unsigned& nloc, unsigned& nx) {
    const unsigned G = gridDim.x * gridDim.y * gridDim.z;
    unsigned sum, cnt, mine, sp = 0u;
    for (;;) {
        sum = 0u; cnt = 0u; mine = 0u;
#pragma unroll
        for (unsigned j = 0; j < 16; ++j) { const unsigned c = xb_ld(&bar[XB_XCNT(j)]); sum += c; cnt += (c > 0u) ? 1u : 0u; mine = (j == x) ? c : mine; }
        if (sum == G) break;
        __builtin_amdgcn_s_sleep(1);
        if ((++sp & 255u) == 0u) { if (xb_ld(&bar[XB_TMO])) break; if (sp > XB_SPIN_CAP) { atomicAdd(&bar[XB_TMO], 1u); break; } }
    }
    nloc = mine > 0u ? mine : 1u; nx = cnt > 0u ? cnt : 1u;
}

__device__ __forceinline__ void xcd_barrier(const XcdBarrier& b) {
    asm volatile("s_waitcnt vmcnt(0)" ::: "memory");
    __syncthreads();
    if (threadIdx.x == 0) {
        unsigned* bar = b.bar;
        __builtin_amdgcn_s_waitcnt(0);
        unsigned nloc = b.st[0], nx = b.st[1];
        if (nloc == 0u) { xcd_barrier_complete(bar, b.x, nloc, nx); b.st[0] = nloc; b.st[1] = nx; }
        const unsigned old = xb_add(&bar[XB_XSUB(b.x)], 1u);
        const unsigned gen = old / nloc;
        if (old + 1u == (gen + 1u) * nloc) {
            __builtin_amdgcn_fence(__ATOMIC_RELEASE, "agent");
            asm volatile("s_waitcnt vmcnt(0)" ::: "memory");
            const unsigned og = xb_add(&bar[XB_TOP], 1u);
            const unsigned tg = og / nx;
            if (og + 1u == (tg + 1u) * nx) xb_add(&bar[XB_TOPGEN], 1u);
            else XB_SPIN(xb_ld(&bar[XB_TOPGEN]) == tg, bar);
            __builtin_amdgcn_fence(__ATOMIC_ACQUIRE, "agent");
            xb_add(&bar[XB_XGEN(b.x)], 1u);
            asm volatile("s_waitcnt vmcnt(0)" ::: "memory");
        } else {
            XB_SPIN(xb_ld(&bar[XB_XGEN(b.x)]) == gen, bar);
            __builtin_amdgcn_fence(__ATOMIC_ACQUIRE, "agent");
            asm volatile("s_waitcnt vmcnt(0)" ::: "memory");
        }
    }
    __syncthreads();
}

#define WT_RSRC(p) __builtin_amdgcn_make_buffer_rsrc((void*)(p), 0, 0x7FFFFFFF, 0x00020000)
#define WT_ST16(rsrc, byteoff, v) __builtin_amdgcn_raw_buffer_store_b128((v), (rsrc), (int)(byteoff), 0, 16)
typedef unsigned u32x2w __attribute__((ext_vector_type(2)));
#define WT_ST8(rsrc, byteoff, v) __builtin_amdgcn_raw_buffer_store_b64((v), (rsrc), (int)(byteoff), 0, 16)
using pg8::Unit; using pg8::cvt_pk_bf16;
typedef pg8::u32x4 u32x4;
struct EpiP1 {
    static constexpr bool PERM = true, AFTER_DRAIN = false;
    bf16* P; const float* rc; const float* rs;
    __device__ __forceinline__ void operator()(const f32x4 (&acc)[2][2][4][2], const Unit& u, int wr, int wc, int fr, int fq) const {
        const int row0 = u.pm * 256 + wr * 64 + fr, col0 = u.pn * 256 + wc * 32 + 8 * fq;
        const bool rot = (u.pn < 64) && ((ROTMASK >> u.pn) & 1ull) && (wc == 0);
        const float sgn = fq < 2 ? -1.f : 1.f;
#pragma unroll
        for (int ai = 0; ai < 2; ++ai)
#pragma unroll
            for (int m = 0; m < 4; ++m) {
                const int row = row0 + ai * 128 + m * 16;
                f32x4 c0 = {1.f, 1.f, 1.f, 1.f}, c1 = c0, s0 = {0.f, 0.f, 0.f, 0.f}, s1 = s0;
                if (rot) { const float* pc = rc + (size_t)row * 16 + 8 * (fq & 1); const float* ps = rs + (size_t)row * 16 + 8 * (fq & 1);
                    c0 = *(const f32x4*)pc; c1 = *(const f32x4*)(pc + 4); s0 = *(const f32x4*)ps; s1 = *(const f32x4*)(ps + 4); }
#pragma unroll
                for (int bj = 0; bj < 2; ++bj) {
                    f32x4 v0 = acc[ai][bj][m][0], v1 = acc[ai][bj][m][1];
                    if (rot) {
#pragma unroll
                        for (int j = 0; j < 4; ++j) { const float p0 = __shfl_xor(v0[j], 32), p1 = __shfl_xor(v1[j], 32);
                            v0[j] = v0[j] * c0[j] + sgn * p0 * s0[j]; v1[j] = v1[j] * c1[j] + sgn * p1 * s1[j]; }
                    }
                    u32x4 w; w.x = cvt_pk_bf16(v0[0], v0[1]); w.y = cvt_pk_bf16(v0[2], v0[3]); w.z = cvt_pk_bf16(v1[0], v1[1]); w.w = cvt_pk_bf16(v1[2], v1[3]);
                    *(u32x4*)(P + (size_t)row * NP + col0 + bj * 128) = w;
                }
            }
    }
};
template <int WHICH> struct EpiProj {
    static constexpr bool PERM = true, AFTER_DRAIN = false;
    const bf16* P; bf16* M1; bf16* MG;
    __device__ __forceinline__ void operator()(const f32x4 (&acc)[2][2][4][2], const Unit& u, int wr, int wc, int fr, int fq) const {
        const int row0 = u.pm * 256 + wr * 64 + fr, col0 = u.pn * 256 + wc * 32 + 8 * fq;
#pragma unroll
        for (int ai = 0; ai < 2; ++ai)
#pragma unroll
            for (int m = 0; m < 4; ++m) {
                const int row = row0 + ai * 128 + m * 16;
#pragma unroll
                for (int bj = 0; bj < 2; ++bj) {
                    const int col = col0 + bj * 128;
                    const u32x4 gw = *(const u32x4*)(P + (size_t)row * NP + C_GM + WHICH * DM + col);
                    const f32x4 v0 = acc[ai][bj][m][0], v1 = acc[ai][bj][m][1];
                    float o[8];
                    o[0] = v0[0] * sigmoidf_(bflo(gw.x)); o[1] = v0[1] * sigmoidf_(bfhi(gw.x)); o[2] = v0[2] * sigmoidf_(bflo(gw.y)); o[3] = v0[3] * sigmoidf_(bfhi(gw.y));
                    o[4] = v1[0] * sigmoidf_(bflo(gw.z)); o[5] = v1[1] * sigmoidf_(bfhi(gw.z)); o[6] = v1[2] * sigmoidf_(bflo(gw.w)); o[7] = v1[3] * sigmoidf_(bfhi(gw.w));
                    if (WHICH == 1) { const u32x4 pw = *(const u32x4*)(M1 + (size_t)row * DM + col);
                        o[0] += bflo(pw.x); o[1] += bfhi(pw.x); o[2] += bflo(pw.y); o[3] += bfhi(pw.y); o[4] += bflo(pw.z); o[5] += bfhi(pw.z); o[6] += bflo(pw.w); o[7] += bfhi(pw.w); }
                    u32x4 w; w.x = cvt_pk_bf16(o[0], o[1]); w.y = cvt_pk_bf16(o[2], o[3]); w.z = cvt_pk_bf16(o[4], o[5]); w.w = cvt_pk_bf16(o[6], o[7]);
                    *(u32x4*)((WHICH == 0 ? M1 : MG) + (size_t)row * DM + col) = w;
                }
            }
    }
};
struct EpiOut {
    static constexpr bool PERM = false, AFTER_DRAIN = false;
    const float* X; float* X1; bf16* HNp; const float* gain;
    __device__ __forceinline__ void operator()(const f32x4 (&acc)[2][2][4][2], const Unit& u, int wr, int wc, int fr, int fq) const {
        const int row0 = u.pm * 256 + wr * 64 + fr, col0 = u.pn * 256 + wc * 32 + 4 * fq;
        f32x4 gv[2][2];
#pragma unroll
        for (int bj = 0; bj < 2; ++bj)
#pragma unroll
            for (int n = 0; n < 2; ++n) gv[bj][n] = *(const f32x4*)(gain + col0 + bj * 128 + n * 16);
#pragma unroll
        for (int ai = 0; ai < 2; ++ai)
#pragma unroll
            for (int m = 0; m < 4; ++m) { const size_t ro = (size_t)(row0 + ai * 128 + m * 16) * DM + col0;
#pragma unroll
                for (int bj = 0; bj < 2; ++bj)
#pragma unroll
                    for (int n = 0; n < 2; ++n) { const f32x4 xv = *(const f32x4*)(X + ro + bj * 128 + n * 16); const f32x4 y = acc[ai][bj][m][n] + xv;
                        *(f32x4*)(X1 + ro + bj * 128 + n * 16) = y;
                        v2u o; o.x = cvt_pk_bf16(y[0] * gv[bj][n][0], y[1] * gv[bj][n][1]); o.y = cvt_pk_bf16(y[2] * gv[bj][n][2], y[3] * gv[bj][n][3]);
                        *(v2u*)(HNp + ro + bj * 128 + n * 16) = o; } }
    }
};
struct EpiMoe1 {
    static constexpr bool PERM = true, AFTER_DRAIN = false;
    bf16* ACT; const float* bg; const float* bu;
    __device__ __forceinline__ void operator()(const f32x4 (&acc)[2][2][4][2], const Unit& u, int wr, int wc, int fr, int fq) const {
        const int e = u.pn >> 4, tn = u.pn & 15;
        const int row0 = u.pm * 256 + wr * 64 + fr, col = tn * 128 + wc * 32 + 8 * fq;
        const f32x4 bg0 = *(const f32x4*)(bg + (size_t)e * DFF + col), bg1 = *(const f32x4*)(bg + (size_t)e * DFF + col + 4);
        const f32x4 bu0 = *(const f32x4*)(bu + (size_t)e * DFF + col), bu1 = *(const f32x4*)(bu + (size_t)e * DFF + col + 4);
#pragma unroll
        for (int ai = 0; ai < 2; ++ai)
#pragma unroll
            for (int m = 0; m < 4; ++m) {
                const int row = row0 + ai * 128 + m * 16;
                float o[8];
#pragma unroll
                for (int j = 0; j < 4; ++j) {
                    float g0 = fminf(acc[ai][0][m][0][j] + bg0[j], 7.f), g1 = fminf(acc[ai][0][m][1][j] + bg1[j], 7.f);
                    float u0 = fminf(fmaxf(acc[ai][1][m][0][j] + bu0[j], -7.f), 7.f), u1 = fminf(fmaxf(acc[ai][1][m][1][j] + bu1[j], -7.f), 7.f);
                    o[j] = (u0 + 1.f) * g0 * sigmoidf_(1.702f * g0); o[4 + j] = (u1 + 1.f) * g1 * sigmoidf_(1.702f * g1);
                }
                u32x4 w; w.x = cvt_pk_bf16(o[0], o[1]); w.y = cvt_pk_bf16(o[2], o[3]); w.z = cvt_pk_bf16(o[4], o[5]); w.w = cvt_pk_bf16(o[6], o[7]);
                *(u32x4*)(ACT + (size_t)row * DFF + col) = w;
            }
    }
};
struct EpiMoe2 {
    static constexpr bool PERM = true, AFTER_DRAIN = false;
    bf16* Y; const float* bd;
    __device__ __forceinline__ void operator()(const f32x4 (&acc)[2][2][4][2], const Unit& u, int wr, int wc, int fr, int fq) const {
        const int e = u.pn >> 3, tn = u.pn & 7;
        const int row0 = u.pm * 256 + wr * 64 + fr, col0 = tn * 256 + wc * 32 + 8 * fq;
#pragma unroll
        for (int bj = 0; bj < 2; ++bj) {
            const int col = col0 + bj * 128;
            const f32x4 b0 = *(const f32x4*)(bd + (size_t)e * DM + col), b1 = *(const f32x4*)(bd + (size_t)e * DM + col + 4);
#pragma unroll
            for (int ai = 0; ai < 2; ++ai)
#pragma unroll
                for (int m = 0; m < 4; ++m) {
                    const int row = row0 + ai * 128 + m * 16;
                    const f32x4 v0 = acc[ai][bj][m][0] + b0, v1 = acc[ai][bj][m][1] + b1;
                    u32x4 w; w.x = cvt_pk_bf16(v0[0], v0[1]); w.y = cvt_pk_bf16(v0[2], v0[3]); w.z = cvt_pk_bf16(v1[0], v1[1]); w.w = cvt_pk_bf16(v1[2], v1[3]);
                    *(u32x4*)(Y + (size_t)row * DM + col) = w;
                }
        }
    }
};
template <bool GATHERED> struct MoeOrder {
    static constexpr bool GATHER = GATHERED;
#ifndef MOE_B_AUX
#define MOE_B_AUX 0
#endif
    static constexpr int B_AUX = MOE_B_AUX;
    const LAS int* tab; int ntn, G, c, total; const int* list;
    __device__ __forceinline__ bool next(int i, Unit& u) const {
        const long L = (long)i * G + c; if (L >= total) return false;
        int id = (int)L; { const int q = total / 8, r = total % 8, xcd = id % 8, off = id / 8; id = (xcd < r ? xcd * (q + 1) : r * (q + 1) + (xcd - r) * q) + off; }
        int e = 0;
#pragma unroll 1
        for (int k = 1; k < NEXP; ++k) e = (id >= tab[k]) ? k : e;
        const int local = id - tab[e], mte = tab[64 + e];
        u.pm = tab[128 + e] + local % mte; u.pn = e * ntn + local / mte; return true;
    }
    __device__ __forceinline__ bool upper_half_empty(const Unit& u) const { const int e = u.pn / ntn; return tab[96 + e] - (u.pm - tab[128 + e]) * 256 <= 128; }
    __device__ __forceinline__ unsigned row_of(const Unit& u, int r) const {
        const int e = u.pn / ntn, rr = (u.pm - tab[128 + e]) * 256 + r;
        return rr < tab[96 + e] ? (unsigned)list[(size_t)e * T + rr] : 0u;
    }
    __device__ __forceinline__ void a_ready(const Unit&) const {}
    __device__ __forceinline__ void done(const Unit&) const {}
};
struct Args { const void* in[27]; float* out; unsigned char* ws; int ph_lo, ph_hi, li, pad; };
struct Ctx {
    LAS unsigned char* lds; int tid, lane, wave, G, bid; const Args* A; float* out; unsigned char* ws; unsigned* ctl;
};
#define WSP(type, off) ((type*)(C.ws + (off)))
__device__ __forceinline__ unsigned cvtpk_c(float lo, float hi) { typedef float f2 __attribute__((ext_vector_type(2))); typedef __bf16 b2 __attribute__((ext_vector_type(2))); f2 v = {lo, hi}; b2 b = __builtin_convertvector(v, b2); return __builtin_bit_cast(unsigned, b); }

struct TrRegs { f32x4 v[16]; };
__device__ __forceinline__ void tr_load(TrRegs& R, const float* W, int ldw, int k0, int src, int lane) {
    const int kr = lane >> 4;
#pragma unroll
    for (int i = 0; i < 16; ++i) R.v[i] = src >= 0 ? __builtin_nontemporal_load((const f32x4*)(W + (size_t)(k0 + 4 * i + kr) * ldw + src)) : (f32x4){0.f, 0.f, 0.f, 0.f};
}
__device__ __forceinline__ void tr_store(const TrRegs& R, bf16* WT, int K, int k0, int n0, LAS float* scr, int lane) {
    const int c4 = 4 * (lane & 15), kr = lane >> 4;
#pragma unroll
    for (int i = 0; i < 16; ++i) { LAS float* d = scr + (4 * i + kr) * 65 + c4; d[0] = R.v[i].x; d[1] = R.v[i].y; d[2] = R.v[i].z; d[3] = R.v[i].w; }
    LDS_WAIT(); asm volatile("" ::: "memory");
    const int c = lane & 7;
#pragma unroll
    for (int j = 0; j < 8; ++j) { const int n = (lane >> 3) + 8 * j; const LAS float* s = scr + (8 * c) * 65 + n;
        v4u o; o.x = cvtpk_c(s[0 * 65], s[1 * 65]); o.y = cvtpk_c(s[2 * 65], s[3 * 65]); o.z = cvtpk_c(s[4 * 65], s[5 * 65]); o.w = cvtpk_c(s[6 * 65], s[7 * 65]);
        __builtin_nontemporal_store(o, (v4u*)(WT + (size_t)(n0 + n) * K + k0 + 8 * c)); }
    LDS_WAIT(); asm volatile("" ::: "memory");
}
struct MapId { __device__ __forceinline__ int operator()(int n) const { return n; } };
struct MapIn { __device__ __forceinline__ int operator()(int r) const {
    return r < 8192 ? r : r < 13312 ? r + 32 : r < 17408 ? r + 80 : r < 17440 ? 8192 + (r - 17408) : r < 17488 ? 13344 + (r - 17440) : -1; } };
template <class Map>
__device__ __forceinline__ void tr_matrix(const Ctx& C, const float* W, int ldw, int K, int Nd, bf16* WT, Map map) {
    LAS float* scr = (LAS float*)(C.lds + C.wave * 16640);
    const int gw = C.bid * NWAVES + C.wave, NGW = C.G * NWAVES, nblk = Nd / 64, nit = nblk * (K / 64), lane = C.lane;
    TrRegs R; int it = gw;
    if (it < nit) tr_load(R, W, ldw, 64 * (it / nblk), map(64 * (it % nblk) + 4 * (lane & 15)), lane);
    while (it < nit) { const int nx = it + NGW; TrRegs N;
        if (nx < nit) tr_load(N, W, ldw, 64 * (nx / nblk), map(64 * (nx % nblk) + 4 * (lane & 15)), lane);
        tr_store(R, WT, K, 64 * (it / nblk), 64 * (it % nblk), scr, lane);
        R = N; it = nx; }
}
__device__ __forceinline__ void rms_row_bf16(const float* xrow, const float* gain, bf16* orow, int lane) {
    f32x4 v[8]; float s = 0.f;
#pragma unroll
    for (int j = 0; j < 8; ++j) { v[j] = *(const f32x4*)(xrow + 4 * lane + 256 * j); s += (v[j].x * v[j].x + v[j].y * v[j].y) + (v[j].z * v[j].z + v[j].w * v[j].w); }
    const float r = __builtin_amdgcn_rsqf(wave_sum(s) * (1.f / DM) + EPS);
#pragma unroll
    for (int j = 0; j < 8; ++j) { const f32x4 g = *(const f32x4*)(gain + 4 * lane + 256 * j);
        v2u o; o.x = pk2(v[j].x * r * g.x, v[j].y * r * g.y); o.y = pk2(v[j].z * r * g.z, v[j].w * r * g.w);
        *(v2u*)(orow + 4 * lane + 256 * j) = o; }
}
__device__ __forceinline__ void p0_prologue(const Ctx& C) {
    { LAS float* scr = (LAS float*)(C.lds + C.wave * 16640);
      const int gw0 = C.bid * NWAVES + C.wave, NGW0 = C.G * NWAVES, lane = C.lane;
      constexpr int N_IN = (NP / 64) * (DM / 64), N_PJ = (DM / 64) * (DM / 64), N_W1 = 0  , N_W2 = 2 * 2, NALL = N_IN + 3 * N_PJ + 2 * N_W1 + 2 * N_W2;
#define P0_DECODE(it_) int i_ = (it_); const float* W_; bf16* WT_; int ldw_, K_, nblk_; bool isin_ = false; \
      if (i_ < N_IN) { W_ = (const float*)C.A->in[3]; WT_ = WSP(bf16, WS_WINT); ldw_ = DIN; K_ = DM; nblk_ = NP / 64; isin_ = true; } \
      else if ((i_ -= N_IN) < 3 * N_PJ) { const int w_ = i_ / N_PJ; i_ -= w_ * N_PJ; W_ = (const float*)C.A->in[14 + w_]; WT_ = WSP(bf16, WS_WPA) + (size_t)w_ * DM * DM; ldw_ = DM; K_ = DM; nblk_ = DM / 64; } \
      else { i_ -= 3 * N_PJ; const int w_ = i_ / N_W2; i_ -= w_ * N_W2; W_ = (const float*)C.A->in[w_ ? 13 : 10]; WT_ = (bf16*)(C.ws + 111 * MiB + w_ * 65536); ldw_ = 128; K_ = 128; nblk_ = 2; } \
      const int k0_ = 64 * (i_ / nblk_), n0_ = 64 * (i_ % nblk_);
      TrRegs R; int it = gw0;
      if (it < NALL) { P0_DECODE(it); const int d_ = n0_ + 4 * (lane & 15); tr_load(R, W_, ldw_, k0_, isin_ ? MapIn()(d_) : d_, lane); }
      while (it < NALL) { const int nx = it + NGW0; TrRegs N;
          if (nx < NALL) { P0_DECODE(nx); const int d_ = n0_ + 4 * (lane & 15); tr_load(N, W_, ldw_, k0_, isin_ ? MapIn()(d_) : d_, lane); }
          { P0_DECODE(it); (void)W_; (void)ldw_; (void)isin_; tr_store(R, WT_, K_, k0_, n0_, scr, lane); }
          R = N; it = nx; }
#undef P0_DECODE
    }
    const int gw = C.bid * NWAVES + C.wave, NGW = C.G * NWAVES;
    for (int m = gw; m < T; m += NGW) rms_row_bf16(((const float*)C.A->in[0]) + (size_t)m * DM, ((const float*)C.A->in[2]), WSP(bf16, WS_H) + (size_t)m * DM, C.lane);
    for (int i = C.bid * NTHR + C.tid; i < 128 * 3 * 64; i += C.G * NTHR) { const int ks = i / 192, r_ = i % 192, nt = r_ >> 6, ln = r_ & 63, c = 32 * nt + (ln & 31);
        const int src = c < 32 ? 8192 + c : c < 80 ? 13344 + (c - 32) : -1;
        v4u o = {0u, 0u, 0u, 0u};
        if (src >= 0) { const float* w = (const float*)C.A->in[3] + (size_t)(16 * ks + 8 * (ln >> 5)) * DIN + src;
            o.x = cvtpk_c(w[0], w[DIN]); o.y = cvtpk_c(w[2 * (size_t)DIN], w[3 * (size_t)DIN]); o.z = cvtpk_c(w[4 * (size_t)DIN], w[5 * (size_t)DIN]); o.w = cvtpk_c(w[6 * (size_t)DIN], w[7 * (size_t)DIN]); }
        *(v4u*)(C.ws + 14 * MiB + (size_t)i * 16) = o; }
    for (int i = C.bid * NTHR + C.tid; i < 2 * 256 * 4 * 64; i += C.G * NTHR) { const int kv = i >> 16, r_ = i & 65535, ks = r_ >> 8, nt = (r_ >> 6) & 3, ln = r_ & 63;
        const float* w1 = (const float*)C.A->in[kv ? 12 : 9] + (size_t)(16 * ks + 8 * (ln >> 5)) * 128 + 32 * nt + (ln & 31);
        v4u o; o.x = cvtpk_c(w1[0], w1[128]); o.y = cvtpk_c(w1[256], w1[384]); o.z = cvtpk_c(w1[512], w1[640]); o.w = cvtpk_c(w1[768], w1[896]);
        *(v4u*)(C.ws + (109 + kv) * MiB + (size_t)r_ * 16) = o; }
    { bf16* WRH = WSP(bf16, 12 * MiB + 65536); bf16* WRL = WRH + 65536;
      for (int i = C.bid * NTHR + C.tid; i < NEXP * DM; i += C.G * NTHR) { const int e = i >> 11, k = i & 2047;
          const float w = ((const float*)C.A->in[17])[k] * ((const float*)C.A->in[18])[k * NEXP + e]; const unsigned hb = f2bf(w);
          WRH[i] = (bf16)hb; WRL[i] = (bf16)f2bf(w - bf2f((unsigned short)hb)); } }
    float* rc = WSP(float, WS_RC); float* rs = WSP(float, WS_RS);
    for (int i = C.bid * NTHR + C.tid; i < T * 16; i += C.G * NTHR) {
        const int m = i >> 4, f = i & 15; const float invf = exp2f(-(float)f * (18.931568569324174f / 16.f));
        const float ang = (float)((const int*)C.A->in[1])[m] * invf;
        double rev = (double)ang * 0.15915494309189535; rev -= rint(rev);
        const float rf = (float)rev; rc[i] = __builtin_amdgcn_cosf(rf); rs[i] = __builtin_amdgcn_sinf(rf);
    }
}
constexpr size_t WS_WSF = 14 * MiB;
__device__ __forceinline__ void small_proj(const Ctx& C) {
    const bf16* H = WSP(bf16, WS_H); const bf16* WF = WSP(bf16, WS_WSF); bf16* P = WSP(bf16, WS_P);
    typedef float f32x16s __attribute__((ext_vector_type(16)));
    for (int job = C.bid * NWAVES + C.wave; job < (T / 32) * 3; job += C.G * NWAVES) {
        int lane = C.lane; asm volatile("" : "+v"(lane));
        const int t = lane & 31, hf = lane >> 5, mt = job / 3, nt = job - 3 * mt;
        const bf16* ap = H + (size_t)(32 * mt + t) * DM + 8 * hf; const bf16* bp = WF + (size_t)nt * 512 + (size_t)lane * 8;
        f32x16s acc = {};
#pragma unroll 16
        for (int s2 = 0; s2 < 128; ++s2) acc = __builtin_amdgcn_mfma_f32_32x32x16_bf16(*(const bf16x8*)(ap + 16 * s2), *(const bf16x8*)(bp + (size_t)s2 * 1536), acc, 0, 0, 0);
        const int odd = t & 1; bf16* opl = P + (size_t)(32 * mt) * NP + 17408 + 32 * nt + t - odd;
#pragma unroll
        for (int i = 0; i < 16; i += 2) { const float va = acc[i], vb = acc[i + 1], x = __shfl_xor(odd ? va : vb, 1); const int row = (i & 3) + 8 * (i >> 2) + 4 * hf + odd;
            *(unsigned*)(opl + (size_t)row * NP) = odd ? cvtpk_c(x, vb) : cvtpk_c(va, x); }
    }
}
__device__ __forceinline__ void moe_weight_convert(const Ctx& C, int it0, int it1, int wv, int nwv) {
    LAS float* scr = (LAS float*)(C.lds + C.wave * 16640);
    if (wv < 0) return;
    const int gw = it0 + wv, NGW = nwv, lane = C.lane;
    bf16* WGU = WSP(bf16, WS_WGU); bf16* WD = WSP(bf16, WS_WD);
    const float* wg = (const float*)C.A->in[20]; const float* wu = (const float*)C.A->in[22]; const float* wd = (const float*)C.A->in[24];
    constexpr int NGU = NEXP * 64 * 32, NIT = NGU + NEXP * 32 * 32;
#define MOE_IT_LOAD(RR, it_) do { const int i_ = (it_); \
        if (i_ < NGU) { const int e = i_ >> 11, r = i_ & 2047, nb = r & 63, kb = r >> 6, n0 = nb * 64, which = (n0 >> 7) & 1, srcn = (n0 >> 8) * 128 + (n0 & 127) + 4 * (lane & 15); \
            tr_load(RR, (which ? wu : wg) + (size_t)e * DM * DFF, DFF, 64 * kb, srcn, lane); } \
        else { const int q_ = i_ - NGU, e = q_ >> 10, r = q_ & 1023, nb = r & 31, kb = r >> 5; tr_load(RR, wd + (size_t)e * DFF * DM, DM, 64 * kb, 64 * nb + 4 * (lane & 15), lane); } } while (0)
#define MOE_IT_STORE(RR, it_) do { const int i_ = (it_); \
        if (i_ < NGU) { const int e = i_ >> 11, r = i_ & 2047, nb = r & 63, kb = r >> 6; tr_store(RR, WGU + (size_t)e * 4096 * DM, DM, 64 * kb, nb * 64, scr, lane); } \
        else { const int q_ = i_ - NGU, e = q_ >> 10, r = q_ & 1023, nb = r & 31, kb = r >> 5; tr_store(RR, WD + (size_t)e * DM * DFF, DFF, 64 * kb, 64 * nb, scr, lane); } } while (0)
    const int NE = it1 < NIT ? it1 : NIT;
    TrRegs R; int it = gw;
    if (it < NE) MOE_IT_LOAD(R, it);
    while (it < NE) { const int nx = it + NGW; TrRegs N;
        if (nx < NE) MOE_IT_LOAD(N, nx);
        MOE_IT_STORE(R, it);
        R = N; it = nx; }
#undef MOE_IT_LOAD
#undef MOE_IT_STORE
}

constexpr size_t WS_RT = 12 * MiB + 524288;
constexpr size_t WS_WRH = 12 * MiB + 65536, WS_WRL = WS_WRH + 131072, WS_LIST = 13 * MiB;
typedef float f32x16r __attribute__((ext_vector_type(16)));
__device__ __forceinline__ void p7_norm_router(const Ctx& C) {
    if (C.wave >= 2) return;
    const float* X1 = WSP(float, WS_X1); bf16* HN = WSP(bf16, WS_HN);
    int* TOPE = WSP(int, WS_TOPE); float* TOPW = WSP(float, WS_TOPW); int* POS = WSP(int, WS_POS);
    const bf16* WRH = WSP(bf16, WS_WRH); const bf16* WRL = WSP(bf16, WS_WRL);
    unsigned* cnt = C.ctl + CW_CNT;
    LAS float* lg = (LAS float*)(C.lds + 133120 + C.wave * 4224);
    for (int tile = C.bid * 2 + C.wave; tile < T / 32; tile += C.G * 2) {
        int lane = C.lane; asm volatile("" : "+v"(lane));
        const int t = lane & 31, hf = lane >> 5, m0 = tile * 32;
        const float* xr = X1 + (size_t)(m0 + t) * DM + 8 * hf; const bf16* wh = WRH + (size_t)t * DM + 8 * hf; const bf16* wl = WRL + (size_t)t * DM + 8 * hf;
        f32x16r acc = {}; float ss = 0.f;
#pragma unroll 8
        for (int s = 0; s < 128; ++s) {
            const f32x4 xa = *(const f32x4*)(xr + 16 * s), xb = *(const f32x4*)(xr + 16 * s + 4);
            const bf16x8 bh = *(const bf16x8*)(wh + 16 * s), bl = *(const bf16x8*)(wl + 16 * s);
            ss += (xa.x * xa.x + xa.y * xa.y) + (xa.z * xa.z + xa.w * xa.w) + (xb.x * xb.x + xb.y * xb.y) + (xb.z * xb.z + xb.w * xb.w);
            v4u h; h.x = cvtpk_c(xa.x, xa.y); h.y = cvtpk_c(xa.z, xa.w); h.z = cvtpk_c(xb.x, xb.y); h.w = cvtpk_c(xb.z, xb.w);
            v4u l; l.x = cvtpk_c(xa.x - bflo(h.x), xa.y - bfhi(h.x)); l.y = cvtpk_c(xa.z - bflo(h.y), xa.w - bfhi(h.y)); l.z = cvtpk_c(xb.x - bflo(h.z), xb.y - bfhi(h.z)); l.w = cvtpk_c(xb.z - bflo(h.w), xb.w - bfhi(h.w));
            const bf16x8 ah = __builtin_bit_cast(bf16x8, h), al = __builtin_bit_cast(bf16x8, l);
            acc = __builtin_amdgcn_mfma_f32_32x32x16_bf16(ah, bh, acc, 0, 0, 0);
            acc = __builtin_amdgcn_mfma_f32_32x32x16_bf16(ah, bl, acc, 0, 0, 0);
            acc = __builtin_amdgcn_mfma_f32_32x32x16_bf16(al, bh, acc, 0, 0, 0);
        }
        ss += __shfl_xor(ss, 32);
        const float r = __builtin_amdgcn_rsqf(ss * (1.f / DM) + EPS);
        const float be = ((const float*)C.A->in[19])[t];
#pragma unroll
        for (int i = 0; i < 16; ++i) { const int tok = (i & 3) + 8 * (i >> 2) + 4 * hf; lg[tok * 33 + t] = acc[i] * __shfl(r, tok) + be; }
        LDS_WAIT();
        if (lane < 32) {
            float v[32];
#pragma unroll
            for (int e = 0; e < 32; ++e) v[e] = lg[lane * 33 + e];
            int te[4]; float tv[4];
#pragma unroll
            for (int k = 0; k < 4; ++k) { float best = -__builtin_inff(); int bi = 0;
#pragma unroll
                for (int e = 0; e < 32; ++e) if (v[e] > best) { best = v[e]; bi = e; }
                te[k] = bi; tv[k] = best;
#pragma unroll
                for (int e = 0; e < 32; ++e) if (e == bi) v[e] = -__builtin_inff(); }
            const float e1 = __expf(tv[1] - tv[0]), e2 = __expf(tv[2] - tv[0]), e3 = __expf(tv[3] - tv[0]), inv = 1.f / (1.f + e1 + e2 + e3);
            const int m = m0 + lane;
            const unsigned p0 = __hip_atomic_fetch_add(cnt + te[0], 1u, __ATOMIC_RELAXED, __HIP_MEMORY_SCOPE_AGENT), p1 = __hip_atomic_fetch_add(cnt + te[1], 1u, __ATOMIC_RELAXED, __HIP_MEMORY_SCOPE_AGENT);
            const unsigned p2 = __hip_atomic_fetch_add(cnt + te[2], 1u, __ATOMIC_RELAXED, __HIP_MEMORY_SCOPE_AGENT), p3 = __hip_atomic_fetch_add(cnt + te[3], 1u, __ATOMIC_RELAXED, __HIP_MEMORY_SCOPE_AGENT);
            *(int4*)(TOPE + m * 4) = make_int4(te[0], te[1], te[2], te[3]); *(float4*)(TOPW + m * 4) = make_float4(inv, e1 * inv, e2 * inv, e3 * inv); *(int4*)(POS + m * 4) = make_int4((int)p0, (int)p1, (int)p2, (int)p3);
        }
        if (lane < 32) WSP(float, WS_RT)[m0 + lane] = r;
        LDS_WAIT();
    }
}
__device__ __forceinline__ void moe_tables(const Ctx& C, int ntn, int& total) {
    LAS int* tab = (LAS int*)(C.lds + TAB_OFF);
    __syncthreads();
    if (C.tid == 0) { int up = 0, tb = 0;
        for (int e = 0; e < NEXP; ++e) { const int cn = (int)__hip_atomic_load(C.ctl + CW_CNT + e, __ATOMIC_RELAXED, __HIP_MEMORY_SCOPE_AGENT); const int mt = (cn + 255) >> 8;
            tab[e] = up; tab[64 + e] = mt; tab[96 + e] = cn; tab[128 + e] = tb; tab[192 + e] = tb * 256; up += mt * ntn; tb += mt; }
        tab[32] = up; }
    __syncthreads();
    total = tab[32];
}
__device__ __forceinline__ void p8_gather(const Ctx& C) {
    int total; moe_tables(C, 1, total);
    const LAS int* tab = (const LAS int*)(C.lds + TAB_OFF);
    const bf16* HN = WSP(bf16, WS_HN); bf16* XG = WSP(bf16, WS_XG);
    const int* TOPE = WSP(int, WS_TOPE); const int* POS = WSP(int, WS_POS);
    const int gw = C.bid * NWAVES + C.wave, NGW = C.G * NWAVES, lane = C.lane;
#pragma unroll 4
    for (int a = gw; a < T * TOPK; a += NGW) {
        const int m = a >> 2, e = TOPE[a], dest = tab[192 + e] + POS[a];
        const v4u* src = (const v4u*)(HN + (size_t)m * DM); v4u* dst = (v4u*)(XG + (size_t)dest * DM); const float rr = WSP(float, WS_RT)[m];
#pragma unroll
        for (int q = 0; q < 4; ++q) { const v4u w = src[lane + 64 * q]; v4u o;
            o.x = cvtpk_c(bflo(w.x) * rr, bfhi(w.x) * rr); o.y = cvtpk_c(bflo(w.y) * rr, bfhi(w.y) * rr); o.z = cvtpk_c(bflo(w.z) * rr, bfhi(w.z) * rr); o.w = cvtpk_c(bflo(w.w) * rr, bfhi(w.w) * rr);
            dst[lane + 64 * q] = o; }
    }
}
__device__ __forceinline__ void p11_final(const Ctx& C) {
    int total; moe_tables(C, 1, total); const LAS int* tab = (const LAS int*)(C.lds + TAB_OFF);
    const float* X1 = WSP(float, WS_X1); const bf16* Y = WSP(bf16, WS_Y); const int* TOPE = WSP(int, WS_TOPE); const int* POS = WSP(int, WS_POS); const float* TOPW = WSP(float, WS_TOPW);
    const int gw = C.bid * NWAVES + C.wave, NGW = C.G * NWAVES, lane = C.lane;
    for (int m = gw; m < T; m += NGW) {
        f32x4 v[8];
#pragma unroll
        for (int j = 0; j < 8; ++j) v[j] = *(const f32x4*)(X1 + (size_t)m * DM + 4 * lane + 256 * j);
#pragma unroll
        for (int k = 0; k < 4; ++k) { const float w = TOPW[m * 4 + k]; const bf16* yr = Y + (size_t)(tab[192 + TOPE[m * 4 + k]] + POS[m * 4 + k]) * DM;
#pragma unroll
            for (int j = 0; j < 8; ++j) { const v2u yw = *(const v2u*)(yr + 4 * lane + 256 * j);
                v[j].x += w * bflo(yw.x); v[j].y += w * bfhi(yw.x); v[j].z += w * bflo(yw.y); v[j].w += w * bfhi(yw.y); } }
        float s = 0.f;
#pragma unroll
        for (int j = 0; j < 8; ++j) s += (v[j].x * v[j].x + v[j].y * v[j].y) + (v[j].z * v[j].z + v[j].w * v[j].w);
        const float r = __builtin_amdgcn_rsqf(wave_sum(s) * (1.f / DM) + EPS);
#pragma unroll
        for (int j = 0; j < 8; ++j) { const f32x4 g = *(const f32x4*)(((const float*)C.A->in[26]) + 4 * lane + 256 * j);
            *(f32x4*)(C.out + (size_t)m * DM + 4 * lane + 256 * j) = (f32x4){v[j].x * r * g.x, v[j].y * r * g.y, v[j].z * r * g.z, v[j].w * r * g.w}; }
    }
}
constexpr size_t WS_REC = 792 * MiB, WS_VBC = 1048 * MiB, WS_EGL = 12 * MiB, WS_ORAWB = 1176 * MiB;
typedef float f32x16 __attribute__((ext_vector_type(16)));
typedef float f32x2_t __attribute__((ext_vector_type(2))); typedef __bf16 bf16x2_t __attribute__((ext_vector_type(2)));
__device__ __forceinline__ unsigned cvtpk(float lo, float hi) { f32x2_t v = {lo, hi}; bf16x2_t b = __builtin_convertvector(v, bf16x2_t); return __builtin_bit_cast(unsigned, b); }
__device__ __forceinline__ bf16x8 pack8f(const float* v) { v4u w = {cvtpk(v[0], v[1]), cvtpk(v[2], v[3]), cvtpk(v[4], v[5]), cvtpk(v[6], v[7])}; return __builtin_bit_cast(bf16x8, w); }
__device__ __forceinline__ int crow(int r, int hi) { return (r & 3) + 8 * (r >> 2) + 4 * hi; }
__device__ __forceinline__ void conv8(const bf16* P, const float* cw, int m, int sp, int col0, float (&y)[8]) {
#pragma unroll
    for (int j = 0; j < 8; ++j) y[j] = 0.f;
#pragma unroll
    for (int i = 0; i < 4; ++i) {
        if (sp - 3 + i >= 0) {
            const v4u w = *(const v4u*)(P + (size_t)(m - 3 + i) * NP + col0);
            const f32x4 c0 = *(const f32x4*)(cw + i * 6144 + col0), c1 = *(const f32x4*)(cw + i * 6144 + col0 + 4);
            y[0] += c0.x * bflo(w.x); y[1] += c0.y * bfhi(w.x); y[2] += c0.z * bflo(w.y); y[3] += c0.w * bfhi(w.y);
            y[4] += c1.x * bflo(w.z); y[5] += c1.y * bfhi(w.z); y[6] += c1.z * bflo(w.w); y[7] += c1.w * bfhi(w.w);
        }
    }
#pragma unroll
    for (int j = 0; j < 8; ++j) y[j] = y[j] * sigmoidf_(y[j]);
}
__device__ __forceinline__ void store_perm_frag(unsigned char* rec, int f, int lane16, const float* v) {
    v2u lo = {cvtpk(v[0], v[1]), cvtpk(v[2], v[3])}, hi = {cvtpk(v[4], v[5]), cvtpk(v[6], v[7])};
    const int o = (lane16 & 511) + ((lane16 >> 9) << 3);
    *(v2u*)(rec + (size_t)f * 1024 + o) = lo;
    *(v2u*)(rec + (size_t)f * 1024 + 512 + o) = hi;
}
template <class F>
__device__ __forceinline__ void conv_rows(const bf16* P, const float* cw, int m0, int sp0, int col0  , int lane, F f) {
    const int c16 = lane & 15, seg = lane >> 4, col = col0 + 8 * c16, row0 = 16 * seg;
    const bf16* pp = P + (size_t)(m0 + row0) * NP + col;
    const v4u z = {0u, 0u, 0u, 0u};
    v4u xa = (sp0 + row0 - 3 >= 0) ? *(const v4u*)(pp - 3 * (size_t)NP) : z, xb = (sp0 + row0 - 2 >= 0) ? *(const v4u*)(pp - 2 * (size_t)NP) : z, xc = (sp0 + row0 - 1 >= 0) ? *(const v4u*)(pp - (size_t)NP) : z;
    v4u xd = *(const v4u*)pp, xe = *(const v4u*)(pp + NP), xf = *(const v4u*)(pp + 2 * (size_t)NP);
    f32x4 w0[4], w1[4];
#pragma unroll
    for (int i = 0; i < 4; ++i) { w0[i] = *(const f32x4*)(cw + i * 6144 + col); w1[i] = *(const f32x4*)(cw + i * 6144 + col + 4); }
#pragma unroll 4
    for (int it = 0; it < 16; ++it) {
        const v4u xn = (it + 3 < 16) ? *(const v4u*)(pp + (size_t)(it + 3) * NP) : z;
        float y[8];
        y[0] = w0[0].x * bflo(xa.x) + w0[1].x * bflo(xb.x) + w0[2].x * bflo(xc.x) + w0[3].x * bflo(xd.x);
        y[1] = w0[0].y * bfhi(xa.x) + w0[1].y * bfhi(xb.x) + w0[2].y * bfhi(xc.x) + w0[3].y * bfhi(xd.x);
        y[2] = w0[0].z * bflo(xa.y) + w0[1].z * bflo(xb.y) + w0[2].z * bflo(xc.y) + w0[3].z * bflo(xd.y);
        y[3] = w0[0].w * bfhi(xa.y) + w0[1].w * bfhi(xb.y) + w0[2].w * bfhi(xc.y) + w0[3].w * bfhi(xd.y);
        y[4] = w1[0].x * bflo(xa.z) + w1[1].x * bflo(xb.z) + w1[2].x * bflo(xc.z) + w1[3].x * bflo(xd.z);
        y[5] = w1[0].y * bfhi(xa.z) + w1[1].y * bfhi(xb.z) + w1[2].y * bfhi(xc.z) + w1[3].y * bfhi(xd.z);
        y[6] = w1[0].z * bflo(xa.w) + w1[1].z * bflo(xb.w) + w1[2].z * bflo(xc.w) + w1[3].z * bflo(xd.w);
        y[7] = w1[0].w * bfhi(xa.w) + w1[1].w * bfhi(xb.w) + w1[2].w * bfhi(xc.w) + w1[3].w * bfhi(xd.w);
        float q = 0.f;
#pragma unroll
        for (int j = 0; j < 8; ++j) { y[j] = y[j] * sigmoidf_(y[j]); q += y[j] * y[j]; }
        q += __shfl_xor(q, 1); q += __shfl_xor(q, 2); q += __shfl_xor(q, 4); q += __shfl_xor(q, 8);
        f(row0 + it, c16, y, q);
        xa = xb; xb = xc; xc = xd; xd = xe; xe = xf; xf = xn; }
}
__device__ __forceinline__ int tile_off(int row, int chunk) { return row * 256 + ((chunk ^ (row & 15)) << 4); }
__device__ __forceinline__ void dn_chunk_prep(const Ctx& C, int u0, int ustride) {
    const bf16* P = WSP(bf16, WS_P); const float* cw = ((const float*)C.A->in[4]);
    LAS unsigned char* wl = C.lds + C.wave * 16384;
    LAS float* gcl = (LAS float*)(C.lds + XTRA_OFF + C.wave * 1024);
    LAS float* betal = gcl + 64; LAS float* ssl = gcl + 128;
    for (int u = u0; u < BATCH * HA * 32; u += ustride) {
        const int n = u & 31, h = (u >> 5) & 15, b = u >> 9, m0 = b * SEQ + n * CHUNK;
        int lane = C.lane; asm volatile("" : "+v"(lane));
        const int r = lane & 31, hf = lane >> 5, lane16 = lane * 16;
        unsigned char* rec = C.ws + WS_REC + (size_t)u * 65536;
        float gcv, betav;
        { const float aa = bf2f(P[(size_t)(m0 + lane) * NP + C_AA + h]), ba = bf2f(P[(size_t)(m0 + lane) * NP + C_BA + h]);
          const float xs = aa + ((const float*)C.A->in[6])[h]; const float sp = xs > 20.f ? xs : log1pf(__expf(xs));
          gcv = -__expf(((const float*)C.A->in[5])[h]) * sp; betav = sigmoidf_(ba);
#pragma unroll
          for (int o = 1; o < 64; o <<= 1) { const float t = __shfl_up(gcv, o); if (lane >= o) gcv += t; } }
        const float glast = __shfl(gcv, 63);
        gcl[lane] = gcv; betal[lane] = betav; LDS_WAIT();
        if (lane == 0) WSP(float, WS_EGL)[u] = __expf(glast);
        float gc_a[2], be_a[2];
#pragma unroll
        for (int a = 0; a < 2; ++a) { gc_a[a] = __shfl(gcv, r + 32 * a); be_a[a] = __shfl(betav, r + 32 * a); }
        bf16x8 kf[2][8];
        { conv_rows(P, cw, m0, n * CHUNK, C_KA + h * 128, lane, [&](int row, int c16, const float* y, float q) { *(LAS bf16x8*)(wl + tile_off(row, c16)) = pack8f(y); if (c16 == 0) ssl[row] = q; });
          LDS_WAIT();
          const float ss0 = ssl[r], ss1 = ssl[32 + r];
#pragma unroll 4
          for (int it = 0; it < 16; ++it) { const int a = it >> 3, s = it & 7;
              const float sc = __builtin_amdgcn_rsqf((a ? ss1 : ss0) + EPS), f1 = -(a ? be_a[1] : be_a[0]) * __expf(a ? gc_a[1] : gc_a[0]);
              LAS bf16x8* tp = (LAS bf16x8*)(wl + tile_off(32 * a + r, 2 * s + hf));
              const v4u w = __builtin_bit_cast(v4u, *tp);
              float y[8] = {bflo(w.x) * sc, bfhi(w.x) * sc, bflo(w.y) * sc, bfhi(w.y) * sc, bflo(w.z) * sc, bfhi(w.z) * sc, bflo(w.w) * sc, bfhi(w.w) * sc}, t[8];
#pragma unroll
              for (int j = 0; j < 8; ++j) t[j] = y[j] * f1;
              store_perm_frag(rec, a * 8 + s, lane16, t);
              *tp = pack8f(y); }
          LDS_WAIT(); }
#pragma unroll
        for (int a = 0; a < 2; ++a)
#pragma unroll
            for (int s = 0; s < 8; ++s) kf[a][s] = *(const LAS bf16x8*)(wl + tile_off(32 * a + r, 2 * s + hf));
        LDS_WAIT();
#pragma unroll 4
        for (int it = 0; it < 16; ++it) { const int a = it >> 3, s = it & 7; const float f2 = __expf(glast - (a ? gc_a[1] : gc_a[0]));
            LAS bf16x8* tp = (LAS bf16x8*)(wl + tile_off(32 * a + r, 2 * s + hf));
            const v4u w = __builtin_bit_cast(v4u, *tp);
            float t[8] = {bflo(w.x) * f2, bfhi(w.x) * f2, bflo(w.y) * f2, bfhi(w.y) * f2, bflo(w.z) * f2, bfhi(w.z) * f2, bflo(w.w) * f2, bfhi(w.w) * f2};
            *tp = pack8f(t); }
        LDS_WAIT();
#pragma unroll 2
        for (int f = 0; f < 16; ++f) { const int db = f >> 2, kst = f & 3; unsigned short e[8];
#pragma unroll
            for (int j = 0; j < 8; ++j) { const int tok = 16 * kst + 8 * (j >> 2) + 4 * hf + (j & 3); e[j] = *(const LAS unsigned short*)(wl + tile_off(tok, 4 * db + (r >> 3)) + (r & 7) * 2); }
            v4u w = {(unsigned)e[0] | ((unsigned)e[1] << 16), (unsigned)e[2] | ((unsigned)e[3] << 16), (unsigned)e[4] | ((unsigned)e[5] << 16), (unsigned)e[6] | ((unsigned)e[7] << 16)};
            *(v4u*)(rec + (size_t)(32 + f) * 1024 + lane16) = w; }
        LDS_WAIT();
        { conv_rows(P, cw, m0, n * CHUNK, C_QA + h * 128, lane, [&](int row, int c16, const float* y, float q) { *(LAS bf16x8*)(wl + tile_off(row, c16)) = pack8f(y); if (c16 == 0) ssl[row] = q; });
          LDS_WAIT();
          const float ss0 = ssl[r], ss1 = ssl[32 + r];
#pragma unroll 4
          for (int it = 0; it < 16; ++it) { const int a = it >> 3, s = it & 7;
              const float sc = 0.08838834764831845f / sqrtf((a ? ss1 : ss0) + EPS), eg = __expf(a ? gc_a[1] : gc_a[0]);
              LAS bf16x8* tp = (LAS bf16x8*)(wl + tile_off(32 * a + r, 2 * s + hf));
              const v4u w = __builtin_bit_cast(v4u, *tp);
              float y[8] = {bflo(w.x) * sc, bfhi(w.x) * sc, bflo(w.y) * sc, bfhi(w.y) * sc, bflo(w.z) * sc, bfhi(w.z) * sc, bflo(w.w) * sc, bfhi(w.w) * sc}, t[8];
#pragma unroll
              for (int j = 0; j < 8; ++j) t[j] = y[j] * eg;
              store_perm_frag(rec, 16 + a * 8 + s, lane16, t);
              *tp = pack8f(y); }
          LDS_WAIT(); }
        { const v4u z = {0u, 0u, 0u, 0u};
          *(v4u*)(rec + (size_t)(48 + 2) * 1024 + lane16) = z; *(v4u*)(rec + (size_t)(48 + 3) * 1024 + lane16) = z; }
#pragma unroll
        for (int tix = 0; tix < 3; ++tix) { const int jb = tix == 2 ? 1 : 0, ib = tix == 0 ? 0 : 1;
            f32x16 acc = {};
#pragma unroll
            for (int s = 0; s < 8; ++s) acc = __builtin_amdgcn_mfma_f32_32x32x16_bf16(kf[jb][s], *(const LAS bf16x8*)(wl + tile_off(32 * ib + r, 2 * s + hf)), acc, 0, 0, 0);
            const int i = 32 * ib + r; float t[16];
#pragma unroll
            for (int q = 0; q < 4; ++q) { const f32x4 gj = *(const LAS f32x4*)(gcl + 32 * jb + 8 * q + 4 * hf);
#pragma unroll
                for (int e = 0; e < 4; ++e) { const int j = 32 * jb + 8 * q + 4 * hf + e; t[4 * q + e] = (i >= j) ? acc[4 * q + e] * __expf(gc_a[ib] - gj[e]) : 0.f; } }
            *(bf16x8*)(rec + (size_t)(48 + ib * 4 + 2 * jb) * 1024 + lane16) = pack8f(t);
            *(bf16x8*)(rec + (size_t)(48 + ib * 4 + 2 * jb + 1) * 1024 + lane16) = pack8f(t + 8); }
        LDS_WAIT();
        { conv_rows(P, cw, m0, n * CHUNK, C_VA + h * 128, lane, [&](int row, int c16, const float* y, float q) { (void)q; const float bb = betal[row]; float t[8];
#pragma unroll
              for (int j = 0; j < 8; ++j) t[j] = y[j] * bb;
              *(LAS bf16x8*)(wl + tile_off(row, c16)) = pack8f(t); });
          LDS_WAIT();
          unsigned char* vbc = C.ws + WS_VBC + (size_t)u * 16384 + lane * 32;
#pragma unroll 2
          for (int q = 0; q < 8; ++q) { const int sl = q >> 1, rb = q & 1, ch = 32 * sl + r; unsigned short e[16];
#pragma unroll
              for (int i = 0; i < 16; ++i) e[i] = *(const LAS unsigned short*)(wl + tile_off(32 * rb + crow(i, hf), ch >> 3) + (ch & 7) * 2);
              v4u w0 = {(unsigned)e[0] | ((unsigned)e[1] << 16), (unsigned)e[2] | ((unsigned)e[3] << 16), (unsigned)e[4] | ((unsigned)e[5] << 16), (unsigned)e[6] | ((unsigned)e[7] << 16)};
              v4u w1 = {(unsigned)e[8] | ((unsigned)e[9] << 16), (unsigned)e[10] | ((unsigned)e[11] << 16), (unsigned)e[12] | ((unsigned)e[13] << 16), (unsigned)e[14] | ((unsigned)e[15] << 16)};
              *(v4u*)(vbc + sl * 4096 + rb * 2048) = w0; *(v4u*)(vbc + sl * 4096 + rb * 2048 + 16) = w1; }
          LDS_WAIT(); }
        LAS float* Lt = (LAS float*)wl;
#pragma unroll
        for (int tix = 0; tix < 3; ++tix) { const int jb = tix == 2 ? 1 : 0, ib = tix == 0 ? 0 : 1;
            f32x16 acc = {};
#pragma unroll
            for (int s = 0; s < 8; ++s) acc = __builtin_amdgcn_mfma_f32_32x32x16_bf16(kf[jb][s], kf[ib][s], acc, 0, 0, 0);
            const int i = 32 * ib + r;
#pragma unroll
            for (int q = 0; q < 4; ++q) { const f32x4 gj = *(const LAS f32x4*)(gcl + 32 * jb + 8 * q + 4 * hf);
#pragma unroll
                for (int e = 0; e < 4; ++e) { const int j = 32 * jb + 8 * q + 4 * hf + e;
                    Lt[j * 64 + i] = (i > j) ? be_a[ib] * acc[4 * q + e] * __expf(gc_a[ib] - gj[e]) : 0.f; } } }
        { const f32x4 z4 = {0.f, 0.f, 0.f, 0.f};
#pragma unroll
          for (int q = 0; q < 4; ++q) { const int idx = q * 64 + lane; *(LAS f32x4*)(Lt + (32 + (idx >> 3)) * 64 + (idx & 7) * 4) = z4; } }
        LDS_WAIT();
        { LAS float* Lb = Lt + hf * (32 * 64 + 32);
#pragma unroll 1
          for (int j = 31; j >= 0; --j) {
              float a0 = (r == j) ? 1.f : 0.f, a1 = 0.f, a2 = 0.f, a3 = 0.f;
#pragma unroll 4
              for (int q = (j + 1) >> 2; q < 8; ++q) { const f32x4 l4 = *(const LAS f32x4*)(Lb + j * 64 + 4 * q);
                  a0 -= Lb[(4 * q) * 64 + r] * l4.x; a1 -= Lb[(4 * q + 1) * 64 + r] * l4.y; a2 -= Lb[(4 * q + 2) * 64 + r] * l4.z; a3 -= Lb[(4 * q + 3) * 64 + r] * l4.w; }
              Lb[j * 64 + r] = (a0 + a1) + (a2 + a3);
          } }
        LDS_WAIT();
        { f32x16 W = {};
#pragma unroll
          for (int s2 = 0; s2 < 2; ++s2) { float ta[8], tb[8];
#pragma unroll
              for (int e = 0; e < 8; ++e) ta[e] = Lt[(16 * s2 + 8 * hf + e) * 64 + 32 + r];
              const f32x4 b0 = *(const LAS f32x4*)(Lt + r * 64 + 16 * s2 + 8 * hf), b1 = *(const LAS f32x4*)(Lt + r * 64 + 16 * s2 + 8 * hf + 4);
              tb[0] = b0.x; tb[1] = b0.y; tb[2] = b0.z; tb[3] = b0.w; tb[4] = b1.x; tb[5] = b1.y; tb[6] = b1.z; tb[7] = b1.w;
              W = __builtin_amdgcn_mfma_f32_32x32x16_bf16(pack8f(ta), pack8f(tb), W, 0, 0, 0); }
          f32x16 Z = {};
#pragma unroll
          for (int s2 = 0; s2 < 2; ++s2) { float ta[8], tw[8];
#pragma unroll
              for (int e = 0; e < 8; ++e) { const int k = 16 * s2 + 8 * (e >> 2) + 4 * hf + (e & 3); ta[e] = Lt[(32 + k) * 64 + 32 + r]; tw[e] = W[8 * s2 + e]; }
              Z = __builtin_amdgcn_mfma_f32_32x32x16_bf16(pack8f(ta), pack8f(tw), Z, 0, 0, 0); }
          LDS_WAIT();
#pragma unroll
          for (int i = 0; i < 16; ++i) Lt[r * 64 + 32 + crow(i, hf)] = -Z[i]; }
        LDS_WAIT();
#pragma unroll 1
        for (int s = 0; s < 4; ++s)
#pragma unroll
            for (int h2 = 0; h2 < 2; ++h2) { float t[8];
#pragma unroll
                for (int e = 0; e < 4; ++e) { t[e] = Lt[(16 * s + 4 * h2 + e) * 64 + lane]; t[4 + e] = Lt[(16 * s + 8 + 4 * h2 + e) * 64 + lane]; }
                *(bf16x8*)(rec + (size_t)(56 + (lane >> 5) * 4 + s) * 1024 + (lane16 & 511) + 512 * h2) = pack8f(t); }
        LDS_WAIT();
    }
}
__device__ __forceinline__ void dn_scan(const Ctx& C, int unit) {
    const int wave = C.wave, tid = C.tid, b = unit >> 4, h = unit & 15;
    int lane = C.lane; asm volatile("" : "+v"(lane));
    const unsigned char* recs = C.ws + WS_REC + (size_t)unit * 32 * 65536;
    bf16* OR = WSP(bf16, WS_ORAWB);
    f32x16 S[4];
#pragma unroll
    for (int d = 0; d < 4; ++d) S[d] = f32x16{};
    __syncthreads();
    if (wave >= 4) {
        unsigned t16 = (unsigned)(tid - 256) * 16u; asm volatile("" : "+v"(t16));
        v4u pre[16];
        { v4u tmp[16];
#pragma unroll
          for (int p = 0; p < 16; ++p) tmp[p] = *(const v4u*)(recs + p * 4096 + t16);
#pragma unroll
          for (int p = 0; p < 16; ++p) pre[p] = *(const v4u*)(recs + 65536 + p * 4096 + t16);
#pragma unroll
          for (int p = 0; p < 16; ++p) *(LAS v4u*)(C.lds + p * 4096 + t16) = tmp[p]; }
        for (int n = 0; n < 32; ++n) {
            asm volatile("s_waitcnt lgkmcnt(0)\n\ts_barrier" ::: "memory");
            if (n + 1 < 32) { LAS unsigned char* dst = C.lds + ((n + 1) & 1) * 65536;
#pragma unroll
                for (int p = 0; p < 16; ++p) *(LAS v4u*)(dst + p * 4096 + t16) = pre[p];
                if (n + 2 < 32) { const unsigned char* src = recs + (size_t)(n + 2) * 65536;
#pragma unroll
                    for (int p = 0; p < 16; ++p) pre[p] = *(const v4u*)(src + p * 4096 + t16); } }
        }
        __syncthreads();
        return;
    }
    v4u vb[4];
    { const unsigned char* vp = C.ws + WS_VBC + (size_t)(unit * 32) * 16384 + wave * 4096 + lane * 32;
      vb[0] = *(const v4u*)vp; vb[1] = *(const v4u*)(vp + 16); vb[2] = *(const v4u*)(vp + 2048); vb[3] = *(const v4u*)(vp + 2048 + 16); }
    for (int n = 0; n < 32; ++n) {
        asm volatile("s_waitcnt lgkmcnt(0)\n\ts_barrier" ::: "memory");
        {
            asm volatile("" : "+v"(lane));
            const int r = lane & 31, hf = lane >> 5;
            const LAS unsigned char* rb_ = C.lds + (n & 1) * 65536 + lane * 16;
#define FRAG(f) (*(const LAS bf16x8*)(rb_ + (f) * 1024))
            const float egl = WSP(float, WS_EGL)[unit * 32 + n];
            f32x16 X[2];
#pragma unroll
            for (int a = 0; a < 2; ++a) { const v4u w0 = vb[2 * a], w1 = vb[2 * a + 1];
                X[a][0] = bflo(w0.x); X[a][1] = bfhi(w0.x); X[a][2] = bflo(w0.y); X[a][3] = bfhi(w0.y); X[a][4] = bflo(w0.z); X[a][5] = bfhi(w0.z); X[a][6] = bflo(w0.w); X[a][7] = bfhi(w0.w);
                X[a][8] = bflo(w1.x); X[a][9] = bfhi(w1.x); X[a][10] = bflo(w1.y); X[a][11] = bfhi(w1.y); X[a][12] = bflo(w1.z); X[a][13] = bfhi(w1.z); X[a][14] = bflo(w1.w); X[a][15] = bfhi(w1.w); }
            if (n + 1 < 32) { const unsigned char* vp = C.ws + WS_VBC + (size_t)(unit * 32 + n + 1) * 16384 + wave * 4096 + lane * 32;
                vb[0] = *(const v4u*)vp; vb[1] = *(const v4u*)(vp + 16); vb[2] = *(const v4u*)(vp + 2048); vb[3] = *(const v4u*)(vp + 2048 + 16); }
            bf16x8 Sb[8];
#pragma unroll
            for (int d = 0; d < 4; ++d) { float t[16];
#pragma unroll
                for (int i = 0; i < 16; ++i) t[i] = S[d][i];
                Sb[2 * d] = pack8f(t); Sb[2 * d + 1] = pack8f(t + 8); }
            { bf16x8 f0 = FRAG(0), f1 = FRAG(8);
#pragma unroll
              for (int ks = 0; ks < 8; ++ks) { const bf16x8 g0 = f0, g1 = f1;
                  if (ks < 7) { f0 = FRAG(ks + 1); f1 = FRAG(8 + ks + 1); }
                  X[0] = __builtin_amdgcn_mfma_f32_32x32x16_bf16(g0, Sb[ks], X[0], 0, 0, 0); X[1] = __builtin_amdgcn_mfma_f32_32x32x16_bf16(g1, Sb[ks], X[1], 0, 0, 0); } }
            bf16x8 Xb[4];
#pragma unroll
            for (int a = 0; a < 2; ++a) { float t[16];
#pragma unroll
                for (int i = 0; i < 16; ++i) t[i] = X[a][i];
                Xb[2 * a] = pack8f(t); Xb[2 * a + 1] = pack8f(t + 8); }
            f32x16 V[2] = {f32x16{}, f32x16{}};
#pragma unroll
            for (int kst = 0; kst < 2; ++kst) { V[0] = __builtin_amdgcn_mfma_f32_32x32x16_bf16(FRAG(56 + kst), Xb[kst], V[0], 0, 0, 0); V[1] = __builtin_amdgcn_mfma_f32_32x32x16_bf16(FRAG(60 + kst), Xb[kst], V[1], 0, 0, 0); }
#pragma unroll
            for (int kst = 2; kst < 4; ++kst) V[1] = __builtin_amdgcn_mfma_f32_32x32x16_bf16(FRAG(60 + kst), Xb[kst], V[1], 0, 0, 0);
            bf16x8 Vb[4];
#pragma unroll
            for (int a = 0; a < 2; ++a) { float t[16];
#pragma unroll
                for (int i = 0; i < 16; ++i) t[i] = V[a][i];
                Vb[2 * a] = pack8f(t); Vb[2 * a + 1] = pack8f(t + 8); }
            f32x16 O[2] = {f32x16{}, f32x16{}};
            { bf16x8 f0 = FRAG(16), f1 = FRAG(24);
#pragma unroll
              for (int ks = 0; ks < 8; ++ks) { const bf16x8 g0 = f0, g1 = f1;
                  if (ks < 7) { f0 = FRAG(16 + ks + 1); f1 = FRAG(24 + ks + 1); }
                  O[0] = __builtin_amdgcn_mfma_f32_32x32x16_bf16(g0, Sb[ks], O[0], 0, 0, 0); O[1] = __builtin_amdgcn_mfma_f32_32x32x16_bf16(g1, Sb[ks], O[1], 0, 0, 0); } }
#pragma unroll
            for (int kst = 0; kst < 2; ++kst) { O[0] = __builtin_amdgcn_mfma_f32_32x32x16_bf16(FRAG(48 + kst), Vb[kst], O[0], 0, 0, 0); O[1] = __builtin_amdgcn_mfma_f32_32x32x16_bf16(FRAG(52 + kst), Vb[kst], O[1], 0, 0, 0); }
#pragma unroll
            for (int kst = 2; kst < 4; ++kst) O[1] = __builtin_amdgcn_mfma_f32_32x32x16_bf16(FRAG(52 + kst), Vb[kst], O[1], 0, 0, 0);
#pragma unroll
            for (int d = 0; d < 4; ++d) {
#pragma unroll
                for (int i = 0; i < 16; ++i) S[d][i] *= egl; }
#pragma unroll
            for (int kst = 0; kst < 4; ++kst) { const bf16x8 k0 = FRAG(32 + kst), k1 = FRAG(36 + kst), k2 = FRAG(40 + kst), k3 = FRAG(44 + kst);
                S[0] = __builtin_amdgcn_mfma_f32_32x32x16_bf16(k0, Vb[kst], S[0], 0, 0, 0); S[1] = __builtin_amdgcn_mfma_f32_32x32x16_bf16(k1, Vb[kst], S[1], 0, 0, 0);
                S[2] = __builtin_amdgcn_mfma_f32_32x32x16_bf16(k2, Vb[kst], S[2], 0, 0, 0); S[3] = __builtin_amdgcn_mfma_f32_32x32x16_bf16(k3, Vb[kst], S[3], 0, 0, 0); }
            bf16* op = OR + (size_t)(b * SEQ + n * CHUNK) * DM + h * 128 + wave * 32 + r;
            const int odd = r & 1; bf16* opl = op - odd;
#pragma unroll
            for (int a = 0; a < 2; ++a)
#pragma unroll
                for (int i = 0; i < 16; i += 2) { const float va = O[a][i], vb2 = O[a][i + 1], x = __shfl_xor(odd ? va : vb2, 1);
                    *(unsigned*)(opl + (size_t)(32 * a + crow(i, hf) + odd) * DM) = odd ? cvtpk(x, vb2) : cvtpk(va, x); }
#undef FRAG
        }
    }
    __syncthreads();
}
__device__ __forceinline__ void dn_post2(const Ctx& C) {
    const bf16* P = WSP(bf16, WS_P); const bf16* OR = WSP(bf16, WS_ORAWB); bf16* OA = WSP(bf16, WS_OA);
    const int gw = C.bid * NWAVES + C.wave, NGW = C.G * NWAVES, lane = C.lane;
    const float* ng = (const float*)C.A->in[7] + 8 * (lane & 15);
    const f32x4 n0 = *(const f32x4*)ng, n1 = *(const f32x4*)(ng + 4);
    for (int m = gw; m < T; m += NGW) {
        v4u ow[4], zw[4];
#pragma unroll
        for (int j = 0; j < 4; ++j) { ow[j] = *(const v4u*)(OR + (size_t)m * DM + 8 * (lane + 64 * j)); zw[j] = *(const v4u*)(P + (size_t)m * NP + C_ZA + 8 * (lane + 64 * j)); }
#pragma unroll
        for (int j = 0; j < 4; ++j) {
            float o[8] = {bflo(ow[j].x), bfhi(ow[j].x), bflo(ow[j].y), bfhi(ow[j].y), bflo(ow[j].z), bfhi(ow[j].z), bflo(ow[j].w), bfhi(ow[j].w)};
            const float z[8] = {bflo(zw[j].x), bfhi(zw[j].x), bflo(zw[j].y), bfhi(zw[j].y), bflo(zw[j].z), bfhi(zw[j].z), bflo(zw[j].w), bfhi(zw[j].w)};
            float q = 0.f;
#pragma unroll
            for (int e = 0; e < 8; ++e) q += o[e] * o[e];
            q += __shfl_xor(q, 1); q += __shfl_xor(q, 2); q += __shfl_xor(q, 4); q += __shfl_xor(q, 8);
            const float rr = __builtin_amdgcn_rsqf(q * (1.f / 128.f) + EPS);
            const float g[8] = {n0.x, n0.y, n0.z, n0.w, n1.x, n1.y, n1.z, n1.w};
#pragma unroll
            for (int e = 0; e < 8; ++e) o[e] = o[e] * rr * g[e] * z[e] * sigmoidf_(z[e]);
            v4u r; r.x = cvtpk(o[0], o[1]); r.y = cvtpk(o[2], o[3]); r.z = cvtpk(o[4], o[5]); r.w = cvtpk(o[6], o[7]);
            *(v4u*)(OA + (size_t)m * DM + 8 * (lane + 64 * j)) = r; }
    }
}
constexpr size_t WS_W1K = 109 * MiB, WS_W1V = 110 * MiB, WS_W2K = 111 * MiB, WS_W2V = 111 * MiB + 65536;
constexpr size_t WS_KT = 5 * MiB, WS_VTT = 7 * MiB;
__device__ __forceinline__ int ktile_off(int row, int chunk) { return row * 256 + ((chunk ^ (row & 15)) << 4); }
__device__ __forceinline__ int vtile_off(int dim, int key) { return dim * 256 + ((((key >> 2) ^ (dim & 31))) << 3) + (key & 3) * 2; }
__device__ __forceinline__ void nsa_compress2(const Ctx& C) {
    const bf16* P = WSP(bf16, WS_P);
    LAS float* red = (LAS float*)C.lds;
    LAS unsigned char* hid = C.lds + XTRA_OFF;
    for (int unit = C.bid; unit < 256; unit += C.G) {
        int lane = C.lane; asm volatile("" : "+v"(lane));
        const int r = lane & 31, hf = lane >> 5, w = C.wave;
        const int kv = unit >> 7, b = (unit >> 4) & 7, g = (unit >> 2) & 3, rbk = unit & 3;
        const bf16* W1T = WSP(bf16, kv ? WS_W1V : WS_W1K); const bf16* W2T = WSP(bf16, kv ? WS_W2V : WS_W2K);
        const float* pe = (const float*)C.A->in[kv ? 11 : 8];
        const int c = 32 * rbk + r; const bool valid = c < NCMP;
        const bf16* xrow = P + (size_t)(b * SEQ + (valid ? 16 * c : 0)) * NP + (kv ? C_VC : C_KC) + g * 128 + 8 * hf;
        f32x16 acc[4] = {f32x16{}, f32x16{}, f32x16{}, f32x16{}};
        __syncthreads();
#pragma unroll 1
        for (int l = 4 * w; l < 4 * w + 4; ++l) {
#pragma unroll 4
            for (int s = 0; s < 8; ++s) {
                const v4u xw = *(const v4u*)(xrow + (size_t)l * NP + 16 * s);
                const f32x4 p0 = *(const f32x4*)(pe + l * 128 + 16 * s + 8 * hf), p1 = *(const f32x4*)(pe + l * 128 + 16 * s + 8 * hf + 4);
                float t[8] = {bflo(xw.x) + p0.x, bfhi(xw.x) + p0.y, bflo(xw.y) + p0.z, bfhi(xw.y) + p0.w, bflo(xw.z) + p1.x, bfhi(xw.z) + p1.y, bflo(xw.w) + p1.z, bfhi(xw.w) + p1.w};
                const bf16x8 af = pack8f(t);
                const bf16* wp = W1T + ((size_t)(l * 8 + s) * 4 * 64 + lane) * 8;
#pragma unroll
                for (int nt = 0; nt < 4; ++nt) acc[nt] = __builtin_amdgcn_mfma_f32_32x32x16_bf16(af, *(const bf16x8*)(wp + nt * 512), acc[nt], 0, 0, 0);
            }
        }
#pragma unroll
        for (int nt = 0; nt < 4; ++nt)
#pragma unroll
            for (int i = 0; i < 16; ++i) red[(w * 32 + crow(i, hf)) * 128 + 32 * nt + r] = acc[nt][i];
        __syncthreads();
#pragma unroll
        for (int q = 0; q < 8; ++q) { const int e = C.tid + 512 * q; float sum = 0.f;
#pragma unroll
            for (int ww = 0; ww < 8; ++ww) sum += red[ww * 4096 + e];
            const float u2 = 1.5957691216057308f * (sum + 0.044715f * sum * sum * sum);
            const int row = e >> 7, col = e & 127;
            *(LAS unsigned short*)(hid + ktile_off(row, col >> 3) + (col & 7) * 2) = (unsigned short)f2bf(sum * sigmoidf_(u2)); }
        __syncthreads();
        if (w < 4) {
            f32x16 o = f32x16{};
#pragma unroll
            for (int s = 0; s < 8; ++s) o = __builtin_amdgcn_mfma_f32_32x32x16_bf16(*(const LAS bf16x8*)(hid + ktile_off(r, 2 * s + hf)), *(const bf16x8*)(W2T + (size_t)(32 * w + r) * 128 + 16 * s + 8 * hf), o, 0, 0, 0);
            const int bg = b * 4 + g, n = 32 * w + r;
#pragma unroll
            for (int i = 0; i < 16; ++i) { const int ci = 32 * rbk + crow(i, hf); const unsigned short v = ci < NCMP ? (unsigned short)f2bf(o[i]) : (unsigned short)0;
                if (kv == 0) WSP(unsigned short, WS_KT)[((size_t)bg * 128 + ci) * 128 + n] = v; else WSP(unsigned short, WS_VTT)[((size_t)bg * 128 + n) * 128 + ci] = v; }
        }
    }
    __syncthreads();
}
__device__ __forceinline__ void nsa_cmp_attn2(const Ctx& C, int wi, int nwg) {
    const bf16* P = WSP(bf16, WS_P); bf16* OC = WSP(bf16, WS_OCB); unsigned* SEL = WSP(unsigned, WS_SEL);
    LAS unsigned char* Kl = C.lds; LAS unsigned char* Vl = C.lds + 32768;
    const int per = 2048 / nwg;
    int cur_bg = -1;
    for (int j0 = 0; j0 < per; j0 += NWAVES) {
        const int job = wi * per + j0 + C.wave, bg = job >> 6, tb32 = job & 63, b = bg >> 2, g = bg & 3;
        if (((wi * per + j0) >> 6) != cur_bg) { cur_bg = (wi * per + j0) >> 6;
            __syncthreads();
            const v4u* ks = (const v4u*)(C.ws + WS_KT + (size_t)cur_bg * 32768); const v2u* vs = (const v2u*)(C.ws + WS_VTT + (size_t)cur_bg * 32768);
#pragma unroll
            for (int q = 0; q < 4; ++q) { const int idx = C.tid + 512 * q; *(LAS v4u*)(Kl + ktile_off(idx >> 4, idx & 15)) = ks[idx]; }
#pragma unroll
            for (int q = 0; q < 8; ++q) { const int idx = C.tid + 512 * q, dim = idx >> 5, gr = idx & 31; *(LAS v2u*)(Vl + vtile_off(dim, gr * 4)) = vs[idx]; }
            __syncthreads(); }
        int lane = C.lane; asm volatile("" : "+v"(lane));
        int r32 = lane & 31, hi = lane >> 5; const int t = 32 * tb32 + r32, m = b * SEQ + t;
        int nvalid = t >= 31 ? ((t - 31) >> 4) + 1 : 0;
        const int tmax = 32 * tb32 + 31, ntile = __builtin_amdgcn_readfirstlane((((tmax - 31) >> 4) + 1 + 31) >> 5);
        float imp[16];
#pragma unroll
        for (int sl = 0; sl < 16; ++sl) imp[sl] = 0.f;
#pragma unroll 1
        for (int rh = 0; rh < RG; ++rh) {
            asm volatile("" : "+v"(r32), "+v"(hi), "+v"(nvalid));
            f32x16 p[4];
            { bf16x8 qf[8];
#pragma unroll
              for (int s = 0; s < 8; ++s) qf[s] = *(const bf16x8*)(P + (size_t)m * NP + C_QB + (g * 4 + rh) * 128 + 16 * s + 8 * hi);
#pragma unroll
              for (int kt = 0; kt < 4; ++kt) { p[kt] = f32x16{};
                  if (kt < ntile) {
#pragma unroll
                      for (int s = 0; s < 8; ++s) p[kt] = __builtin_amdgcn_mfma_f32_32x32x16_bf16(*(const LAS bf16x8*)(Kl + ktile_off(32 * kt + r32, 2 * s + hi)), qf[s], p[kt], 0, 0, 0); } } }
            float mx = -1e30f;
#pragma unroll
            for (int kt = 0; kt < 4; ++kt)
#pragma unroll
                for (int i = 0; i < 16; ++i) { const bool ok = 32 * kt + crow(i, hi) < nvalid; p[kt][i] = ok ? p[kt][i] * 0.08838834764831845f : -1e30f; mx = fmaxf(mx, p[kt][i]); }
            mx = fmaxf(mx, __shfl_xor(mx, 32));
            float sum = 0.f;
#pragma unroll
            for (int kt = 0; kt < 4; ++kt)
#pragma unroll
                for (int i = 0; i < 16; ++i) { const float e = __expf(p[kt][i] - mx); p[kt][i] = e; sum += e; }
            sum += __shfl_xor(sum, 32);
            const float inv = nvalid > 0 ? __builtin_amdgcn_rcpf(sum) : 0.f;
#pragma unroll
            for (int kt = 0; kt < 4; ++kt)
#pragma unroll
                for (int i = 0; i < 16; ++i) p[kt][i] *= inv;
#pragma unroll
            for (int sl = 0; sl < 16; ++sl) { const int kt = sl >> 2, qg = sl & 3;
                const float G = (p[kt][4 * qg] + p[kt][4 * qg + 1]) + (p[kt][4 * qg + 2] + p[kt][4 * qg + 3]);
                const float same = __shfl_xor(p[kt][4 * qg + 3], 32);
                const float prev = sl > 0 ? __shfl_xor(p[(sl > 0 ? sl - 1 : 0) >> 2][4 * ((sl > 0 ? sl - 1 : 0) & 3) + 3], 32) : 0.f;
                imp[sl] += G + (hi ? same : prev); }
            { f32x16 o[4] = {f32x16{}, f32x16{}, f32x16{}, f32x16{}};
#pragma unroll
              for (int ks = 0; ks < 8; ++ks) { if ((ks >> 1) >= ntile) continue; float tt[8];
#pragma unroll
                  for (int j = 0; j < 8; ++j) tt[j] = p[ks >> 1][8 * (ks & 1) + j];
                  const bf16x8 pa = pack8f(tt);
#pragma unroll
                  for (int dt = 0; dt < 4; ++dt) { const int dim = 32 * dt + r32;
                      const v2u lo = *(const LAS v2u*)(Vl + vtile_off(dim, 16 * ks + 4 * hi)), hv = *(const LAS v2u*)(Vl + vtile_off(dim, 16 * ks + 8 + 4 * hi));
                      const v4u bw = {lo.x, lo.y, hv.x, hv.y};
                      o[dt] = __builtin_amdgcn_mfma_f32_32x32x16_bf16(pa, __builtin_bit_cast(bf16x8, bw), o[dt], 0, 0, 0); } }
              const int odd = r32 & 1; bf16* opl = OC + (size_t)(b * SEQ + 32 * tb32) * DM + (g * 4 + rh) * 128 + r32 - odd;
#pragma unroll
              for (int dt = 0; dt < 4; ++dt)
#pragma unroll
                  for (int i = 0; i < 16; i += 2) { const float a = o[dt][i], b2 = o[dt][i + 1], x = __shfl_xor(odd ? a : b2, 1);
                      *(unsigned*)(opl + (size_t)(crow(i, hi) + odd) * DM + 32 * dt) = odd ? cvtpk(x, b2) : cvtpk(a, x); } }
        }
        { const int cur = t >> 6; const float INF = __builtin_inff();
          float oth[16];
#pragma unroll
          for (int sl = 0; sl < 16; ++sl) { const int j = 2 * sl + hi, jo = 2 * sl + (1 - hi);
              float v = imp[sl]; if (j == 0 || j == cur) v = INF; else if (j > cur) v = -INF; imp[sl] = v;
              (void)jo; }
#pragma unroll
          for (int sl = 0; sl < 16; ++sl) oth[sl] = __shfl_xor(imp[sl], 32);
          unsigned bits = 0u;
#pragma unroll
          for (int sl = 0; sl < 16; ++sl) { const int j = 2 * sl + hi; const float v = imp[sl]; int rank = 0;
#pragma unroll
              for (int q = 0; q < 16; ++q) { const int jm = 2 * q + hi, jo = 2 * q + (1 - hi);
                  rank += (imp[q] > v || (imp[q] == v && jm < j)) ? 1 : 0;
                  rank += (oth[q] > v || (oth[q] == v && jo < j)) ? 1 : 0; }
              if (rank < 8 && j <= cur) bits |= 1u << j; }
          bits |= __shfl_xor(bits, 32);
          if (hi == 0) SEL[(size_t)m * GKV + g] = bits; }
    }
    __syncthreads();
}
namespace fa {
constexpr float SCALE = 0.08838834764831845f; constexpr int D = 128;
constexpr int NW = 8, QBLK = 32, KVBLK = 64, QB = NW * QBLK, PB = 64  ; constexpr int SHM_V = KVBLK * D * 2, SHM_K = KVBLK * D * 2; constexpr int LDS_BYTES = 2 * SHM_V + 2 * SHM_K + NW * 64 * 4; constexpr float THR = 8.f;
constexpr int QSTR = NP, KSTR = NP, OSTR = DM;
enum { ORDER_NATURAL = 0, ORDER_REVERSED = 1, ORDER_PAIRED = 2, ORDER_XCD = 4 };

typedef short bf16x8 __attribute__((ext_vector_type(8)));
typedef short s16x4 __attribute__((ext_vector_type(4)));
typedef float f32x16 __attribute__((ext_vector_type(16)));
typedef float f32x4 __attribute__((ext_vector_type(4)));
typedef unsigned u32x4 __attribute__((ext_vector_type(4)));
template <class A, class Bt> struct same_t { static constexpr bool v = false; };
template <class A> struct same_t<A, A> { static constexpr bool v = true; };
#define TOKOFF(w) (((w) & 1) * QBLK)
#define HEADOFF(w) (((w) >> 1) * D)
#define KSWZ(row, colB) ((row) * 256 + ((colB) ^ (((row) & 7) << 4)))
#define SBAR() __builtin_amdgcn_sched_barrier(0)
__device__ __forceinline__ int v_st(int k, int c) { const int kk = (k & ~0xC) | ((k & 4) << 1) | ((k & 8) >> 1); return ((kk >> 3) * 4 + (c >> 5)) * 512 + ((kk & 7) * 32 + (c & 31)) * 2; }
__device__ __forceinline__ int v_rd_base(int lane) { return ((lane & 3) << 3) | (((lane >> 2) & 3) << 6) | (((lane >> 4) & 1) << 5) | (((lane >> 5) & 1) << 8); }
constexpr int v_rd_off(int d0, int ks, int half) { return d0 * 512 + ks * 4096 + half * 2048; }
__device__ __forceinline__ int crow(int r, int hi) { return (r & 3) + 8 * (r >> 2) + 4 * hi; }
__device__ __forceinline__ unsigned cvtpk(float lo, float hi) {
    unsigned r; asm volatile("v_cvt_pk_bf16_f32 %0, %1, %2" : "=v"(r) : "v"(lo), "v"(hi)); return r;
}
__device__ __forceinline__ bf16x8 pack8(f32x4 a, f32x4 b) {
    u32x4 w = {cvtpk(a[0], a[1]), cvtpk(a[2], a[3]), cvtpk(b[0], b[1]), cvtpk(b[2], b[3])};
    return *reinterpret_cast<bf16x8*>(&w);
}
template <class T> __device__ __forceinline__ bf16x8 load8(const T* p) {
    if constexpr (same_t<T, float>::v) { return pack8(*(const f32x4*)p, *(const f32x4*)(p + 4)); }
    else { return *reinterpret_cast<const bf16x8*>(p); }
}
__device__ __forceinline__ void mask_tile(f32x16& p0, f32x16& p1, int dq, unsigned W) {
    const float NEG = -__builtin_inff();
#pragma unroll
    for (int r = 0; r < 16; ++r) {
        const int c = (r & 3) + 8 * (r >> 2);
        if ((unsigned)(dq - c) >= W) p0[r] = NEG;
        if ((unsigned)(dq - c - 32) >= W) p1[r] = NEG;
    }
}
__device__ __forceinline__ void mask_tile_sel(f32x16& p0, f32x16& p1, int dq, bool sel) {
    const float NEG = -__builtin_inff();
#pragma unroll
    for (int r = 0; r < 16; ++r) {
        const int c = (r & 3) + 8 * (r >> 2);
        if (!sel || dq - c < 0) p0[r] = NEG;
        if (!sel || dq - c - 32 < 0) p1[r] = NEG;
    }
}
__device__ __forceinline__ void partialSM(f32x16& p0, f32x16& p1, float& m_reg, float& mn, float& alpha) {
    float pmax = p0[0]; for (int r = 1; r < 16; ++r) pmax = fmaxf(pmax, p0[r]); for (int r = 0; r < 16; ++r) pmax = fmaxf(pmax, p1[r]);
    { auto rr = __builtin_amdgcn_permlane32_swap(__float_as_uint(pmax), __float_as_uint(pmax), false, false);
      pmax = fmaxf(__uint_as_float(rr[0]), __uint_as_float(rr[1])); }
    constexpr float C2 = 1.4426950408889634f * SCALE;
    if (__builtin_expect(__all((pmax - m_reg) * SCALE <= THR), 1)) { mn = m_reg; alpha = 1.f; }
    else { mn = fmaxf(m_reg, pmax); alpha = __builtin_amdgcn_exp2f((m_reg - mn) * C2); m_reg = mn; }
    const float mnL = -mn * C2;
    for (int r = 0; r < 16; ++r) p0[r] = fmaf(p0[r], C2, mnL); for (int r = 0; r < 16; ++r) p1[r] = fmaf(p1[r], C2, mnL);
    for (int r = 0; r < 16; ++r) p0[r] = __builtin_amdgcn_exp2f(p0[r]);
}
__device__ __forceinline__ void finishSM(f32x16& p0, f32x16& p1, float alpha, float& l_reg, bf16x8& pa0, bf16x8& pa1, bf16x8& pa2, bf16x8& pa3) {
    for (int r = 0; r < 16; ++r) p1[r] = __builtin_amdgcn_exp2f(p1[r]);
    float ps = 0; for (int r = 0; r < 16; ++r) ps += p0[r]; for (int r = 0; r < 16; ++r) ps += p1[r];
    { auto rr = __builtin_amdgcn_permlane32_swap(__float_as_uint(ps), __float_as_uint(ps), false, false);
      ps = __uint_as_float(rr[0]) + __uint_as_float(rr[1]); }
    l_reg = l_reg * alpha + ps;
#define PK4(P, B_, OUT) do { unsigned a0 = cvtpk(P[B_+0], P[B_+1]), a1 = cvtpk(P[B_+2], P[B_+3]);                          \
        unsigned b0 = cvtpk(P[B_+4], P[B_+5]), b1 = cvtpk(P[B_+6], P[B_+7]);                                             \
        auto r0 = __builtin_amdgcn_permlane32_swap(a0, b0, false, false); auto r1 = __builtin_amdgcn_permlane32_swap(a1, b1, false, false); \
        u32x4 w = {r0[0], r1[0], r0[1], r1[1]}; OUT = *reinterpret_cast<bf16x8*>(&w); } while (0)
    PK4(p0, 0, pa0); PK4(p0, 8, pa1); PK4(p1, 0, pa2); PK4(p1, 8, pa3);
#undef PK4
}
template <int KB, bool SK>
__device__ __forceinline__ void qkt(f32x16& p0, f32x16& p1, const char* K_lds, int r32, int hi, const bf16x8* qr, bool act) {
    if (SK && !act) { const float NEG = -__builtin_inff();
#pragma unroll
        for (int r = 0; r < 16; ++r) { p0[r] = NEG; p1[r] = NEG; } return; }
    p0 = f32x16{}; p1 = f32x16{};
    const char* kb[4];
#pragma unroll
    for (int dd = 0; dd < 4; ++dd) kb[dd] = K_lds + KB * SHM_K + KSWZ(r32, (dd * 16 + hi * 8) * 2);
#pragma unroll
    for (int d0 = 0; d0 < 8; ++d0) { const char* a = kb[d0 & 3] + (d0 >> 2) * 128;
        bf16x8 b0 = *reinterpret_cast<const bf16x8*>(a);
        bf16x8 b1 = *reinterpret_cast<const bf16x8*>(a + 32 * 256);
        p0 = __builtin_amdgcn_mfma_f32_32x32x16_bf16(b0, qr[d0], p0, 0, 0, 0);
        p1 = __builtin_amdgcn_mfma_f32_32x32x16_bf16(b1, qr[d0], p1, 0, 0, 0); }
}
template <int VB, bool SK>
__device__ __forceinline__ void pv_tile(f32x16* o, int vb0, bf16x8 pa0, bf16x8 pa1, bf16x8 pa2, bf16x8 pa3, bool act) {
    if (SK && !act) return;
#define TRRD(dst, off) asm volatile("ds_read_b64_tr_b16 %0, %1 offset:%2" : "=&v"(dst) : "v"(vb0), "i"(off) : "memory")
#define PV_D0(d0) do { s16x4 l0, l1, l2, l3, h0, h1, h2, h3; constexpr int b_ = VB * SHM_V + v_rd_off(d0, 0, 0);     \
        TRRD(l0, b_); TRRD(h0, b_ + 2048); TRRD(l1, b_ + 4096); TRRD(h1, b_ + 6144); TRRD(l2, b_ + 8192); TRRD(h2, b_ + 10240); TRRD(l3, b_ + 12288); TRRD(h3, b_ + 14336); \
        asm volatile("s_waitcnt lgkmcnt(0)" ::: "memory"); SBAR();                 \
        o[d0] = __builtin_amdgcn_mfma_f32_32x32x16_bf16(pa0, (bf16x8){l0[0], l0[1], l0[2], l0[3], h0[0], h0[1], h0[2], h0[3]}, o[d0], 0, 0, 0);   \
        o[d0] = __builtin_amdgcn_mfma_f32_32x32x16_bf16(pa1, (bf16x8){l1[0], l1[1], l1[2], l1[3], h1[0], h1[1], h1[2], h1[3]}, o[d0], 0, 0, 0);   \
        o[d0] = __builtin_amdgcn_mfma_f32_32x32x16_bf16(pa2, (bf16x8){l2[0], l2[1], l2[2], l2[3], h2[0], h2[1], h2[2], h2[3]}, o[d0], 0, 0, 0);   \
        o[d0] = __builtin_amdgcn_mfma_f32_32x32x16_bf16(pa3, (bf16x8){l3[0], l3[1], l3[2], l3[3], h3[0], h3[1], h3[2], h3[3]}, o[d0], 0, 0, 0); } while (0)
    PV_D0(0); PV_D0(1); PV_D0(2); PV_D0(3);
#undef PV_D0
#undef TRRD
}

template <class TIn, class TOut> struct BlockRef { const TIn* Q; const TIn* K; const TIn* V; TOut* O; const unsigned* SELP; int P0; };
template <class TIn> struct Seam {
    bf16x8 qr[8];
    bf16x8 st_v0, st_v1, st_k0, st_k1; f32x4 sf0, sf1, sf2, sf3;
    f32x4 tq[16];
};
__device__ __forceinline__ int swa_jlo(int P0, int W) { const int lowk = P0 - W + 1; return lowk > 0 ? lowk / KVBLK : 0; }
#define ROW(p, k0, rr) ((p) + (size_t)((k0) + (rr)) * KSTR + sc)
#define VMW() asm volatile("s_waitcnt vmcnt(0)" ::: "memory")
#define VMWN(n) asm volatile("s_waitcnt vmcnt(%0)" :: "i"(n) : "memory")
#define SLOAD_H(Kp, Vp, k0) do { S.st_v0 = load8<TIn>(ROW(Vp, k0, sr)); S.st_v1 = load8<TIn>(ROW(Vp, k0, 32 + sr));              \
                         S.st_k0 = load8<TIn>(ROW(Kp, k0, sr)); S.st_k1 = load8<TIn>(ROW(Kp, k0, 32 + sr)); } while (0)
#define SWRITE_HK(bf) do { *(bf16x8*)(K_lds + (bf) * SHM_K + kws) = S.st_k0; *(bf16x8*)(K_lds + (bf) * SHM_K + kws + 32 * 256) = S.st_k1; } while (0)
#define SWRITE_HV(bf) do { *(bf16x8*)(V_lds + (bf) * SHM_V + vst0) = S.st_v0; *(bf16x8*)(V_lds + (bf) * SHM_V + vst1) = S.st_v1; } while (0)
#define SWRITE_H(bf) do { SWRITE_HV(bf); SWRITE_HK(bf); } while (0)
#define SLOAD_F(p, k0) do { S.sf0 = *(const f32x4*)ROW(p, k0, sr); S.sf1 = *(const f32x4*)(ROW(p, k0, sr) + 4);                \
                            S.sf2 = *(const f32x4*)ROW(p, k0, 32 + sr); S.sf3 = *(const f32x4*)(ROW(p, k0, 32 + sr) + 4); } while (0)
#define SWRITE_KF(bf) do { *(bf16x8*)(K_lds + (bf) * SHM_K + kws) = pack8(S.sf0, S.sf1); *(bf16x8*)(K_lds + (bf) * SHM_K + kws + 32 * 256) = pack8(S.sf2, S.sf3); } while (0)
#define SWRITE_VF(bf) do { *(bf16x8*)(V_lds + (bf) * SHM_V + vst0) = pack8(S.sf0, S.sf1); *(bf16x8*)(V_lds + (bf) * SHM_V + vst1) = pack8(S.sf2, S.sf3); } while (0)
template <class TIn, class TOut>
__device__ __forceinline__ void causal_swa_prime(const BlockRef<TIn, TOut>& cur, int W, char* lds, Seam<TIn>& S) {
    constexpr bool F32 = same_t<TIn, float>::v;
    const int tid = threadIdx.x, wid = __builtin_amdgcn_readfirstlane(tid >> 6), lane = tid & 63, r32 = lane & 31, hi = lane >> 5;
    const int sr = tid >> 4, sc = (tid & 15) * 8, kws = KSWZ(sr, sc * 2); char* K_lds = lds + 2 * SHM_V;
    const int kb0 = swa_jlo(cur.P0, W) * KVBLK;
    for (int d0 = 0; d0 < 8; ++d0) S.qr[d0] = load8<TIn>(cur.Q + HEADOFF(wid) + (size_t)(TOKOFF(wid) + r32) * QSTR + d0 * 16 + hi * 8);
    if constexpr (F32) { SLOAD_F((const float*)cur.K, kb0); VMW(); SWRITE_KF(0); SBAR(); SLOAD_F((const float*)cur.V, kb0); }
    else { SLOAD_H(cur.K, cur.V, kb0); VMW(); SWRITE_HK(0); }
    __syncthreads();
}
template <int MODE, class TIn, class TOut>
__device__ __forceinline__ void causal_swa_block(const BlockRef<TIn, TOut>& cur, const BlockRef<TIn, TOut>& nxt, int skv, int W, char* lds, Seam<TIn>& S) {
    constexpr bool F32 = same_t<TIn, float>::v;
    const int tid = threadIdx.x, wid = __builtin_amdgcn_readfirstlane(tid >> 6), lane = tid & 63, r32 = lane & 31, hi = lane >> 5;
    const int j_lo = swa_jlo(cur.P0, W);
    int j_hi = (cur.P0 + PB - 1) / KVBLK + 1; if (j_hi > skv / KVBLK) j_hi = skv / KVBLK;
    const int NT = j_hi - j_lo;
    const int kbn = swa_jlo(nxt.P0, W) * KVBLK;
    const int qlo = cur.P0 + TOKOFF(wid), qm = qlo + r32 - 4 * hi;
    unsigned selrow = 0xffffffffu; if constexpr (MODE == 1) selrow = cur.SELP[(size_t)(TOKOFF(wid) + r32) * GKV];
    char* V_lds = lds; char* K_lds = lds + 2 * SHM_V;
    float* ws = (float*)(lds + 2 * SHM_V + 2 * SHM_K) + wid * 64; float* li_l = ws, * al_l = ws + 32;
    float m_reg = -1e30f, l_reg = 0; f32x16 o[4] = {};
    const int sr = tid >> 4, sc = (tid & 15) * 8, vst0 = v_st(sr, sc), vst1 = v_st(32 + sr, sc), kws = KSWZ(sr, sc * 2);
    const int vb0 = (int)(uintptr_t)V_lds + v_rd_base(lane);
    const TIn* Kh = cur.K; const TIn* Vh = cur.V;
#define RESC(a) do { if (__any((a) < 1.f)) { if (hi == 0) al_l[r32] = (a); asm volatile("s_waitcnt lgkmcnt(0)" ::: "memory");              \
                     for (int d_ = 0; d_ < 4; ++d_) for (int r = 0; r < 16; ++r) o[d_][r] *= al_l[crow(r, hi)]; } } while (0)
#define KBASE(t) ((j_lo + (t)) * KVBLK)
#define ACT(t) (KBASE(t) <= qlo + QBLK - 1 && KBASE(t) + KVBLK - 1 >= qlo - W + 1)
#define MASKT(P0_, P1_, t) do { const int kb_ = KBASE(t); if constexpr (MODE == 1) { const bool sb_ = (selrow >> (kb_ >> 6)) & 1u; if (__any(!sb_) || kb_ + KVBLK - 1 > qlo) mask_tile_sel(P0_, P1_, qm - kb_, sb_); } else { if ((!SK || ACT(t)) && (kb_ + KVBLK - 1 > qlo || kb_ <= qlo + QBLK - 1 - W)) mask_tile(P0_, P1_, qm - kb_, (unsigned)W); } } while (0)
    constexpr int NQL = F32 ? 16 : 8;
    constexpr bool SK = false;
#define SEAM_K0() do { VMWN(NQL); if constexpr (F32) { SWRITE_KF(0); SBAR(); SLOAD_F((const float*)nxt.V, kbn); } else { SWRITE_HK(0); } SBAR(); } while (0)
    f32x16 pA0, pA1, pB0, pB1; float mnA, mnB, alA, alB; bf16x8 pa0, pa1, pa2, pa3;
    if constexpr (F32) { VMW(); SWRITE_VF(0); SBAR(); } else { SWRITE_HV(0); SBAR(); }
    if (NT > 1) { if constexpr (F32) SLOAD_F((const float*)Kh, KBASE(1)); else SLOAD_H(Kh, Vh, KBASE(1)); }
    SBAR(); qkt<0, SK>(pA0, pA1, K_lds, r32, hi, S.qr, ACT(0));
    if constexpr (F32) { if (NT > 1) { VMW(); SWRITE_KF(1); SBAR(); SLOAD_F((const float*)Vh, KBASE(1)); } }
    MASKT(pA0, pA1, 0); partialSM(pA0, pA1, m_reg, mnA, alA);
    if (NT > 1) { VMW(); if constexpr (F32) { SWRITE_VF(1); SBAR(); if (NT > 2) SLOAD_F((const float*)Kh, KBASE(2)); } else SWRITE_H(1); }
    __syncthreads();
#define HALF_STEP(PX0, PX1, mnX, alX, PY0, PY1, alY, t, KB, VB, SB) do {                                                      \
        SBAR(); qkt<KB, SK>(PX0, PX1, K_lds, r32, hi, S.qr, ACT(t));                                             \
        finishSM(PY0, PY1, alY, l_reg, pa0, pa1, pa2, pa3); SBAR();                                                           \
        if ((t) + 1 < NT) { if constexpr (F32) { VMW(); SWRITE_KF(SB); SBAR(); SLOAD_F((const float*)Vh, KBASE((t) + 1)); }  \
                            else { SLOAD_H(Kh, Vh, KBASE((t) + 1)); } SBAR(); }                                               \
        pv_tile<VB, SK>(o, vb0, pa0, pa1, pa2, pa3, ACT((t) - 1)); MASKT(PX0, PX1, (t)); partialSM(PX0, PX1, m_reg, mnX, alX);                                        \
        __syncthreads();                                                                                                      \
        if ((t) + 1 < NT) { VMW(); if constexpr (F32) { SWRITE_VF(SB); SBAR(); if ((t) + 2 < NT) SLOAD_F((const float*)Kh, KBASE((t) + 2)); } \
                            else { SWRITE_H(SB); } }                                                                          \
        RESC(alX); __syncthreads(); } while (0)
    for (int t = 1; t + 1 < NT; t += 2) {
        HALF_STEP(pB0, pB1, mnB, alB, pA0, pA1, alA, t, 1, 0, 0);
        HALF_STEP(pA0, pA1, mnA, alA, pB0, pB1, alB, t + 1, 0, 1, 1);
    }
    const bool even = (NT & 1) == 0;
    if (even) { SBAR(); qkt<1, SK>(pB0, pB1, K_lds, r32, hi, S.qr, ACT(NT - 1)); SBAR(); }
#define QROW(e) (nxt.Q + HEADOFF(wid) + (size_t)(TOKOFF(wid) + r32) * QSTR + ((e) >> 1) * 16 + hi * 8 + ((e) & 1) * 4)
    if constexpr (F32) { SLOAD_F((const float*)nxt.K, kbn); SBAR();
#pragma unroll
        for (int e = 0; e < 8; ++e) S.tq[e] = *(const f32x4*)QROW(e); }
    else { SLOAD_H(nxt.K, nxt.V, kbn); SBAR();
#pragma unroll
        for (int d0 = 0; d0 < 8; ++d0) S.qr[d0] = load8<TIn>(nxt.Q + HEADOFF(wid) + (size_t)(TOKOFF(wid) + r32) * QSTR + d0 * 16 + hi * 8); }
    SBAR();
    finishSM(pA0, pA1, alA, l_reg, pa0, pa1, pa2, pa3); SBAR();
    if constexpr (F32) {
#pragma unroll
        for (int e = 8; e < 16; ++e) S.tq[e] = *(const f32x4*)QROW(e); SBAR(); }
#undef QROW
    pv_tile<0, SK>(o, vb0, pa0, pa1, pa2, pa3, ACT(even ? NT - 2 : NT - 1));
    if (even) { MASKT(pB0, pB1, NT - 1); partialSM(pB0, pB1, m_reg, mnB, alB); __syncthreads(); RESC(alB);
        finishSM(pB0, pB1, alB, l_reg, pa0, pa1, pa2, pa3); SBAR(); pv_tile<1, SK>(o, vb0, pa0, pa1, pa2, pa3, ACT(NT - 1)); }
    SBAR(); SEAM_K0();
    if (hi == 0) li_l[r32] = l_reg; asm volatile("s_waitcnt lgkmcnt(0)" ::: "memory");
    float rli[16];
#pragma unroll
    for (int r = 0; r < 16; ++r) rli[r] = __builtin_amdgcn_rcpf(li_l[crow(r, hi)]);
    TOut* Ow = cur.O + HEADOFF(wid) + (size_t)TOKOFF(wid) * OSTR;
#pragma unroll
    for (int r = 0; r < 16; ++r) { const int orow = crow(r, hi);
#pragma unroll
        for (int d0 = 0; d0 < 4; ++d0) { const float v = o[d0][r] * rli[r];
            if constexpr (same_t<TOut, float>::v) { Ow[(size_t)orow * OSTR + d0 * 32 + r32] = v; }
            else { const float vn = __shfl_xor(v, 1);
                   if ((r32 & 1) == 0) *(unsigned*)(Ow + (size_t)orow * OSTR + d0 * 32 + r32) = cvtpk(v, vn); } } }
    if constexpr (F32) {
#pragma unroll
        for (int d0 = 0; d0 < 8; ++d0) S.qr[d0] = pack8(S.tq[2 * d0], S.tq[2 * d0 + 1]); }
    __syncthreads();
#undef RESC
#undef KBASE
#undef ACT
#undef MASKT
#undef SEAM_K0
#undef HALF_STEP
}
#undef ROW
#undef VMW
#undef VMWN
#undef SLOAD_H
#undef SWRITE_HK
#undef SWRITE_HV
#undef SWRITE_H
#undef SLOAD_F
#undef SWRITE_KF
#undef SWRITE_VF
__host__ __device__ inline int swa_nramp(int nqb, int W, int qoff) { const int t = W - 1 - qoff; const int n = t < 0 ? 0 : t / PB + 1; return n > nqb ? nqb : n; }
__host__ __device__ inline int swa_nx(int nqb, int nramp, int order) { return (order & ORDER_PAIRED) ? (nramp + 1) / 2 + (nqb - nramp) : nqb; }
struct SwaItem { int bh, qb0, qb1; };
__device__ __forceinline__ SwaItem swa_decode(int L, int nb, int nh, int nhkv, int nqb, int nx, int nramp, int order) {
    const int G = nh / nhkv; SwaItem it; int x;
    if ((order & ORDER_XCD) && (nb * nhkv) % 8 == 0) { const int xcd = L & 7, k = L >> 3, per = G * nx, gi = k / per, r = k - gi * per;
        it.bh = (gi * 8 + xcd) * G + r / nx; x = r % nx; }
    else { it.bh = L / nx; x = L - it.bh * nx; }
    if (order & ORDER_PAIRED) { const int ns = nqb - nramp;
        if (x < ns) { it.qb0 = it.qb1 = nqb - 1 - x; } else { it.qb0 = x - ns; it.qb1 = nramp - 1 - it.qb0; } }
    else { it.qb0 = it.qb1 = ((order & 3) == ORDER_REVERSED) ? nqb - 1 - x : x; }
    return it;
}
}
template <int MODE>
__device__ __forceinline__ fa::BlockRef<bf16, bf16> fa_ref(unsigned char* ws, const fa::SwaItem& it, int pass) {
    const int tb = pass ? it.qb1 : it.qb0, b = it.bh >> 2, g = it.bh & 3;
    const bf16* P = (const bf16*)(ws + WS_P);
    fa::BlockRef<bf16, bf16> r;
    const size_t m0 = (size_t)b * SEQ + (size_t)tb * fa::PB;
    r.Q = P + m0 * NP + C_QB + g * RG * 128;
    r.K = P + (size_t)b * SEQ * NP + (MODE ? C_KS : C_KW) + g * 128;
    r.V = P + (size_t)b * SEQ * NP + (MODE ? C_VS : C_VW) + g * 128;
    r.O = (bf16*)(ws + (MODE ? WS_OSB : WS_OWB)) + m0 * DM + g * RG * 128;
    r.SELP = (const unsigned*)(ws + WS_SEL) + m0 * GKV + g;
    r.P0 = tb * fa::PB;
    return r;
}
template <int MODE>
__device__ __forceinline__ void fa_phase(const Ctx& C, char* lds, int nwg  ) {
    using namespace fa;
    constexpr int W = MODE == 0 ? WIN : SEQ;
    constexpr int nqb = SEQ / PB, order = ORDER_PAIRED | ORDER_XCD;
    const int nramp = swa_nramp(nqb, W, 0), nx = swa_nx(nqb, nramp, order), total = nx * BATCH * GKV, stride = nwg;
    int L = (MODE == 0 && nwg == C.G) ? (C.bid + C.G / 2) % C.G : C.bid;
    if (L >= total || C.bid >= nwg) return;
    SwaItem it = swa_decode(L, BATCH, GKV, GKV, nqb, nx, nramp, order); int pass = 0;
    BlockRef<bf16, bf16> cur = fa_ref<MODE>(C.ws, it, 0);
    Seam<bf16> S;
    causal_swa_prime<bf16, bf16>(cur, W, lds, S);
    for (;;) {
        const bool more_pass = pass == 0 && it.qb1 != it.qb0, more_item = L + stride < total, last = !more_pass && !more_item;
        SwaItem itn = it; int passn = pass + 1, Ln = L;
        if (!more_pass) { passn = 0; Ln = more_item ? L + stride : L; itn = swa_decode(Ln, BATCH, GKV, GKV, nqb, nx, nramp, order); }
        const BlockRef<bf16, bf16> nxt = last ? cur : fa_ref<MODE>(C.ws, itn, passn);
        causal_swa_block<MODE, bf16, bf16>(cur, nxt, SEQ, W, lds, S);
        if (last) break;
        cur = nxt; it = itn; pass = passn; L = Ln;
    }
}
__device__ __forceinline__ void nsa_combine(const Ctx& C) {
    const bf16* P = WSP(bf16, WS_P); const bf16* OC = WSP(bf16, WS_OCB); const bf16* OS = WSP(bf16, WS_OSB); const bf16* OW = WSP(bf16, WS_OWB); bf16* OB = WSP(bf16, WS_OB);
    for (int idx = C.bid * NTHR + C.tid; idx < T * 256; idx += C.G * NTHR) {
        const int m = idx >> 8, col = (idx & 255) * 8, hb = col >> 7;
        const bf16* gp = P + (size_t)m * NP + C_GB + hb * 3;
        const float g0 = sigmoidf_(bf2f(gp[0])), g1 = sigmoidf_(bf2f(gp[1])), g2 = sigmoidf_(bf2f(gp[2]));
        const size_t o = (size_t)m * DM + col;
        const v4u cw = *(const v4u*)(OC + o);
        const f32x4 c0 = {bflo(cw.x), bfhi(cw.x), bflo(cw.y), bfhi(cw.y)}, c1 = {bflo(cw.z), bfhi(cw.z), bflo(cw.w), bfhi(cw.w)};
        const v4u sw = *(const v4u*)(OS + o), ww = *(const v4u*)(OW + o);
        v4u r;
        r.x = pk2(g0 * c0.x + g1 * bflo(sw.x) + g2 * bflo(ww.x), g0 * c0.y + g1 * bfhi(sw.x) + g2 * bfhi(ww.x));
        r.y = pk2(g0 * c0.z + g1 * bflo(sw.y) + g2 * bflo(ww.y), g0 * c0.w + g1 * bfhi(sw.y) + g2 * bfhi(ww.y));
        r.z = pk2(g0 * c1.x + g1 * bflo(sw.z) + g2 * bflo(ww.z), g0 * c1.y + g1 * bfhi(sw.z) + g2 * bfhi(ww.z));
        r.w = pk2(g0 * c1.z + g1 * bflo(sw.w) + g2 * bflo(ww.w), g0 * c1.w + g1 * bfhi(sw.w) + g2 * bfhi(ww.w));
        *(v4u*)(OB + o) = r;
    }
}
#ifndef MK_N_LAUNCHES
#define MK_N_LAUNCHES 1
#endif
constexpr int N_PHASES = 13;
#ifndef FA1_WGS
#define FA1_WGS 171
#endif
#ifndef CONV_P4
#define CONV_P4 40000
#endif

__global__ void __launch_bounds__(NTHR, 2) fwd(Args args) {
    extern __shared__ __attribute__((aligned(16))) unsigned char lds_raw[];
    Ctx C;
    C.lds = (LAS unsigned char*)lds_raw; C.tid = threadIdx.x; C.lane = C.tid & 63; C.wave = __builtin_amdgcn_readfirstlane(C.tid >> 6); C.G = gridDim.x; C.bid = blockIdx.x;
    C.A = &args;
    C.out = args.out; C.ws = args.ws; C.ctl = (unsigned*)(args.ws + WS_CTL);
    volatile LAS unsigned* MISC = (volatile LAS unsigned*)(C.lds + MISC_OFF);
    if (C.tid < 32) MISC[C.tid] = 0u;
    __syncthreads();
    const int lo = args.ph_lo, hi = args.ph_hi;
    XcdBarrier bar; bar.bar = C.ctl + CW_BAR + args.li * 4096; bar.x = 0; bar.st = nullptr;
    if (hi - lo > 1) bar = xcd_barrier_post(C.ctl + CW_BAR + args.li * 4096, MISC + 8);
#ifndef PH_MASK
#define PH_MASK 0x1FFF
#endif
#define IN(k) (((PH_MASK >> (k)) & 1) && lo <= (k) && (k) < hi)
#define PH_BEGIN() do { int t_ = threadIdx.x; asm volatile("" : "+v"(t_)); C.tid = t_; C.lane = t_ & 63; } while (0)
#define SEAM(k) do { if (IN(k) && IN((k) + 1)) xcd_barrier(bar); } while (0)
    bf16* P = WSP(bf16, WS_P);
    if (IN(0)) { PH_BEGIN(); p0_prologue(C); SEAM(0); }
    if (IN(1)) { PH_BEGIN();
        pg8::Gemm g{WSP(bf16, WS_H), WSP(bf16, WS_WINT), T, 17408, DM}; pg8::StaticOrder S; S.init(T, 17408, C.G, C.bid);
        EpiP1 E{P, WSP(float, WS_RC), WSP(float, WS_RS)};
        pg8::gemm_phase<EpiP1, pg8::StaticOrder, PG8_ALIGN, PG8_SP2>(C.lds + RING_OFF, g, S, E);
        if (args.pad != 1) small_proj(C);
        SEAM(1);
    }
    const int sub = args.pad;
    if (IN(2)) { PH_BEGIN(); if (sub != 2) dn_chunk_prep(C, C.bid * NWAVES + C.wave, C.G * NWAVES); if (sub != 1) nsa_compress2(C); SEAM(2); }
    if (IN(3)) { PH_BEGIN();
        const int half = C.G / 2;
#ifndef X_NO_SCAN
        if (C.bid < half && sub != 2 && sub != 4) { for (int u = C.bid; u < BATCH * HA; u += half) dn_scan(C, u); }
#endif
#ifndef X_NO_CMP
        if (C.bid >= half && sub != 2 && sub != 3) nsa_cmp_attn2(C, C.bid - half, C.G - half);
#endif
        __syncthreads();
#ifndef X_NO_FA0
        if (sub != 1) fa_phase<0>(C, (char*)lds_raw + RING_OFF, C.G);
#endif
        SEAM(3);
    }
    if (IN(4)) { PH_BEGIN();
        const int nfa = C.G > FA1_WGS ? FA1_WGS : C.G;
        if (sub != 2) fa_phase<1>(C, (char*)lds_raw + RING_OFF, nfa);
        if (sub == 0 && C.bid >= nfa) moe_weight_convert(C, 0, CONV_P4, (C.bid - nfa) * NWAVES + C.wave, (C.G - nfa) * NWAVES);
        if (sub != 1) dn_post2(C); SEAM(4); }
    if (IN(5)) { PH_BEGIN(); nsa_combine(C); SEAM(5); }
    if (IN(6)) { PH_BEGIN();
        { pg8::Gemm g{WSP(bf16, WS_OA), WSP(bf16, WS_WPA), T, DM, DM}; pg8::StaticOrder S; S.init(T, DM, C.G, C.bid);
          EpiProj<0> E{P, WSP(bf16, WS_M1), WSP(bf16, WS_MERGED)};
          pg8::gemm_phase<EpiProj<0>, pg8::StaticOrder, PG8_ALIGN, PG8_SP2>(C.lds + RING_OFF, g, S, E); }
        { pg8::Gemm g{WSP(bf16, WS_OB), WSP(bf16, WS_WPB), T, DM, DM}; pg8::StaticOrder S; S.init(T, DM, C.G, C.bid);
          EpiProj<1> E{P, WSP(bf16, WS_M1), WSP(bf16, WS_MERGED)};
          pg8::gemm_phase<EpiProj<1>, pg8::StaticOrder, PG8_ALIGN, PG8_SP2>(C.lds + RING_OFF, g, S, E); }
        SEAM(6);
    }
    if (IN(7)) { PH_BEGIN();
        pg8::Gemm g{WSP(bf16, WS_MERGED), WSP(bf16, WS_WOT), T, DM, DM}; pg8::StaticOrder S; S.init(T, DM, C.G, C.bid);
        EpiOut E{((const float*)C.A->in[0]), WSP(float, WS_X1), WSP(bf16, WS_HN), ((const float*)C.A->in[17])};
        pg8::gemm_phase<EpiOut, pg8::StaticOrder, PG8_ALIGN, PG8_SP2>(C.lds + RING_OFF, g, S, E);
        SEAM(7);
    }
    if (IN(8)) { PH_BEGIN(); p7_norm_router(C); moe_weight_convert(C, (C.G > FA1_WGS) ? CONV_P4 : 0, 1 << 30, C.wave < 2 ? -1 : C.bid * (NWAVES - 2) + C.wave - 2, C.G * (NWAVES - 2)); SEAM(8); }
    if (IN(9)) { PH_BEGIN(); p8_gather(C); SEAM(9); }
    if (IN(10)) { PH_BEGIN();
        int total; moe_tables(C, 16, total);
        pg8::Gemm g{WSP(bf16, WS_XG), WSP(bf16, WS_WGU), MOE_ROWS, NEXP * 4096, DM};
        MoeOrder<false> S{(const LAS int*)(C.lds + TAB_OFF), 16, C.G, C.bid, total, nullptr};
        EpiMoe1 E{WSP(bf16, WS_ACT), ((const float*)C.A->in[21]), ((const float*)C.A->in[23])};
        pg8::gemm_phase<EpiMoe1, MoeOrder<false>, PG8_ALIGN, PG8_SP2>(C.lds + RING_OFF, g, S, E);
        SEAM(10);
    }
    if (IN(11)) { PH_BEGIN();
        int total; moe_tables(C, 8, total);
        pg8::Gemm g{WSP(bf16, WS_ACT), WSP(bf16, WS_WD), MOE_ROWS, NEXP * DM, DFF};
        MoeOrder<false> S{(const LAS int*)(C.lds + TAB_OFF), 8, C.G, C.bid, total, nullptr};
        EpiMoe2 E{WSP(bf16, WS_Y), ((const float*)C.A->in[25])};
        pg8::gemm_phase<EpiMoe2, MoeOrder<false>, PG8_ALIGN, PG8_SP2>(C.lds + RING_OFF, g, S, E);
        SEAM(11);
    }
    if (IN(12)) { PH_BEGIN(); p11_final(C); }
}

extern "C" void kernel_launch(void* const* d_in, const int* in_sizes, int n_in, void* d_out, int out_size, void* d_ws, size_t ws_size, hipStream_t stream) {
    static int grid = 0;
    if (grid == 0) {
        if (n_in != 27 || out_size != T * DM || ws_size < WS_END) { fprintf(stderr, "kernel_launch: unexpected shapes (n_in %d out %d ws %zu)\n", n_in, out_size, ws_size); grid = -1; return; }
        int dev = 0, cus = 0, per_cu = 0;
        if (hipGetDevice(&dev) != hipSuccess || hipDeviceGetAttribute(&cus, hipDeviceAttributeMultiprocessorCount, dev) != hipSuccess) { grid = -1; return; }
        if (hipFuncSetAttribute((const void*)fwd, hipFuncAttributeMaxDynamicSharedMemorySize, LDS_BYTES) != hipSuccess) { fprintf(stderr, "kernel_launch: hipFuncSetAttribute failed\n"); grid = -1; return; }
        if (hipOccupancyMaxActiveBlocksPerMultiprocessor(&per_cu, (const void*)fwd, NTHR, LDS_BYTES) != hipSuccess || per_cu < 1) fprintf(stderr, "kernel_launch: occupancy query says %d\n", per_cu);
        (void)hipGetLastError();
        grid = cus;
    }
    if (grid < 0) return;
    if (hipMemsetAsync((char*)d_ws + WS_CTL, 0, CTL_ZERO_BYTES, stream) != hipSuccess) return;
    Args a{};
    for (int i = 0; i < 27; ++i) a.in[i] = d_in[i];
    a.out = (float*)d_out; a.ws = (unsigned char*)d_ws;
#if MK_N_LAUNCHES == 1
    const int cuts[2] = {0, N_PHASES}; const int nl = 1;
#else
    int cuts[N_PHASES + 1]; for (int i = 0; i <= N_PHASES; ++i) cuts[i] = i; const int nl = N_PHASES;
#endif
    for (int li = 0; li < nl; ++li) {
        a.ph_lo = cuts[li]; a.ph_hi = cuts[li + 1]; a.li = li; a.pad = 0;
        hipLaunchKernelGGL(fwd, dim3(grid), dim3(NTHR), LDS_BYTES, stream, a);
        const hipError_t le = hipPeekAtLastError();
        if (le != hipSuccess) { fprintf(stderr, "kernel_launch: launch %d failed: %s\n", li, hipGetErrorName(le)); break; }
    }
#if defined(PROBE_LO)
    { a.ph_lo = PROBE_LO; a.ph_hi = PROBE_HI; a.li = 1;
#if defined(PROBE_SUB)
      a.pad = PROBE_SUB;
#else
      a.pad = 0;
#endif
 hipLaunchKernelGGL(fwd, dim3(grid), dim3(NTHR), LDS_BYTES, stream, a); }
#endif
}
```

```cpp
#include <hip/hip_runtime.h>
#include <cstdio>
#include <cstdint>
#ifndef STATIC_B_TILED
#define STATIC_B_TILED 1
#endif
namespace pg8 {
#define PG8_LAS __attribute__((address_space(3)))
typedef unsigned short bf16_t;
typedef short bf16x8 __attribute__((ext_vector_type(8)));
typedef float f32x4 __attribute__((ext_vector_type(4)));
typedef unsigned u32x4 __attribute__((ext_vector_type(4)));
constexpr int BM = 256, BK = 64, HALF = 128, HTB = HALF * BK * 2  , STAGE_BYTES = 8 * HTB, NXCD = 8, WGM = 8;

__host__ __device__ __forceinline__ int lds_byte(int r, int c) { const int st = (r >> 4) * 2 + (c >> 5), rr = r & 15, cc = c & 31, ob = rr * 64 + cc * 2; return st * 1024 + (ob ^ (((ob >> 9) & 1) << 5)); }
__host__ __device__ __forceinline__ void stage_rc(int b, int& R, int& C) { const int st = b / 1024, sb = b % 1024, swz = sb ^ (((sb >> 9) & 1) << 5); R = (st >> 1) * 16 + swz / 64; C = (st & 1) * 32 + (swz % 64) / 2; }
__host__ __device__ __forceinline__ int perm32(int rho) { const int n = rho >> 4, i = rho & 15; return 8 * (i >> 2) + 4 * n + (i & 3); }

typedef int i32x8_ __attribute__((ext_vector_type(8)));
typedef int i32x4_ __attribute__((ext_vector_type(4)));
__device__ __forceinline__ f32x4 mfma_fp8_k128(bf16x8 b0, bf16x8 b1, bf16x8 a0, bf16x8 a1, f32x4 c) {
    const i32x4_ B0 = __builtin_bit_cast(i32x4_, b0), B1 = __builtin_bit_cast(i32x4_, b1), A0 = __builtin_bit_cast(i32x4_, a0), A1 = __builtin_bit_cast(i32x4_, a1);
    const i32x8_ B = __builtin_shufflevector(B0, B1, 0, 1, 2, 3, 4, 5, 6, 7), A = __builtin_shufflevector(A0, A1, 0, 1, 2, 3, 4, 5, 6, 7);
    f32x4 r = c; const int one = 0x7F7F7F7F;
    asm volatile("v_mfma_scale_f32_16x16x128_f8f6f4 %0, %1, %2, %0, %3, %3 op_sel_hi:[0,0,0]" : "+v"(r) : "v"(B), "v"(A), "v"(one));
    return r;
}
struct Unit { int pm, pn; };
struct Gemm { const bf16_t* A; const bf16_t* Bt; int M, N, K; };

template <bool F8> struct StaticOrderT {
    static constexpr bool GATHER = false;
    static constexpr int B_AUX = 0;
#ifndef STATIC_B_TILED
#define STATIC_B_TILED 0
#endif
    static constexpr bool FP8 = F8;
    static constexpr bool B_TILED = STATIC_B_TILED;
    __device__ __forceinline__ bool upper_half_empty(const Unit&) const { return false; }
    int nM, nN, nwg, G, c;
    __host__ __device__ void init(int M, int N, int G_, int c_) { nM = M / BM; nN = N / BM; nwg = nM * nN; G = G_; c = c_; }
    __host__ __device__ bool next(int i, Unit& u) const {
        const long L = (long)i * G + c; if (L >= nwg) return false;
        int wgid = (int)L; { const int q = nwg / NXCD, r = nwg % NXCD, xcd = wgid % NXCD, off = wgid / NXCD; wgid = (xcd < r ? xcd * (q + 1) : r * (q + 1) + (xcd - r) * q) + off; }
        const int nig = WGM * nN, gid = wgid / nig, fm = gid * WGM, gsz = (nM - fm) < WGM ? (nM - fm) : WGM;
        u.pm = fm + ((wgid % nig) % gsz); u.pn = (wgid % nig) / gsz; return true;
    }
    __device__ __forceinline__ void a_ready(const Unit&) const {}
    __device__ __forceinline__ void done(const Unit&) const {}
};
typedef StaticOrderT<false> StaticOrder;

__device__ __forceinline__ unsigned cvt_pk_bf16(float lo, float hi) { unsigned r; asm volatile("v_cvt_pk_bf16_f32 %0, %1, %2" : "=v"(r) : "v"(lo), "v"(hi)); return r; }
typedef float f32x2 __attribute__((ext_vector_type(2)));

template <class Epi, class Sched, bool ALIGN_EPI = false, bool SP2 = false>
__device__ __forceinline__ void gemm_phase(PG8_LAS unsigned char* lds, const Gemm g, const Sched& S, const Epi& E) {
    const int tid = threadIdx.x, wid = __builtin_amdgcn_readfirstlane(tid >> 6), lane = tid & 63, wr = wid >> 2, wc = wid & 3, fr = lane & 15, fq = lane >> 4;
    const int K = g.K, nt = K / BK;
    unsigned voffA[2], voffB[2];
#pragma unroll
    for (int i = 0; i < 2; ++i) { int R, C; stage_rc(tid * 16 + i * 8192, R, C); const int Rb = Epi::PERM ? ((R & ~31) + perm32(R & 31)) : R;
        voffA[i] = (unsigned)(R * K + C) * 2u; voffB[i] = Sched::B_TILED ? (unsigned)((Rb >> 6) * (K >> 6) * 8192 + (Rb & 63) * 128 + C * 2) : (unsigned)(Rb * K + C) * 2u; }
    const size_t kstep = (size_t)(BK * 2);
    const size_t kstepB = Sched::B_TILED ? (size_t)8192 : (size_t)(BK * 2);
    const size_t hstep = (size_t)HALF * K * 2;
    const size_t tstep = 2 * hstep;
    const unsigned ldsw = (unsigned)wid * 1024u;
    const int aoff = lds_byte(wr * 64 + fr, fq * 8), boff = lds_byte(wc * 32 + fr, fq * 8);
#define PG8_SA(b, h) (((b) * 2 + (h)) * HTB)
#define PG8_SB(b, h) ((4 + (b) * 2 + (h)) * HTB)
#define PG8_STAGE(bufoff, gbase, voff) do { _Pragma("unroll") for (int _i = 0; _i < 2; ++_i) \
        __builtin_amdgcn_global_load_lds((const unsigned*)((const char*)(gbase) + (voff)[_i]), (PG8_LAS unsigned*)(lds + (bufoff) + ldsw + _i * 8192), 16, 0, 0); } while (0)
#define PG8_STAGE_BW(bufoff, gbase, voff) do { _Pragma("unroll") for (int _i = 0; _i < 2; ++_i) \
        __builtin_amdgcn_global_load_lds((const unsigned*)((const char*)(gbase) + (voff)[_i]), (PG8_LAS unsigned*)(lds + (bufoff) + ldsw + _i * 8192), 16, 0, Sched::B_AUX); } while (0)
#define PG8_LDA(dst, b, h) do { _Pragma("unroll") for (int m = 0; m < 4; ++m) _Pragma("unroll") for (int k = 0; k < 2; ++k) dst[m][k] = *(const PG8_LAS bf16x8*)(lds + PG8_SA(b, h) + aoff + m * 2048 + k * 1024); } while (0)
#define PG8_LDB(dst, b, h) do { _Pragma("unroll") for (int n = 0; n < 2; ++n) _Pragma("unroll") for (int k = 0; k < 2; ++k) dst[n][k] = *(const PG8_LAS bf16x8*)(lds + PG8_SB(b, h) + boff + n * 2048 + k * 1024); } while (0)
#define PG8_MMA(ai, bj, At, Bt) do { __builtin_amdgcn_s_setprio(1); _Pragma("unroll") for (int m = 0; m < 4; ++m) _Pragma("unroll") for (int n = 0; n < 2; ++n) { \
        if constexpr (Sched::FP8) acc[ai][bj][m][n] = mfma_fp8_k128(Bt[n][0], Bt[n][1], At[m][0], At[m][1], acc[ai][bj][m][n]); \
        else { _Pragma("unroll") for (int k = 0; k < 2; ++k) acc[ai][bj][m][n] = __builtin_amdgcn_mfma_f32_16x16x32_bf16(Bt[n][k], At[m][k], acc[ai][bj][m][n], 0, 0, 0); } } __builtin_amdgcn_s_setprio(0); } while (0)
#define PG8_WAIT_V(n) asm volatile("s_waitcnt vmcnt(" #n ")" ::: "memory")
#define PG8_WAIT_L(n) asm volatile("s_waitcnt lgkmcnt(" #n ")" ::: "memory")
#define PG8_BAR __builtin_amdgcn_s_barrier()
#define PG8_SCHED __builtin_amdgcn_sched_barrier(0)
    Unit cur, nxt; int ui = 0;
    if (!S.next(0, cur)) return;
    unsigned vGc[2][2] = {{0u, 0u}, {0u, 0u}}, vGn[2][2] = {{0u, 0u}, {0u, 0u}};
    if constexpr (Sched::GATHER) {
#pragma unroll
        for (int h = 0; h < 2; ++h)
#pragma unroll
            for (int i = 0; i < 2; ++i) { int R, Cc; stage_rc(tid * 16 + i * 8192, R, Cc); vGc[h][i] = S.row_of(cur, h * HALF + R) * (unsigned)(K * 2) + (unsigned)(Cc * 2); }
    }
#define PG8_STAGE_A(bufoff, aptr, half, nx) do { if constexpr (Sched::GATHER) { _Pragma("unroll") for (int _i = 0; _i < 2; ++_i) { const unsigned _vo = (nx) ? vGn[half][_i] : vGc[half][_i]; \
        __builtin_amdgcn_global_load_lds((const unsigned*)((const char*)(aptr) + _vo), (PG8_LAS unsigned*)(lds + (bufoff) + ldsw + _i * 8192), 16, 0, 0); } } \
        else { PG8_STAGE(bufoff, (aptr) + ((half) ? hstep : 0), voffA); } } while (0)
    f32x4 acc[2][2][4][2];
#pragma unroll
    for (int a = 0; a < 2; ++a)
#pragma unroll
        for (int b = 0; b < 2; ++b)
#pragma unroll
            for (int m = 0; m < 4; ++m)
#pragma unroll
                for (int n = 0; n < 2; ++n) acc[a][b][m][n] = (f32x4){0.f, 0.f, 0.f, 0.f};
    bf16x8 At[4][2], B0[2][2], B1[2][2];
    const char* cA = (const char*)g.A + (Sched::GATHER ? (size_t)0 : (size_t)cur.pm * tstep); const char* cB = (const char*)g.Bt + (size_t)cur.pn * tstep;
    S.a_ready(cur);
    if constexpr (SP2) {
        PG8_STAGE_BW(PG8_SB(0, 0), cB, voffB); PG8_STAGE_BW(PG8_SB(0, 1), cB + hstep, voffB); PG8_STAGE_A(PG8_SA(0, 0), cA, 0, false); PG8_STAGE_A(PG8_SA(0, 1), cA, 1, false);
        if (wr == 1) PG8_BAR;
        PG8_WAIT_V(2); PG8_BAR;
        PG8_STAGE_BW(PG8_SB(1, 0), cB + kstepB, voffB); PG8_STAGE_A(PG8_SA(1, 0), cA + kstep, 0, false); PG8_STAGE_BW(PG8_SB(1, 1), cB + hstep + kstepB, voffB);
        PG8_WAIT_V(6); PG8_BAR;
    } else {
        PG8_STAGE_BW(PG8_SB(0, 0), cB, voffB); PG8_STAGE_A(PG8_SA(0, 0), cA, 0, false); PG8_STAGE_BW(PG8_SB(0, 1), cB + hstep, voffB); PG8_STAGE_A(PG8_SA(0, 1), cA, 1, false);
        if (wr == 1) PG8_BAR;
        PG8_WAIT_V(4); PG8_BAR;
        PG8_STAGE_BW(PG8_SB(1, 0), cB + kstepB, voffB); PG8_STAGE_A(PG8_SA(1, 0), cA + kstep, 0, false); PG8_STAGE_BW(PG8_SB(1, 1), cB + hstep + kstepB, voffB);
        PG8_WAIT_V(6); PG8_BAR;
    }
    for (;;) {
        const bool has_next = S.next(ui + 1, nxt);
        if constexpr (Sched::GATHER) { if (has_next) {
#pragma unroll
            for (int h = 0; h < 2; ++h)
#pragma unroll
                for (int i = 0; i < 2; ++i) { int R, Cc; stage_rc(tid * 16 + i * 8192, R, Cc); vGn[h][i] = S.row_of(nxt, h * HALF + R) * (unsigned)(K * 2) + (unsigned)(Cc * 2); } }
            else { vGn[0][0] = vGc[0][0]; vGn[0][1] = vGc[0][1]; vGn[1][0] = vGc[1][0]; vGn[1][1] = vGc[1][1]; } }
        const char* nA = (has_next && !Sched::GATHER) ? (const char*)g.A + (size_t)nxt.pm * tstep : cA; const char* nB = has_next ? (const char*)g.Bt + (size_t)nxt.pn * tstep : cB;
        for (int t = 0; t < nt; t += 2) {
            const bool last = (t == nt - 2);
            const char* a1 = cA + (size_t)(t + 1) * kstep;
            const char* a2 = last ? nA : cA + (size_t)(t + 2) * kstep; const char* b2 = last ? nB : cB + (size_t)(t + 2) * kstepB;
            const char* a3 = a2 + kstep; const char* b3 = b2 + kstepB;
            if (last && has_next) S.a_ready(nxt);
            if constexpr (SP2) {
            PG8_LDB(B0, 0, 0); PG8_LDB(B1, 0, 1); PG8_SCHED; PG8_LDA(At, 0, 0); PG8_STAGE_A(PG8_SA(1, 1), a1, 1, false);
            PG8_WAIT_V(8); PG8_WAIT_L(0); PG8_BAR; PG8_MMA(0, 0, At, B0); PG8_MMA(0, 1, At, B1); PG8_BAR; PG8_SCHED;
            PG8_LDA(At, 0, 1); PG8_STAGE_BW(PG8_SB(0, 0), b2, voffB); PG8_STAGE_BW(PG8_SB(0, 1), b2 + hstep, voffB); PG8_STAGE_A(PG8_SA(0, 0), a2, 0, last);
            PG8_WAIT_V(8); PG8_WAIT_L(0); PG8_BAR; PG8_MMA(1, 0, At, B0); PG8_MMA(1, 1, At, B1); PG8_BAR; PG8_SCHED;
            PG8_LDB(B0, 1, 0); PG8_LDB(B1, 1, 1); PG8_SCHED; PG8_LDA(At, 1, 0); PG8_STAGE_A(PG8_SA(0, 1), a2, 1, last);
            PG8_WAIT_V(8); PG8_WAIT_L(0); PG8_BAR; PG8_MMA(0, 0, At, B0); PG8_MMA(0, 1, At, B1); PG8_BAR; PG8_SCHED;
            PG8_LDA(At, 1, 1); PG8_STAGE_BW(PG8_SB(1, 0), b3, voffB); PG8_STAGE_BW(PG8_SB(1, 1), b3 + hstep, voffB); PG8_STAGE_A(PG8_SA(1, 0), a3, 0, last);
            PG8_WAIT_V(8); PG8_WAIT_L(0); PG8_BAR; PG8_MMA(1, 0, At, B0); PG8_MMA(1, 1, At, B1); PG8_BAR; PG8_SCHED;
            } else {
            PG8_LDB(B0, 0, 0); PG8_SCHED; PG8_LDA(At, 0, 0); PG8_STAGE_A(PG8_SA(1, 1), a1, 1, false);
            PG8_WAIT_L(8); PG8_BAR; PG8_WAIT_L(0); PG8_MMA(0, 0, At, B0); PG8_BAR; PG8_SCHED;
            PG8_LDB(B1, 0, 1); PG8_STAGE_BW(PG8_SB(0, 0), b2, voffB);
            PG8_BAR; PG8_WAIT_L(0); PG8_MMA(0, 1, At, B1); PG8_BAR;
            PG8_LDA(At, 0, 1); PG8_STAGE_A(PG8_SA(0, 0), a2, 0, last);
            PG8_BAR; PG8_WAIT_L(0); PG8_MMA(1, 0, At, B0); PG8_BAR; PG8_SCHED;
            PG8_STAGE_BW(PG8_SB(0, 1), b2 + hstep, voffB);
            PG8_WAIT_V(6); PG8_BAR; PG8_MMA(1, 1, At, B1); PG8_BAR;
            PG8_LDB(B0, 1, 0); PG8_SCHED; PG8_LDA(At, 1, 0); PG8_STAGE_A(PG8_SA(0, 1), a2, 1, last);
            PG8_WAIT_L(8); PG8_BAR; PG8_WAIT_L(0); PG8_MMA(0, 0, At, B0); PG8_BAR; PG8_SCHED;
            PG8_LDB(B1, 1, 1); PG8_STAGE_BW(PG8_SB(1, 0), b3, voffB);
            PG8_BAR; PG8_WAIT_L(0); PG8_MMA(0, 1, At, B1); PG8_BAR;
            PG8_LDA(At, 1, 1); PG8_STAGE_A(PG8_SA(1, 0), a3, 0, last);
            PG8_BAR; PG8_WAIT_L(0); PG8_MMA(1, 0, At, B0); PG8_BAR; PG8_SCHED;
            PG8_STAGE_BW(PG8_SB(1, 1), b3 + hstep, voffB);
            PG8_WAIT_V(6); PG8_BAR; PG8_MMA(1, 1, At, B1); PG8_BAR;
            }
        }
        if constexpr (ALIGN_EPI) { if (wr == 0) PG8_BAR; }
        if constexpr (Sched::FP8) asm volatile("s_nop 15\n\ts_nop 15\n\ts_nop 15\n\ts_nop 15\n\ts_nop 15" ::: "memory");
        if constexpr (!Epi::AFTER_DRAIN) { E(acc, cur, wr, wc, fr, fq); S.done(cur); }
        if (!has_next) break;
#pragma unroll
        for (int a = 0; a < 2; ++a)
#pragma unroll
            for (int b = 0; b < 2; ++b)
#pragma unroll
                for (int m = 0; m < 4; ++m)
#pragma unroll
                    for (int n = 0; n < 2; ++n) acc[a][b][m][n] = (f32x4){0.f, 0.f, 0.f, 0.f};
        cur = nxt; cA = nA; cB = nB; ++ui;
        if constexpr (Sched::GATHER) { vGc[0][0] = vGn[0][0]; vGc[0][1] = vGn[0][1]; vGc[1][0] = vGn[1][0]; vGc[1][1] = vGn[1][1]; }
        if constexpr (ALIGN_EPI) { if (wr == 1) PG8_BAR; }
    }
    PG8_WAIT_V(0);
    if constexpr (!ALIGN_EPI) { if (wr == 0) PG8_BAR; }
    PG8_BAR;
    if constexpr (Epi::AFTER_DRAIN) { E.fused(acc, cur, wr, wc, fr, fq, lds, wid, lane); S.done(cur); }
#undef PG8_SA
#undef PG8_SB
#undef PG8_STAGE
#undef PG8_STAGE_BW
#undef PG8_STAGE_A
#undef PG8_LDA
#undef PG8_LDB
#undef PG8_MMA
#undef PG8_WAIT_V
#undef PG8_WAIT_L
#undef PG8_BAR
#undef PG8_SCHED
}
}
#ifndef PG8_SP2
#define PG8_SP2 true
#endif
#ifndef MOE_SP2
#define MOE_SP2 PG8_SP2
#endif
#ifndef PG8_ALIGN
#define PG8_ALIGN true
#endif
constexpr int NWAVES = 8, NTHR = 512;
constexpr int BATCH = 8, SEQ = 2048, DM = 2048, T = BATCH * SEQ;
constexpr int HA = 16, DKA = 128, CHUNK = 64;
constexpr int HB = 16, GKV = 4, RG = 4, DH = 128;
constexpr int NCMP = 127, NSLC = 32, WIN = 512;
constexpr int NEXP = 32, TOPK = 4, DFF = 2048;
constexpr int DIN = 17488, NP = 17664;
constexpr int C_QA = 0, C_KA = 2048, C_VA = 4096, C_ZA = 6144, C_QB = 8192, C_KC = 10240, C_VC = 10752, C_KS = 11264, C_VS = 11776,
              C_KW = 12288, C_VW = 12800, C_GM = 13312, C_AA = 17408, C_BA = 17424, C_GB = 17440;
constexpr unsigned long long ROTMASK = (0x3FFull << 32) | (3ull << 44) | (3ull << 48);
constexpr float EPS = 1e-6f;
constexpr int MOE_ROWS = T * TOPK + NEXP * 256;

constexpr size_t MiB = 1u << 20;
constexpr size_t WS_CTL = 0, CTL_ZERO_BYTES = 1 * MiB;
constexpr size_t WS_RC = 1 * MiB, WS_RS = 2 * MiB, WS_G = 3 * MiB, WS_BETA = 4 * MiB, WS_KCMP = 5 * MiB, WS_VCMP = 7 * MiB, WS_SEL = 9 * MiB;
constexpr size_t WS_TOPE = 10 * MiB, WS_TOPW = WS_TOPE + 256 * 1024, WS_POS = WS_TOPW + 256 * 1024, WS_DEST = WS_POS + 256 * 1024;
constexpr size_t WS_WINT = 16 * MiB, WS_WPA = 85 * MiB, WS_WPB = 93 * MiB, WS_WOT = 101 * MiB;
constexpr size_t WS_H = 112 * MiB, WS_OWB = 112 * MiB, WS_OB = 176 * MiB, WS_P = 240 * MiB;
constexpr size_t WS_H8 = 176 * MiB;
constexpr size_t WS_OSB = 792 * MiB, WS_OA = 856 * MiB, WS_M1 = 920 * MiB, WS_MERGED = 984 * MiB, WS_OCB = 1112 * MiB;
constexpr size_t WS_WGU = 1280 * MiB, WS_WD = 1792 * MiB, WS_END = 2048 * MiB;
constexpr size_t WS_X1 = 240 * MiB, WS_HN = 368 * MiB, WS_XG = 432 * MiB, WS_ACT = 720 * MiB, WS_Y = 432 * MiB;
static_assert(WS_P + (size_t)T * NP * 2 <= WS_OSB && WS_ACT + (size_t)MOE_ROWS * DFF * 2 <= WS_WGU && WS_WINT + (size_t)NP * DM * 2 <= WS_WPA, "ws map");
constexpr int CW_BAR = 4096;
constexpr int CW_CNT = 2048;
constexpr int CW_CQ = 2304;

constexpr int RING_OFF = 0, RING_BYTES = 131072;
constexpr int XTRA_OFF = RING_BYTES;
constexpr int TAB_OFF = 145920;
constexpr int MISC_OFF = 146944;
constexpr int LDS_BYTES = 147456;

#define GAS __attribute__((address_space(1)))
#define LAS __attribute__((address_space(3)))
typedef unsigned short bf16;
typedef unsigned v4u __attribute__((ext_vector_type(4)));
typedef unsigned v2u __attribute__((ext_vector_type(2)));
typedef float f32x4 __attribute__((ext_vector_type(4)));
typedef short bf16x8 __attribute__((ext_vector_type(8)));
#define LDS_WAIT() asm volatile("s_waitcnt lgkmcnt(0)" ::: "memory")
#define VM_WAIT() asm volatile("s_waitcnt vmcnt(0)" ::: "memory")
__device__ __forceinline__ unsigned f2bf(float f) { unsigned u = __builtin_bit_cast(unsigned, f); return (u + 0x7fffu + ((u >> 16) & 1u)) >> 16; }
__device__ __forceinline__ unsigned pk2(float lo, float hi) { return f2bf(lo) | (f2bf(hi) << 16); }
__device__ __forceinline__ float bf2f(unsigned short b) { return __builtin_bit_cast(float, ((unsigned)b) << 16); }
__device__ __forceinline__ float bflo(unsigned w) { return __builtin_bit_cast(float, w << 16); }
__device__ __forceinline__ float bfhi(unsigned w) { return __builtin_bit_cast(float, w & 0xffff0000u); }
__device__ __forceinline__ float sigmoidf_(float x) { return __builtin_amdgcn_rcpf(1.f + __expf(-x)); }
__device__ __forceinline__ float wave_sum(float v) {
#pragma unroll
    for (int o = 1; o < 64; o <<= 1) v += __shfl_xor(v, o);
    return v;
}
__device__ __forceinline__ float wave_max(float v) {
#pragma unroll
    for (int o = 1; o < 64; o <<= 1) v = fmaxf(v, __shfl_xor(v, o));
    return v;
}
#define XB_TMO      128
#define XB_XCNT(j)  (256  + 64 * (j))
#define XB_XSUB(j)  (1280 + 64 * (j))
#define XB_XGEN(j)  (2304 + 64 * (j))
#define XB_TOP      3328
#define XB_TOPGEN   3392
#define XCD_BAR_WORDS 3456
#define XB_SPIN_CAP (1u << 18)

__device__ __forceinline__ unsigned xb_ld(unsigned* p)              { return __hip_atomic_load(p, __ATOMIC_RELAXED, __HIP_MEMORY_SCOPE_AGENT); }
__device__ __forceinline__ unsigned xb_add(unsigned* p, unsigned v) { return __hip_atomic_fetch_add(p, v, __ATOMIC_RELAXED, __HIP_MEMORY_SCOPE_AGENT); }
__device__ __forceinline__ unsigned xb_xcc_id() { return (unsigned)__builtin_amdgcn_s_getreg((3 << 11) | 20) & 0xFu; }
#define XB_SPIN(cond, bar) do { unsigned _sp = 0; while (cond) { __builtin_amdgcn_s_sleep(1); \
    if ((++_sp & 255u) == 0u) { if (xb_ld(&(bar)[XB_TMO])) break; if (_sp > XB_SPIN_CAP) { atomicAdd(&(bar)[XB_TMO], 1u); break; } } } } while (0)

struct XcdBarrier {
    unsigned* bar; unsigned x;
    volatile LAS unsigned* st;
};

__device__ __forceinline__ XcdBarrier xcd_barrier_post(unsigned* bar, volatile LAS unsigned* st) {
    XcdBarrier b; b.bar = bar; b.x = xb_xcc_id(); b.st = st;
    if (threadIdx.x == 0) (void)xb_add(&bar[XB_XCNT(b.x)], 1u);
    return b;
}
__device__ __forceinline__ void xcd_barrier_complete(unsigned* bar, unsigned x, unsigned& nloc, unsigned& nx) {
    const unsigned G = gridDim.x * gridDim.y * gridDim.z;
    unsigned sum, cnt, mine, sp = 0u;
    for (;;) {
        sum = 0u; cnt = 0u; mine = 0u;
#pragma unroll
        for (unsigned j = 0; j < 16; ++j) { const unsigned c = xb_ld(&bar[XB_XCNT(j)]); sum += c; cnt += (c > 0u) ? 1u : 0u; mine = (j == x) ? c : mine; }
        if (sum == G) break;
        __builtin_amdgcn_s_sleep(1);
        if ((++sp & 255u) == 0u) { if (xb_ld(&bar[XB_TMO])) break; if (sp > XB_SPIN_CAP) { atomicAdd(&bar[XB_TMO], 1u); break; } }
    }
    nloc = mine > 0u ? mine : 1u; nx = cnt > 0u ? cnt : 1u;
}

__device__ __forceinline__ void xcd_barrier(const XcdBarrier& b) {
    asm volatile("s_waitcnt vmcnt(0)" ::: "memory");
    __syncthreads();
    if (threadIdx.x == 0) {
        unsigned* bar = b.bar;
        __builtin_amdgcn_s_waitcnt(0);
        unsigned nloc = b.st[0], nx = b.st[1];
        if (nloc == 0u) { xcd_barrier_complete(bar, b.x, nloc, nx); b.st[0] = nloc; b.st[1] = nx; }
        const unsigned old = xb_add(&bar[XB_XSUB(b.x)], 1u);
        const unsigned gen = old / nloc;
        if (old + 1u == (gen + 1u) * nloc) {
            __builtin_amdgcn_fence(__ATOMIC_RELEASE, "agent");
            asm volatile("s_waitcnt vmcnt(0)" ::: "memory");
            const unsigned og = xb_add(&bar[XB_TOP], 1u);
            const unsigned tg = og / nx;
            if (og + 1u == (tg + 1u) * nx) xb_add(&bar[XB_TOPGEN], 1u);
            else XB_SPIN(xb_ld(&bar[XB_TOPGEN]) == tg, bar);
            __builtin_amdgcn_fence(__ATOMIC_ACQUIRE, "agent");
            xb_add(&bar[XB_XGEN(b.x)], 1u);
            asm volatile("s_waitcnt vmcnt(0)" ::: "memory");
        } else {
            XB_SPIN(xb_ld(&bar[XB_XGEN(b.x)]) == gen, bar);
            __builtin_amdgcn_fence(__ATOMIC_ACQUIRE, "agent");
            asm volatile("s_waitcnt vmcnt(0)" ::: "memory");
        }
    }
    __syncthreads();
}

#ifndef MOE_FP8
#define MOE_FP8 1
#endif
#ifndef Y_FP8
#define Y_FP8 1
#endif
constexpr float FP8_SY = 16.f;
constexpr float FP8_SW = 256.f, FP8_SX = 4.f, FP8_SA = 4.f;
__device__ __forceinline__ unsigned pk_fp8x4(float a, float b, float c, float d) { int w = __builtin_amdgcn_cvt_pk_fp8_f32(a, b, 0, false); w = __builtin_amdgcn_cvt_pk_fp8_f32(c, d, w, true); return (unsigned)w; }
#ifndef P1_FP8
#define P1_FP8 1
#endif
#define WT_RSRC(p) __builtin_amdgcn_make_buffer_rsrc((void*)(p), 0, 0x7FFFFFFF, 0x00020000)
#define WT_ST16(rsrc, byteoff, v) __builtin_amdgcn_raw_buffer_store_b128((v), (rsrc), (int)(byteoff), 0, 16)
typedef unsigned u32x2w __attribute__((ext_vector_type(2)));
#define WT_ST8(rsrc, byteoff, v) __builtin_amdgcn_raw_buffer_store_b64((v), (rsrc), (int)(byteoff), 0, 16)
using pg8::Unit; using pg8::cvt_pk_bf16;
typedef pg8::u32x4 u32x4;
struct EpiP1 {
    static constexpr bool PERM = true, AFTER_DRAIN = false;
    bf16* P; const float* rc; const float* rs;
    __device__ __forceinline__ void operator()(const f32x4 (&acc)[2][2][4][2], const Unit& u, int wr, int wc, int fr, int fq) const {
        const int row0 = u.pm * 256 + wr * 64 + fr, col0 = u.pn * 256 + wc * 32 + 8 * fq;
        const bool rot = (u.pn < 64) && ((ROTMASK >> u.pn) & 1ull) && (wc == 0);
        const float sgn = fq < 2 ? -1.f : 1.f;
#pragma unroll
        for (int ai = 0; ai < 2; ++ai)
#pragma unroll
            for (int m = 0; m < 4; ++m) {
                const int row = row0 + ai * 128 + m * 16;
                f32x4 c0 = {1.f, 1.f, 1.f, 1.f}, c1 = c0, s0 = {0.f, 0.f, 0.f, 0.f}, s1 = s0;
                if (rot) { const float* pc = rc + (size_t)row * 16 + 8 * (fq & 1); const float* ps = rs + (size_t)row * 16 + 8 * (fq & 1);
                    c0 = *(const f32x4*)pc; c1 = *(const f32x4*)(pc + 4); s0 = *(const f32x4*)ps; s1 = *(const f32x4*)(ps + 4); }
#pragma unroll
                for (int bj = 0; bj < 2; ++bj) {
                    constexpr float ASC = P1_FP8 ? 1.f / (FP8_SX * FP8_SW) : 1.f;
                    f32x4 v0 = acc[ai][bj][m][0] * ASC, v1 = acc[ai][bj][m][1] * ASC;
                    if (rot) {
#pragma unroll
                        for (int j = 0; j < 4; ++j) { const float p0 = __shfl_xor(v0[j], 32), p1 = __shfl_xor(v1[j], 32);
                            v0[j] = v0[j] * c0[j] + sgn * p0 * s0[j]; v1[j] = v1[j] * c1[j] + sgn * p1 * s1[j]; }
                    }
                    u32x4 w; w.x = cvt_pk_bf16(v0[0], v0[1]); w.y = cvt_pk_bf16(v0[2], v0[3]); w.z = cvt_pk_bf16(v1[0], v1[1]); w.w = cvt_pk_bf16(v1[2], v1[3]);
                    *(u32x4*)(P + (size_t)row * NP + col0 + bj * 128) = w;
                }
            }
    }
};
template <int WHICH> struct EpiProj {
    static constexpr bool PERM = true, AFTER_DRAIN = false;
    const bf16* P; bf16* M1; bf16* MG;
    __device__ __forceinline__ void operator()(const f32x4 (&acc)[2][2][4][2], const Unit& u, int wr, int wc, int fr, int fq) const {
        const int row0 = u.pm * 256 + wr * 64 + fr, col0 = u.pn * 256 + wc * 32 + 8 * fq;
#pragma unroll
        for (int ai = 0; ai < 2; ++ai)
#pragma unroll
            for (int m = 0; m < 4; ++m) {
                const int row = row0 + ai * 128 + m * 16;
#pragma unroll
                for (int bj = 0; bj < 2; ++bj) {
                    const int col = col0 + bj * 128;
                    const u32x4 gw = *(const u32x4*)(P + (size_t)row * NP + C_GM + WHICH * DM + col);
                    const f32x4 v0 = acc[ai][bj][m][0], v1 = acc[ai][bj][m][1];
                    float o[8];
                    o[0] = v0[0] * sigmoidf_(bflo(gw.x)); o[1] = v0[1] * sigmoidf_(bfhi(gw.x)); o[2] = v0[2] * sigmoidf_(bflo(gw.y)); o[3] = v0[3] * sigmoidf_(bfhi(gw.y));
                    o[4] = v1[0] * sigmoidf_(bflo(gw.z)); o[5] = v1[1] * sigmoidf_(bfhi(gw.z)); o[6] = v1[2] * sigmoidf_(bflo(gw.w)); o[7] = v1[3] * sigmoidf_(bfhi(gw.w));
                    if (WHICH == 1) { const u32x4 pw = *(const u32x4*)(M1 + (size_t)row * DM + col);
                        o[0] += bflo(pw.x); o[1] += bfhi(pw.x); o[2] += bflo(pw.y); o[3] += bfhi(pw.y); o[4] += bflo(pw.z); o[5] += bfhi(pw.z); o[6] += bflo(pw.w); o[7] += bfhi(pw.w); }
                    u32x4 w; w.x = cvt_pk_bf16(o[0], o[1]); w.y = cvt_pk_bf16(o[2], o[3]); w.z = cvt_pk_bf16(o[4], o[5]); w.w = cvt_pk_bf16(o[6], o[7]);
                    *(u32x4*)((WHICH == 0 ? M1 : MG) + (size_t)row * DM + col) = w;
                }
            }
    }
};
struct EpiOut {
    static constexpr bool PERM = true, AFTER_DRAIN = false;
    const float* X; bf16* X1b;
    __device__ __forceinline__ void operator()(const f32x4 (&acc)[2][2][4][2], const Unit& u, int wr, int wc, int fr, int fq) const {
        const int row0 = u.pm * 256 + wr * 64 + fr, col0 = u.pn * 256 + wc * 32 + 8 * fq;
#pragma unroll
        for (int ai = 0; ai < 2; ++ai)
#pragma unroll
            for (int m = 0; m < 4; ++m) { const size_t ro = (size_t)(row0 + ai * 128 + m * 16) * DM + col0;
#pragma unroll
                for (int bj = 0; bj < 2; ++bj) { const f32x4 x0 = *(const f32x4*)(X + ro + bj * 128), x1 = *(const f32x4*)(X + ro + bj * 128 + 4);
                    const f32x4 y0 = acc[ai][bj][m][0] + x0, y1 = acc[ai][bj][m][1] + x1;
                    u32x4 o; o.x = cvt_pk_bf16(y0[0], y0[1]); o.y = cvt_pk_bf16(y0[2], y0[3]); o.z = cvt_pk_bf16(y1[0], y1[1]); o.w = cvt_pk_bf16(y1[2], y1[3]);
                    *(u32x4*)(X1b + ro + bj * 128) = o; } }
    }
};
struct EpiMoe1 {
    static constexpr bool PERM = true, AFTER_DRAIN = false;
    bf16* ACT; const float* bg; const float* bu;
    __device__ __forceinline__ void operator()(const f32x4 (&acc)[2][2][4][2], const Unit& u, int wr, int wc, int fr, int fq) const {
        const int e = u.pn >> 4, tn = u.pn & 15;
        constexpr float ASC = MOE_FP8 ? 1.f / (FP8_SX * FP8_SW) : 1.f;
        const int row0 = u.pm * 256 + wr * 64 + fr, col = tn * 128 + wc * 32 + 8 * fq;
        const f32x4 bg0 = *(const f32x4*)(bg + (size_t)e * DFF + col), bg1 = *(const f32x4*)(bg + (size_t)e * DFF + col + 4);
        const f32x4 bu0 = *(const f32x4*)(bu + (size_t)e * DFF + col), bu1 = *(const f32x4*)(bu + (size_t)e * DFF + col + 4);
#pragma unroll
        for (int ai = 0; ai < 2; ++ai)
#pragma unroll
            for (int m = 0; m < 4; ++m) {
                const int row = row0 + ai * 128 + m * 16;
                float o[8];
#pragma unroll
                for (int j = 0; j < 4; ++j) {
                    float g0 = fminf(acc[ai][0][m][0][j] * ASC + bg0[j], 7.f), g1 = fminf(acc[ai][0][m][1][j] * ASC + bg1[j], 7.f);
                    float u0 = fminf(fmaxf(acc[ai][1][m][0][j] * ASC + bu0[j], -7.f), 7.f), u1 = fminf(fmaxf(acc[ai][1][m][1][j] * ASC + bu1[j], -7.f), 7.f);
                    o[j] = (u0 + 1.f) * g0 * sigmoidf_(1.702f * g0); o[4 + j] = (u1 + 1.f) * g1 * sigmoidf_(1.702f * g1);
                }
                if constexpr (MOE_FP8 != 0) { v2u w8; w8.x = pk_fp8x4(o[0] * FP8_SA, o[1] * FP8_SA, o[2] * FP8_SA, o[3] * FP8_SA); w8.y = pk_fp8x4(o[4] * FP8_SA, o[5] * FP8_SA, o[6] * FP8_SA, o[7] * FP8_SA);
                    *(v2u*)((unsigned char*)ACT + (size_t)row * DFF + col) = w8; }
                else { u32x4 w; w.x = cvt_pk_bf16(o[0], o[1]); w.y = cvt_pk_bf16(o[2], o[3]); w.z = cvt_pk_bf16(o[4], o[5]); w.w = cvt_pk_bf16(o[6], o[7]);
                *(u32x4*)(ACT + (size_t)row * DFF + col) = w; }
            }
    }
};
struct EpiMoe2 {
    static constexpr bool PERM = true, AFTER_DRAIN = false;
    bf16* Y; const float* bd;
    __device__ __forceinline__ void operator()(const f32x4 (&acc)[2][2][4][2], const Unit& u, int wr, int wc, int fr, int fq) const {
        const int e = u.pn >> 3, tn = u.pn & 7;
        const int row0 = u.pm * 256 + wr * 64 + fr, col0 = tn * 256 + wc * 32 + 8 * fq;
#pragma unroll
        for (int bj = 0; bj < 2; ++bj) {
            const int col = col0 + bj * 128;
            const f32x4 b0 = *(const f32x4*)(bd + (size_t)e * DM + col), b1 = *(const f32x4*)(bd + (size_t)e * DM + col + 4);
#pragma unroll
            for (int ai = 0; ai < 2; ++ai)
#pragma unroll
                for (int m = 0; m < 4; ++m) {
                    const int row = row0 + ai * 128 + m * 16;
                    constexpr float ASC = MOE_FP8 ? 1.f / (FP8_SA * FP8_SW) : 1.f;
                    const f32x4 v0 = acc[ai][bj][m][0] * ASC + b0, v1 = acc[ai][bj][m][1] * ASC + b1;
                    if constexpr (Y_FP8 != 0) { v2u w8; w8.x = pk_fp8x4(v0[0] * FP8_SY, v0[1] * FP8_SY, v0[2] * FP8_SY, v0[3] * FP8_SY); w8.y = pk_fp8x4(v1[0] * FP8_SY, v1[1] * FP8_SY, v1[2] * FP8_SY, v1[3] * FP8_SY);
                        *(v2u*)((unsigned char*)Y + (size_t)row * DM + col) = w8; }
                    else { u32x4 w; w.x = cvt_pk_bf16(v0[0], v0[1]); w.y = cvt_pk_bf16(v0[2], v0[3]); w.z = cvt_pk_bf16(v1[0], v1[1]); w.w = cvt_pk_bf16(v1[2], v1[3]);
                    *(u32x4*)(Y + (size_t)row * DM + col) = w; }
                }
        }
    }
};
template <bool GATHERED> struct MoeOrder {
    static constexpr bool GATHER = GATHERED;
    static constexpr bool FP8 = MOE_FP8 != 0;
#ifndef MOE_B_AUX
#define MOE_B_AUX 0
#endif
#ifndef MOE_B_TILED
#define MOE_B_TILED 1
#endif
    static constexpr bool B_TILED = MOE_B_TILED;
    static constexpr int B_AUX = MOE_B_AUX;
    const LAS int* tab; int ntn, G, c, total; const int* list;
    __device__ __forceinline__ bool next(int i, Unit& u) const {
        const long L = (long)i * G + c; if (L >= total) return false;
        int id = (int)L; { const int q = total / 8, r = total % 8, xcd = id % 8, off = id / 8; id = (xcd < r ? xcd * (q + 1) : r * (q + 1) + (xcd - r) * q) + off; }
        int e = 0;
#pragma unroll 1
        for (int k = 1; k < NEXP; ++k) e = (id >= tab[k]) ? k : e;
        const int local = id - tab[e], mte = tab[64 + e];
        u.pm = tab[128 + e] + local % mte; u.pn = e * ntn + local / mte; return true;
    }
    __device__ __forceinline__ bool upper_half_empty(const Unit& u) const { const int e = u.pn / ntn; return tab[96 + e] - (u.pm - tab[128 + e]) * 256 <= 128; }
    __device__ __forceinline__ unsigned row_of(const Unit& u, int r) const {
        const int e = u.pn / ntn, rr = (u.pm - tab[128 + e]) * 256 + r;
        return rr < tab[96 + e] ? (unsigned)list[(size_t)e * T + rr] : 0u;
    }
    __device__ __forceinline__ void a_ready(const Unit&) const {}
    __device__ __forceinline__ void done(const Unit&) const {}
};
struct Args { const void* in[27]; float* out; unsigned char* ws; int ph_lo, ph_hi, li, pad; };
struct Ctx {
    LAS unsigned char* lds; int tid, lane, wave, G, bid; const Args* A; float* out; unsigned char* ws; unsigned* ctl;
};
#define WSP(type, off) ((type*)(C.ws + (off)))
__device__ __forceinline__ unsigned cvtpk_c(float lo, float hi) { typedef float f2 __attribute__((ext_vector_type(2))); typedef __bf16 b2 __attribute__((ext_vector_type(2))); f2 v = {lo, hi}; b2 b = __builtin_convertvector(v, b2); return __builtin_bit_cast(unsigned, b); }

struct TrRegs { f32x4 v[16]; };
__device__ __forceinline__ void tr_load(TrRegs& R, const float* W, int ldw, int k0, int src, int lane) {
    const int kr = lane >> 4;
#pragma unroll
    for (int i = 0; i < 16; ++i) R.v[i] = src >= 0 ? __builtin_nontemporal_load((const f32x4*)(W + (size_t)(k0 + 4 * i + kr) * ldw + src)) : (f32x4){0.f, 0.f, 0.f, 0.f};
}
template <bool TILED = false>
__device__ __forceinline__ void tr_store(const TrRegs& R, bf16* WT, int K, int k0, int n0, LAS float* scr, int lane) {
    const int c4 = 4 * (lane & 15), kr = lane >> 4;
#pragma unroll
    for (int i = 0; i < 16; ++i) { LAS float* d = scr + (4 * i + kr) * 65 + c4; d[0] = R.v[i].x; d[1] = R.v[i].y; d[2] = R.v[i].z; d[3] = R.v[i].w; }
    LDS_WAIT(); asm volatile("" ::: "memory");
    const int c = lane & 7;
#pragma unroll
    for (int j = 0; j < 8; ++j) { const int n = (lane >> 3) + 8 * j; const LAS float* s = scr + (8 * c) * 65 + n;
        v4u o; o.x = cvtpk_c(s[0 * 65], s[1 * 65]); o.y = cvtpk_c(s[2 * 65], s[3 * 65]); o.z = cvtpk_c(s[4 * 65], s[5 * 65]); o.w = cvtpk_c(s[6 * 65], s[7 * 65]);
        __builtin_nontemporal_store(o, (v4u*)(TILED ? WT + ((size_t)(n0 >> 6) * (K >> 6) + (k0 >> 6)) * 4096 + n * 64 + 8 * c : WT + (size_t)(n0 + n) * K + k0 + 8 * c)); }
    LDS_WAIT(); asm volatile("" ::: "memory");
}
__device__ __forceinline__ void tr_store_fp8(const TrRegs& R, unsigned char* WT8, int K, int k0, int n0, LAS float* scr, int lane, float scale) {
    const int c4 = 4 * (lane & 15), kr = lane >> 4;
#pragma unroll
    for (int i = 0; i < 16; ++i) { LAS float* d = scr + (4 * i + kr) * 65 + c4; d[0] = R.v[i].x; d[1] = R.v[i].y; d[2] = R.v[i].z; d[3] = R.v[i].w; }
    LDS_WAIT(); asm volatile("" ::: "memory");
    const int c = lane & 3;
#pragma unroll
    for (int j = 0; j < 4; ++j) { const int n = (lane >> 2) + 16 * j; const LAS float* s = scr + (16 * c) * 65 + n;
        v4u o; o.x = pk_fp8x4(s[0 * 65] * scale, s[1 * 65] * scale, s[2 * 65] * scale, s[3 * 65] * scale); o.y = pk_fp8x4(s[4 * 65] * scale, s[5 * 65] * scale, s[6 * 65] * scale, s[7 * 65] * scale);
        o.z = pk_fp8x4(s[8 * 65] * scale, s[9 * 65] * scale, s[10 * 65] * scale, s[11 * 65] * scale); o.w = pk_fp8x4(s[12 * 65] * scale, s[13 * 65] * scale, s[14 * 65] * scale, s[15 * 65] * scale);
        __builtin_nontemporal_store(o, (v4u*)(WT8 + ((size_t)(n0 >> 6) * (K >> 7) + (k0 >> 7)) * 8192 + n * 128 + (k0 & 64) + 16 * c)); }
    LDS_WAIT(); asm volatile("" ::: "memory");
}
struct MapId { __device__ __forceinline__ int operator()(int n) const { return n; } };
struct MapIn { __device__ __forceinline__ int operator()(int r) const {
    return r < 8192 ? r : r < 13312 ? r + 32 : r < 17408 ? r + 80 : r < 17440 ? 8192 + (r - 17408) : r < 17488 ? 13344 + (r - 17440) : -1; } };
template <class Map>
__device__ __forceinline__ void tr_matrix(const Ctx& C, const float* W, int ldw, int K, int Nd, bf16* WT, Map map) {
    LAS float* scr = (LAS float*)(C.lds + C.wave * 16640);
    const int gw = C.bid * NWAVES + C.wave, NGW = C.G * NWAVES, nblk = Nd / 64, nit = nblk * (K / 64), lane = C.lane;
    TrRegs R; int it = gw;
    if (it < nit) tr_load(R, W, ldw, 64 * (it / nblk), map(64 * (it % nblk) + 4 * (lane & 15)), lane);
    while (it < nit) { const int nx = it + NGW; TrRegs N;
        if (nx < nit) tr_load(N, W, ldw, 64 * (nx / nblk), map(64 * (nx % nblk) + 4 * (lane & 15)), lane);
        tr_store(R, WT, K, 64 * (it / nblk), 64 * (it % nblk), scr, lane);
        R = N; it = nx; }
}
__device__ __forceinline__ void rms_row_bf16(const float* xrow, const float* gain, bf16* orow, int lane, unsigned char* o8 = nullptr  ) {
    f32x4 v[8]; float s = 0.f;
#pragma unroll
    for (int j = 0; j < 8; ++j) { v[j] = *(const f32x4*)(xrow + 4 * lane + 256 * j); s += (v[j].x * v[j].x + v[j].y * v[j].y) + (v[j].z * v[j].z + v[j].w * v[j].w); }
    const float r = __builtin_amdgcn_rsqf(wave_sum(s) * (1.f / DM) + EPS);
#pragma unroll
    for (int j = 0; j < 8; ++j) { const f32x4 g = *(const f32x4*)(gain + 4 * lane + 256 * j);
        v2u o; o.x = pk2(v[j].x * r * g.x, v[j].y * r * g.y); o.y = pk2(v[j].z * r * g.z, v[j].w * r * g.w);
        if (orow) *(v2u*)(orow + 4 * lane + 256 * j) = o;
        if (o8) *(unsigned*)(o8 + 4 * lane + 256 * j) = pk_fp8x4(v[j].x * r * g.x * FP8_SX, v[j].y * r * g.y * FP8_SX, v[j].z * r * g.z * FP8_SX, v[j].w * r * g.w * FP8_SX); }
}
__device__ __forceinline__ void p0_prologue(const Ctx& C) {
    { LAS float* scr = (LAS float*)(C.lds + C.wave * 16640);
      const int gw0 = C.bid * NWAVES + C.wave, NGW0 = C.G * NWAVES, lane = C.lane;
      constexpr int N_IN = (NP / 64) * (DM / 64), N_PJ = (DM / 64) * (DM / 64), N_W1 = 0  , N_W2 = 2 * 2, NALL = N_IN + 3 * N_PJ + 2 * N_W1 + 2 * N_W2;
#define P0_DECODE(it_) int i_ = (it_); const float* W_; bf16* WT_; int ldw_, K_, nblk_; bool isin_ = false; \
      if (i_ < N_IN) { W_ = (const float*)C.A->in[3]; WT_ = WSP(bf16, WS_WINT); ldw_ = DIN; K_ = DM; nblk_ = NP / 64; isin_ = true; } \
      else if ((i_ -= N_IN) < 3 * N_PJ) { const int w_ = i_ / N_PJ; i_ -= w_ * N_PJ; W_ = (const float*)C.A->in[14 + w_]; WT_ = WSP(bf16, WS_WPA) + (size_t)w_ * DM * DM; ldw_ = DM; K_ = DM; nblk_ = DM / 64; } \
      else { i_ -= 3 * N_PJ; const int w_ = i_ / N_W2; i_ -= w_ * N_W2; W_ = (const float*)C.A->in[w_ ? 13 : 10]; WT_ = (bf16*)(C.ws + 111 * MiB + w_ * 65536); ldw_ = 128; K_ = 128; nblk_ = 2; } \
      const int k0_ = 64 * (i_ / nblk_), n0_ = 64 * (i_ % nblk_);
      TrRegs R; int it = gw0;
      if (it < NALL) { P0_DECODE(it); const int d_ = n0_ + 4 * (lane & 15); tr_load(R, W_, ldw_, k0_, isin_ ? MapIn()(d_) : d_, lane); }
      while (it < NALL) { const int nx = it + NGW0; TrRegs N;
          if (nx < NALL) { P0_DECODE(nx); const int d_ = n0_ + 4 * (lane & 15); tr_load(N, W_, ldw_, k0_, isin_ ? MapIn()(d_) : d_, lane); }
          { P0_DECODE(it); (void)W_; (void)ldw_; if (P1_FP8 && isin_) tr_store_fp8(R, (unsigned char*)WT_, K_, k0_, n0_, scr, lane, FP8_SW); else if (STATIC_B_TILED && K_ == DM) tr_store<true>(R, WT_, K_, k0_, n0_, scr, lane); else tr_store<false>(R, WT_, K_, k0_, n0_, scr, lane); }
          R = N; it = nx; }
#undef P0_DECODE
    }
    const int gw = C.bid * NWAVES + C.wave, NGW = C.G * NWAVES;
    for (int m = gw; m < T; m += NGW) rms_row_bf16(((const float*)C.A->in[0]) + (size_t)m * DM, ((const float*)C.A->in[2]), P1_FP8 ? (bf16*)nullptr : WSP(bf16, WS_H) + (size_t)m * DM, C.lane, P1_FP8 ? C.ws + WS_H8 + (size_t)m * DM : nullptr);
    for (int i = C.bid * NTHR + C.tid; i < 128 * 3 * 64; i += C.G * NTHR) { const int ks = i / 192, r_ = i % 192, nt = r_ >> 6, ln = r_ & 63, c = 32 * nt + (ln & 31);
        const int src = c < 32 ? 8192 + c : c < 80 ? 13344 + (c - 32) : -1;
        v4u o = {0u, 0u, 0u, 0u};
        if (src >= 0) { const float* w = (const float*)C.A->in[3] + (size_t)(16 * ks + 8 * (ln >> 5)) * DIN + src;
            o.x = cvtpk_c(w[0], w[DIN]); o.y = cvtpk_c(w[2 * (size_t)DIN], w[3 * (size_t)DIN]); o.z = cvtpk_c(w[4 * (size_t)DIN], w[5 * (size_t)DIN]); o.w = cvtpk_c(w[6 * (size_t)DIN], w[7 * (size_t)DIN]); }
        *(v4u*)(C.ws + 14 * MiB + (size_t)i * 16) = o; }
    for (int i = C.bid * NTHR + C.tid; i < 2 * 256 * 4 * 64; i += C.G * NTHR) { const int kv = i >> 16, r_ = i & 65535, ks = r_ >> 8, nt = (r_ >> 6) & 3, ln = r_ & 63;
        const float* w1 = (const float*)C.A->in[kv ? 12 : 9] + (size_t)(16 * ks + 8 * (ln >> 5)) * 128 + 32 * nt + (ln & 31);
        v4u o; o.x = cvtpk_c(w1[0], w1[128]); o.y = cvtpk_c(w1[256], w1[384]); o.z = cvtpk_c(w1[512], w1[640]); o.w = cvtpk_c(w1[768], w1[896]);
        *(v4u*)(C.ws + (109 + kv) * MiB + (size_t)r_ * 16) = o; }
    { bf16* WRH = WSP(bf16, 12 * MiB + 65536); bf16* WRL = WRH + 65536;
      for (int i = C.bid * NTHR + C.tid; i < NEXP * DM; i += C.G * NTHR) { const int e = i >> 11, k = i & 2047;
          const float w = ((const float*)C.A->in[17])[k] * ((const float*)C.A->in[18])[k * NEXP + e]; const unsigned hb = f2bf(w);
          WRH[i] = (bf16)hb; WRL[i] = (bf16)f2bf(w - bf2f((unsigned short)hb)); } }
    float* rc = WSP(float, WS_RC); float* rs = WSP(float, WS_RS);
    for (int i = C.bid * NTHR + C.tid; i < T * 16; i += C.G * NTHR) {
        const int m = i >> 4, f = i & 15; const float invf = exp2f(-(float)f * (18.931568569324174f / 16.f));
        const float ang = (float)((const int*)C.A->in[1])[m] * invf;
        double rev = (double)ang * 0.15915494309189535; rev -= rint(rev);
        const float rf = (float)rev; rc[i] = __builtin_amdgcn_cosf(rf); rs[i] = __builtin_amdgcn_sinf(rf);
    }
}
constexpr size_t WS_WSF = 14 * MiB;
__device__ __forceinline__ void small_proj(const Ctx& C) {
    const bf16* H = WSP(bf16, WS_H); const bf16* WF = WSP(bf16, WS_WSF); bf16* P = WSP(bf16, WS_P);
    typedef float f32x16s __attribute__((ext_vector_type(16)));
    LAS float* part = (LAS float*)C.lds;
    for (int base = C.bid * 2; base < T / 32; base += C.G * 2) {
        int lane = C.lane; asm volatile("" : "+v"(lane));
        const int tw = C.wave >> 2, kq = C.wave & 3, mt = base + tw, t = lane & 31, hf = lane >> 5;
        const bool valid = mt < T / 32;
        f32x16s acc0 = {}, acc1 = {}, acc2 = {};
        if (valid) {
            const unsigned char* ap = C.ws + WS_H8 + (size_t)(32 * mt + t) * DM + 8 * hf + 512 * kq; const bf16* bp = WF + (size_t)lane * 8 + (size_t)(32 * kq) * 1536;
#pragma unroll 8
            for (int s2 = 0; s2 < 32; ++s2) { const v2u a8 = *(const v2u*)(ap + 16 * s2); const bf16* b_ = bp + (size_t)s2 * 1536;
                typedef float f2_ __attribute__((ext_vector_type(2)));
                const f2_ p0 = __builtin_amdgcn_cvt_pk_f32_fp8((int)a8.x, false), p1 = __builtin_amdgcn_cvt_pk_f32_fp8((int)a8.x, true), p2 = __builtin_amdgcn_cvt_pk_f32_fp8((int)a8.y, false), p3 = __builtin_amdgcn_cvt_pk_f32_fp8((int)a8.y, true);
                v4u aw; aw.x = cvtpk_c(p0.x, p0.y); aw.y = cvtpk_c(p1.x, p1.y); aw.z = cvtpk_c(p2.x, p2.y); aw.w = cvtpk_c(p3.x, p3.y);
                const bf16x8 a = __builtin_bit_cast(bf16x8, aw);
                acc0 = __builtin_amdgcn_mfma_f32_32x32x16_bf16(a, *(const bf16x8*)(b_), acc0, 0, 0, 0);
                acc1 = __builtin_amdgcn_mfma_f32_32x32x16_bf16(a, *(const bf16x8*)(b_ + 512), acc1, 0, 0, 0);
                acc2 = __builtin_amdgcn_mfma_f32_32x32x16_bf16(a, *(const bf16x8*)(b_ + 1024), acc2, 0, 0, 0); }
            if (kq) { LAS float* pp = part + (size_t)((tw * 3 + kq - 1) * 3) * 1024 + lane;
#pragma unroll
                for (int i = 0; i < 16; ++i) { pp[i * 64] = acc0[i]; pp[1024 + i * 64] = acc1[i]; pp[2048 + i * 64] = acc2[i]; } }
        }
        __syncthreads();
        if (valid && kq == 0) {
#pragma unroll
            for (int q = 0; q < 3; ++q) { const LAS float* pp = part + (size_t)((tw * 3 + q) * 3) * 1024 + lane;
#pragma unroll
                for (int i = 0; i < 16; ++i) { acc0[i] += pp[i * 64]; acc1[i] += pp[1024 + i * 64]; acc2[i] += pp[2048 + i * 64]; } }
            const int odd = t & 1;
#pragma unroll
            for (int nt = 0; nt < 3; ++nt) { const f32x16s acc = nt == 0 ? acc0 : nt == 1 ? acc1 : acc2; bf16* opl = P + (size_t)(32 * mt) * NP + 17408 + 32 * nt + t - odd;
#pragma unroll
                for (int i = 0; i < 16; i += 2) { const float va = acc[i] * (1.f / FP8_SX), vb = acc[i + 1] * (1.f / FP8_SX), x = __shfl_xor(odd ? va : vb, 1); const int row = (i & 3) + 8 * (i >> 2) + 4 * hf + odd;
                    *(unsigned*)(opl + (size_t)row * NP) = odd ? cvtpk_c(x, vb) : cvtpk_c(va, x); } }
        }
        __syncthreads();
    }
}
#if MOE_FP8
#define MOE_ST(RR, base, eoff, K_, k0_, n0_) tr_store_fp8(RR, (unsigned char*)(base) + (eoff), K_, k0_, n0_, scr, lane, FP8_SW)
#else
#define MOE_ST(RR, base, eoff, K_, k0_, n0_) tr_store<MOE_B_TILED>(RR, (base) + (eoff), K_, k0_, n0_, scr, lane)
#endif
__device__ __forceinline__ void moe_weight_convert(const Ctx& C, int it0, int it1, int wv, int nwv) {
    LAS float* scr = (LAS float*)(C.lds + C.wave * 16640);
    if (wv < 0) return;
    const int gw = it0 + wv, NGW = nwv, lane = C.lane;
    bf16* WGU = WSP(bf16, WS_WGU); bf16* WD = WSP(bf16, WS_WD);
    const float* wg = (const float*)C.A->in[20]; const float* wu = (const float*)C.A->in[22]; const float* wd = (const float*)C.A->in[24];
    constexpr int NGU = NEXP * 64 * 32, NIT = NGU + NEXP * 32 * 32;
#define MOE_IT_LOAD(RR, it_) do { const int i_ = (it_); \
        if (i_ < NGU) { const int e = i_ >> 11, r = i_ & 2047, nb = r & 63, kb = r >> 6, n0 = nb * 64, which = (n0 >> 7) & 1, srcn = (n0 >> 8) * 128 + (n0 & 127) + 4 * (lane & 15); \
            tr_load(RR, (which ? wu : wg) + (size_t)e * DM * DFF, DFF, 64 * kb, srcn, lane); } \
        else { const int q_ = i_ - NGU, e = q_ >> 10, r = q_ & 1023, nb = r & 31, kb = r >> 5; tr_load(RR, wd + (size_t)e * DFF * DM, DM, 64 * kb, 64 * nb + 4 * (lane & 15), lane); } } while (0)
#define MOE_IT_STORE(RR, it_) do { const int i_ = (it_); \
        if (i_ < NGU) { const int e = i_ >> 11, r = i_ & 2047, nb = r & 63, kb = r >> 6; MOE_ST(RR, WGU, (size_t)e * 4096 * DM, DM, 64 * kb, nb * 64); } \
        else { const int q_ = i_ - NGU, e = q_ >> 10, r = q_ & 1023, nb = r & 31, kb = r >> 5; MOE_ST(RR, WD, (size_t)e * DM * DFF, DFF, 64 * kb, 64 * nb); } } while (0)
    const int NE = it1 < NIT ? it1 : NIT;
    TrRegs R; int it = gw;
    if (it < NE) MOE_IT_LOAD(R, it);
    while (it < NE) { const int nx = it + NGW; TrRegs N;
        if (nx < NE) MOE_IT_LOAD(N, nx);
        MOE_IT_STORE(R, it);
        R = N; it = nx; }
#undef MOE_IT_LOAD
#undef MOE_IT_STORE
}

__device__ __forceinline__ void moe_convert_queue(const Ctx& C, int first, int n_items) {
    LAS float* scr = (LAS float*)(C.lds + C.wave * 16640);
    const int lane = C.lane; bf16* WD = WSP(bf16, WS_WD); const float* wd = (const float*)C.A->in[24];
    unsigned* q = C.ctl + CW_CQ;
    constexpr int NGU = NEXP * 64 * 32;
    for (;;) {
        const int base = __builtin_amdgcn_readfirstlane((int)(lane == 0 ? __hip_atomic_fetch_add(q, 2u, __ATOMIC_RELAXED, __HIP_MEMORY_SCOPE_AGENT) : 0u));
        if (base >= n_items) break;
#pragma unroll 1
        for (int k = 0; k < 2; ++k) { const int it = first + base + k; if (base + k >= n_items) break;
            const int q_ = it - NGU, e = q_ >> 10, r = q_ & 1023, nb = r & 31, kb = r >> 5; TrRegs R;
            tr_load(R, wd + (size_t)e * DFF * DM, DM, 64 * kb, 64 * nb + 4 * (lane & 15), lane);
            MOE_ST(R, WD, (size_t)e * DM * DFF, DFF, 64 * kb, 64 * nb); }
    }
}

constexpr size_t WS_RT = 12 * MiB + 524288;
constexpr size_t WS_WRH = 12 * MiB + 65536, WS_WRL = WS_WRH + 131072, WS_LIST = 13 * MiB;
typedef float f32x16r __attribute__((ext_vector_type(16)));
__device__ __forceinline__ void p7_norm_router(const Ctx& C) {
    if (C.wave >= 4) return;
    const int khalf = C.wave & 1, tsub = C.wave >> 1;
    const bf16* X1b = WSP(bf16, WS_HN);
    int* TOPE = WSP(int, WS_TOPE); float* TOPW = WSP(float, WS_TOPW); int* POS = WSP(int, WS_POS);
    const bf16* WRH = WSP(bf16, WS_WRH); const bf16* WRL = WSP(bf16, WS_WRL);
    unsigned* cnt = C.ctl + CW_CNT;
    LAS float* lg = (LAS float*)(C.lds + 133120 + tsub * 5120);
    LAS float* ssB = lg + 1056; volatile LAS int* flag = (volatile LAS int*)(lg + 1120); volatile LAS int* ack = flag + 1;
    int it = 0;
    for (int tile = C.bid * 2 + tsub; tile < T / 32; tile += C.G * 2, ++it) {
        int lane = C.lane; asm volatile("" : "+v"(lane));
        const int t = lane & 31, hf = lane >> 5, m0 = tile * 32;
        const bf16* xr = X1b + (size_t)(m0 + t) * DM + 8 * hf + 1024 * khalf; const bf16* wh = WRH + (size_t)t * DM + 8 * hf + 1024 * khalf; const bf16* wl = WRL + (size_t)t * DM + 8 * hf + 1024 * khalf;
        f32x16r acc = {}; float ss = 0.f;
#pragma unroll 8
        for (int s = 0; s < 64; ++s) {
            const v4u h = *(const v4u*)(xr + 16 * s);
            const bf16x8 bh = *(const bf16x8*)(wh + 16 * s), bl = *(const bf16x8*)(wl + 16 * s);
            { const float a0 = bflo(h.x), a1 = bfhi(h.x), a2 = bflo(h.y), a3 = bfhi(h.y), a4 = bflo(h.z), a5 = bfhi(h.z), a6 = bflo(h.w), a7 = bfhi(h.w);
              ss += (a0 * a0 + a1 * a1) + (a2 * a2 + a3 * a3) + (a4 * a4 + a5 * a5) + (a6 * a6 + a7 * a7); }
            const bf16x8 ah = __builtin_bit_cast(bf16x8, h);
            acc = __builtin_amdgcn_mfma_f32_32x32x16_bf16(ah, bh, acc, 0, 0, 0);
            acc = __builtin_amdgcn_mfma_f32_32x32x16_bf16(ah, bl, acc, 0, 0, 0);
        }
        ss += __shfl_xor(ss, 32);
        if (khalf) {
            while (*ack != it) __builtin_amdgcn_s_sleep(1);
#pragma unroll
            for (int i = 0; i < 16; ++i) lg[i * 64 + lane] = acc[i];
            ssB[lane] = ss; LDS_WAIT(); asm volatile("" ::: "memory");
            if (lane == 0) *flag = it + 1;
            continue; }
        while (*flag != it + 1) __builtin_amdgcn_s_sleep(1);
#pragma unroll
        for (int i = 0; i < 16; ++i) acc[i] += lg[i * 64 + lane];
        ss += ssB[lane]; LDS_WAIT(); asm volatile("" ::: "memory");
        if (lane == 0) *ack = it + 1;
        const float r = __builtin_amdgcn_rsqf(ss * (1.f / DM) + EPS);
        const float be = ((const float*)C.A->in[19])[t];
#pragma unroll
        for (int i = 0; i < 16; ++i) { const int tok = (i & 3) + 8 * (i >> 2) + 4 * hf; lg[tok * 33 + t] = acc[i] * __shfl(r, tok) + be; }
        LDS_WAIT();
        if (lane < 32) {
            float v[32];
#pragma unroll
            for (int e = 0; e < 32; ++e) v[e] = lg[lane * 33 + e];
            int te[4]; float tv[4];
#pragma unroll
            for (int k = 0; k < 4; ++k) { float best = -__builtin_inff(); int bi = 0;
#pragma unroll
                for (int e = 0; e < 32; ++e) if (v[e] > best) { best = v[e]; bi = e; }
                te[k] = bi; tv[k] = best;
#pragma unroll
                for (int e = 0; e < 32; ++e) if (e == bi) v[e] = -__builtin_inff(); }
            const float e1 = __expf(tv[1] - tv[0]), e2 = __expf(tv[2] - tv[0]), e3 = __expf(tv[3] - tv[0]), inv = 1.f / (1.f + e1 + e2 + e3);
            const int m = m0 + lane;
            LAS unsigned* hist = (LAS unsigned*)(lg + 1152); LAS unsigned* basev = hist + 32;
            hist[lane] = 0u;
            const unsigned r0 = __hip_atomic_fetch_add(hist + te[0], 1u, __ATOMIC_RELAXED, __HIP_MEMORY_SCOPE_WORKGROUP), r1 = __hip_atomic_fetch_add(hist + te[1], 1u, __ATOMIC_RELAXED, __HIP_MEMORY_SCOPE_WORKGROUP);
            const unsigned r2 = __hip_atomic_fetch_add(hist + te[2], 1u, __ATOMIC_RELAXED, __HIP_MEMORY_SCOPE_WORKGROUP), r3 = __hip_atomic_fetch_add(hist + te[3], 1u, __ATOMIC_RELAXED, __HIP_MEMORY_SCOPE_WORKGROUP);
            LDS_WAIT(); asm volatile("" ::: "memory");
            const unsigned cn = hist[lane];
            basev[lane] = cn ? __hip_atomic_fetch_add(cnt + lane, cn, __ATOMIC_RELAXED, __HIP_MEMORY_SCOPE_AGENT) : 0u;
            LDS_WAIT(); asm volatile("" ::: "memory");
            const unsigned p0 = basev[te[0]] + r0, p1 = basev[te[1]] + r1, p2 = basev[te[2]] + r2, p3 = basev[te[3]] + r3;
            *(int4*)(TOPE + m * 4) = make_int4(te[0], te[1], te[2], te[3]); *(float4*)(TOPW + m * 4) = make_float4(inv, e1 * inv, e2 * inv, e3 * inv); *(int4*)(POS + m * 4) = make_int4((int)p0, (int)p1, (int)p2, (int)p3);
        }
        if (lane < 32) WSP(float, WS_RT)[m0 + lane] = r;
        LDS_WAIT();
    }
}
__device__ __forceinline__ void moe_tables(const Ctx& C, int ntn, int& total) {
    LAS int* tab = (LAS int*)(C.lds + TAB_OFF);
    __syncthreads();
    if (C.tid == 0) { int up = 0, tb = 0; int cnv[NEXP];
#pragma unroll
        for (int e = 0; e < NEXP; ++e) cnv[e] = (int)__hip_atomic_load(C.ctl + CW_CNT + e, __ATOMIC_RELAXED, __HIP_MEMORY_SCOPE_AGENT);
#pragma unroll
        for (int e = 0; e < NEXP; ++e) { const int cn = cnv[e]; const int mt = (cn + 255) >> 8;
            tab[e] = up; tab[64 + e] = mt; tab[96 + e] = cn; tab[128 + e] = tb; tab[192 + e] = tb * 256; up += mt * ntn; tb += mt; }
        tab[32] = up; }
    __syncthreads();
    total = tab[32];
}
__device__ __forceinline__ void p8_gather(const Ctx& C) {
    int total; moe_tables(C, 1, total);
    const LAS int* tab = (const LAS int*)(C.lds + TAB_OFF);
    const bf16* HN = WSP(bf16, WS_HN); bf16* XG = WSP(bf16, WS_XG);
    const int* TOPE = WSP(int, WS_TOPE); const int* POS = WSP(int, WS_POS);
    const int gw = C.bid * NWAVES + C.wave, NGW = C.G * NWAVES, lane = C.lane;
    f32x4 gq[4][2];
#pragma unroll
    for (int q = 0; q < 4; ++q) { const float* gp = (const float*)C.A->in[17] + 8 * (lane + 64 * q); gq[q][0] = *(const f32x4*)gp; gq[q][1] = *(const f32x4*)(gp + 4); }
#if MOE_FP8
#pragma unroll 2
    for (int m = gw; m < T; m += NGW) {
        const int4 te = *(const int4*)(TOPE + m * 4), tp = *(const int4*)(POS + m * 4); const float r8 = WSP(float, WS_RT)[m] * FP8_SX;
        const size_t d0 = (size_t)(tab[192 + te.x] + tp.x) * DM, d1 = (size_t)(tab[192 + te.y] + tp.y) * DM, d2 = (size_t)(tab[192 + te.z] + tp.z) * DM, d3 = (size_t)(tab[192 + te.w] + tp.w) * DM;
        const v4u* src = (const v4u*)(HN + (size_t)m * DM);
#pragma unroll
        for (int q = 0; q < 4; ++q) { const v4u w = src[lane + 64 * q]; const f32x4 g0 = gq[q][0] * r8, g1 = gq[q][1] * r8; v2u o8;
            o8.x = pk_fp8x4(bflo(w.x) * g0.x, bfhi(w.x) * g0.y, bflo(w.y) * g0.z, bfhi(w.y) * g0.w); o8.y = pk_fp8x4(bflo(w.z) * g1.x, bfhi(w.z) * g1.y, bflo(w.w) * g1.z, bfhi(w.w) * g1.w);
            unsigned char* xb = (unsigned char*)XG + 8 * (lane + 64 * q);
            *(v2u*)(xb + d0) = o8; *(v2u*)(xb + d1) = o8; *(v2u*)(xb + d2) = o8; *(v2u*)(xb + d3) = o8; }
    }
#else
#pragma unroll 4
    for (int a = gw; a < T * TOPK; a += NGW) {
        const int m = a >> 2, e = TOPE[a], dest = tab[192 + e] + POS[a];
        const v4u* src = (const v4u*)(HN + (size_t)m * DM); v4u* dst = (v4u*)(XG + (size_t)dest * DM); const float rr = WSP(float, WS_RT)[m];
#pragma unroll
        for (int q = 0; q < 4; ++q) { const v4u w = src[lane + 64 * q]; v4u o;
            o.x = cvtpk_c(bflo(w.x) * rr, bfhi(w.x) * rr); o.y = cvtpk_c(bflo(w.y) * rr, bfhi(w.y) * rr); o.z = cvtpk_c(bflo(w.z) * rr, bfhi(w.z) * rr); o.w = cvtpk_c(bflo(w.w) * rr, bfhi(w.w) * rr);
            dst[lane + 64 * q] = o; }
    }
#endif
}
__device__ __forceinline__ void p11_final(const Ctx& C) {
    int total; moe_tables(C, 1, total); const LAS int* tab = (const LAS int*)(C.lds + TAB_OFF);
    const bf16* X1b = WSP(bf16, WS_HN); const bf16* Y = WSP(bf16, WS_Y); const int* TOPE = WSP(int, WS_TOPE); const int* POS = WSP(int, WS_POS); const float* TOPW = WSP(float, WS_TOPW);
    const int gw = C.bid * NWAVES + C.wave, NGW = C.G * NWAVES, lane = C.lane;
    for (int m = gw; m < T; m += NGW) {
        f32x4 v[8];
#pragma unroll
        for (int j = 0; j < 8; ++j) { const v2u xw = *(const v2u*)(X1b + (size_t)m * DM + 4 * lane + 256 * j); v[j] = (f32x4){bflo(xw.x), bfhi(xw.x), bflo(xw.y), bfhi(xw.y)}; }
#pragma unroll
        for (int k = 0; k < 4; ++k) { const float w = TOPW[m * 4 + k]; const size_t yoff = (size_t)(tab[192 + TOPE[m * 4 + k]] + POS[m * 4 + k]) * DM; const bf16* yr = Y + yoff; (void)yr;
#pragma unroll
            for (int j = 0; j < 8; ++j) {
#if Y_FP8
                const int y8 = *(const int*)((const unsigned char*)Y + yoff + 4 * lane + 256 * j); const float w8 = w * (1.f / FP8_SY);
                v[j].x += w8 * __builtin_amdgcn_cvt_f32_fp8(y8, 0); v[j].y += w8 * __builtin_amdgcn_cvt_f32_fp8(y8, 1); v[j].z += w8 * __builtin_amdgcn_cvt_f32_fp8(y8, 2); v[j].w += w8 * __builtin_amdgcn_cvt_f32_fp8(y8, 3); } }
#else
                const v2u yw = *(const v2u*)(yr + 4 * lane + 256 * j);
                v[j].x += w * bflo(yw.x); v[j].y += w * bfhi(yw.x); v[j].z += w * bflo(yw.y); v[j].w += w * bfhi(yw.y); } }
#endif
        float s = 0.f;
#pragma unroll
        for (int j = 0; j < 8; ++j) s += (v[j].x * v[j].x + v[j].y * v[j].y) + (v[j].z * v[j].z + v[j].w * v[j].w);
        const float r = __builtin_amdgcn_rsqf(wave_sum(s) * (1.f / DM) + EPS);
#pragma unroll
        for (int j = 0; j < 8; ++j) { const f32x4 g = *(const f32x4*)(((const float*)C.A->in[26]) + 4 * lane + 256 * j);
            *(f32x4*)(C.out + (size_t)m * DM + 4 * lane + 256 * j) = (f32x4){v[j].x * r * g.x, v[j].y * r * g.y, v[j].z * r * g.z, v[j].w * r * g.w}; }
    }
}
constexpr size_t WS_REC = 792 * MiB, WS_VBC = 1048 * MiB, WS_EGL = 12 * MiB, WS_ORAWB = 1176 * MiB;
typedef float f32x16 __attribute__((ext_vector_type(16)));
typedef float f32x2_t __attribute__((ext_vector_type(2))); typedef __bf16 bf16x2_t __attribute__((ext_vector_type(2)));
__device__ __forceinline__ unsigned cvtpk(float lo, float hi) { f32x2_t v = {lo, hi}; bf16x2_t b = __builtin_convertvector(v, bf16x2_t); return __builtin_bit_cast(unsigned, b); }
__device__ __forceinline__ bf16x8 pack8f(const float* v) { v4u w = {cvtpk(v[0], v[1]), cvtpk(v[2], v[3]), cvtpk(v[4], v[5]), cvtpk(v[6], v[7])}; return __builtin_bit_cast(bf16x8, w); }
__device__ __forceinline__ int crow(int r, int hi) { return (r & 3) + 8 * (r >> 2) + 4 * hi; }
__device__ __forceinline__ void conv8(const bf16* P, const float* cw, int m, int sp, int col0, float (&y)[8]) {
#pragma unroll
    for (int j = 0; j < 8; ++j) y[j] = 0.f;
#pragma unroll
    for (int i = 0; i < 4; ++i) {
        if (sp - 3 + i >= 0) {
            const v4u w = *(const v4u*)(P + (size_t)(m - 3 + i) * NP + col0);
            const f32x4 c0 = *(const f32x4*)(cw + i * 6144 + col0), c1 = *(const f32x4*)(cw + i * 6144 + col0 + 4);
            y[0] += c0.x * bflo(w.x); y[1] += c0.y * bfhi(w.x); y[2] += c0.z * bflo(w.y); y[3] += c0.w * bfhi(w.y);
            y[4] += c1.x * bflo(w.z); y[5] += c1.y * bfhi(w.z); y[6] += c1.z * bflo(w.w); y[7] += c1.w * bfhi(w.w);
        }
    }
#pragma unroll
    for (int j = 0; j < 8; ++j) y[j] = y[j] * sigmoidf_(y[j]);
}
__device__ __forceinline__ void store_perm_frag(unsigned char* rec, int f, int lane16, const float* v) {
    v2u lo = {cvtpk(v[0], v[1]), cvtpk(v[2], v[3])}, hi = {cvtpk(v[4], v[5]), cvtpk(v[6], v[7])};
    const int o = (lane16 & 511) + ((lane16 >> 9) << 3);
    *(v2u*)(rec + (size_t)f * 1024 + o) = lo;
    *(v2u*)(rec + (size_t)f * 1024 + 512 + o) = hi;
}
template <class F>
__device__ __forceinline__ void conv_rows(const bf16* P, const float* cw, int m0, int sp0, int col0  , int lane, F f) {
    const int c16 = lane & 15, seg = lane >> 4, col = col0 + 8 * c16, row0 = 16 * seg;
    const bf16* pp = P + (size_t)(m0 + row0) * NP + col;
    const v4u z = {0u, 0u, 0u, 0u};
    v4u xa = (sp0 + row0 - 3 >= 0) ? *(const v4u*)(pp - 3 * (size_t)NP) : z, xb = (sp0 + row0 - 2 >= 0) ? *(const v4u*)(pp - 2 * (size_t)NP) : z, xc = (sp0 + row0 - 1 >= 0) ? *(const v4u*)(pp - (size_t)NP) : z;
    v4u xd = *(const v4u*)pp, xe = *(const v4u*)(pp + NP), xf = *(const v4u*)(pp + 2 * (size_t)NP);
    f32x4 w0[4], w1[4];
#pragma unroll
    for (int i = 0; i < 4; ++i) { w0[i] = *(const f32x4*)(cw + i * 6144 + col); w1[i] = *(const f32x4*)(cw + i * 6144 + col + 4); }
#pragma unroll 4
    for (int it = 0; it < 16; ++it) {
        const v4u xn = (it + 3 < 16) ? *(const v4u*)(pp + (size_t)(it + 3) * NP) : z;
        float y[8];
        y[0] = w0[0].x * bflo(xa.x) + w0[1].x * bflo(xb.x) + w0[2].x * bflo(xc.x) + w0[3].x * bflo(xd.x);
        y[1] = w0[0].y * bfhi(xa.x) + w0[1].y * bfhi(xb.x) + w0[2].y * bfhi(xc.x) + w0[3].y * bfhi(xd.x);
        y[2] = w0[0].z * bflo(xa.y) + w0[1].z * bflo(xb.y) + w0[2].z * bflo(xc.y) + w0[3].z * bflo(xd.y);
        y[3] = w0[0].w * bfhi(xa.y) + w0[1].w * bfhi(xb.y) + w0[2].w * bfhi(xc.y) + w0[3].w * bfhi(xd.y);
        y[4] = w1[0].x * bflo(xa.z) + w1[1].x * bflo(xb.z) + w1[2].x * bflo(xc.z) + w1[3].x * bflo(xd.z);
        y[5] = w1[0].y * bfhi(xa.z) + w1[1].y * bfhi(xb.z) + w1[2].y * bfhi(xc.z) + w1[3].y * bfhi(xd.z);
        y[6] = w1[0].z * bflo(xa.w) + w1[1].z * bflo(xb.w) + w1[2].z * bflo(xc.w) + w1[3].z * bflo(xd.w);
        y[7] = w1[0].w * bfhi(xa.w) + w1[1].w * bfhi(xb.w) + w1[2].w * bfhi(xc.w) + w1[3].w * bfhi(xd.w);
        float q = 0.f;
#pragma unroll
        for (int j = 0; j < 8; ++j) { y[j] = y[j] * sigmoidf_(y[j]); q += y[j] * y[j]; }
        q += __shfl_xor(q, 1); q += __shfl_xor(q, 2); q += __shfl_xor(q, 4); q += __shfl_xor(q, 8);
        f(row0 + it, c16, y, q);
        xa = xb; xb = xc; xc = xd; xd = xe; xe = xf; xf = xn; }
}
__device__ __forceinline__ int tile_off(int row, int chunk) { return row * 256 + ((chunk ^ (row & 15)) << 4); }
__device__ __forceinline__ void dn_chunk_prep(const Ctx& C, int u0, int ustride) {
    const bf16* P = WSP(bf16, WS_P); const float* cw = ((const float*)C.A->in[4]);
    LAS unsigned char* wl = C.lds + C.wave * 16384;
    LAS float* gcl = (LAS float*)(C.lds + XTRA_OFF + C.wave * 1024);
    LAS float* betal = gcl + 64; LAS float* ssl = gcl + 128;
    for (int u = u0; u < BATCH * HA * 32; u += ustride) {
        const int n = u & 31, h = (u >> 5) & 15, b = u >> 9, m0 = b * SEQ + n * CHUNK;
        int lane = C.lane; asm volatile("" : "+v"(lane));
        const int r = lane & 31, hf = lane >> 5, lane16 = lane * 16;
        unsigned char* rec = C.ws + WS_REC + (size_t)u * 65536;
        float gcv, betav;
        { const float aa = bf2f(P[(size_t)(m0 + lane) * NP + C_AA + h]), ba = bf2f(P[(size_t)(m0 + lane) * NP + C_BA + h]);
          const float xs = aa + ((const float*)C.A->in[6])[h]; const float sp = xs > 20.f ? xs : log1pf(__expf(xs));
          gcv = -__expf(((const float*)C.A->in[5])[h]) * sp; betav = sigmoidf_(ba);
#pragma unroll
          for (int o = 1; o < 64; o <<= 1) { const float t = __shfl_up(gcv, o); if (lane >= o) gcv += t; } }
        const float glast = __shfl(gcv, 63);
        gcl[lane] = gcv; betal[lane] = betav; LDS_WAIT();
        if (lane == 0) WSP(float, WS_EGL)[u] = __expf(glast);
        float gc_a[2], be_a[2];
#pragma unroll
        for (int a = 0; a < 2; ++a) { gc_a[a] = __shfl(gcv, r + 32 * a); be_a[a] = __shfl(betav, r + 32 * a); }
        bf16x8 kf[2][8];
        { conv_rows(P, cw, m0, n * CHUNK, C_KA + h * 128, lane, [&](int row, int c16, const float* y, float q) { *(LAS bf16x8*)(wl + tile_off(row, c16)) = pack8f(y); if (c16 == 0) ssl[row] = q; });
          LDS_WAIT();
          const float ss0 = ssl[r], ss1 = ssl[32 + r];
#pragma unroll 4
          for (int it = 0; it < 16; ++it) { const int a = it >> 3, s = it & 7;
              const float sc = __builtin_amdgcn_rsqf((a ? ss1 : ss0) + EPS), f1 = -(a ? be_a[1] : be_a[0]) * __expf(a ? gc_a[1] : gc_a[0]);
              LAS bf16x8* tp = (LAS bf16x8*)(wl + tile_off(32 * a + r, 2 * s + hf));
              const v4u w = __builtin_bit_cast(v4u, *tp);
              float y[8] = {bflo(w.x) * sc, bfhi(w.x) * sc, bflo(w.y) * sc, bfhi(w.y) * sc, bflo(w.z) * sc, bfhi(w.z) * sc, bflo(w.w) * sc, bfhi(w.w) * sc}, t[8];
#pragma unroll
              for (int j = 0; j < 8; ++j) t[j] = y[j] * f1;
              store_perm_frag(rec, a * 8 + s, lane16, t);
              *tp = pack8f(y); }
          LDS_WAIT(); }
#pragma unroll
        for (int a = 0; a < 2; ++a)
#pragma unroll
            for (int s = 0; s < 8; ++s) kf[a][s] = *(const LAS bf16x8*)(wl + tile_off(32 * a + r, 2 * s + hf));
        LDS_WAIT();
#pragma unroll 4
        for (int it = 0; it < 16; ++it) { const int a = it >> 3, s = it & 7; const float f2 = __expf(glast - (a ? gc_a[1] : gc_a[0]));
            LAS bf16x8* tp = (LAS bf16x8*)(wl + tile_off(32 * a + r, 2 * s + hf));
            const v4u w = __builtin_bit_cast(v4u, *tp);
            float t[8] = {bflo(w.x) * f2, bfhi(w.x) * f2, bflo(w.y) * f2, bfhi(w.y) * f2, bflo(w.z) * f2, bfhi(w.z) * f2, bflo(w.w) * f2, bfhi(w.w) * f2};
            *tp = pack8f(t); }
        LDS_WAIT();
#pragma unroll 2
        for (int f = 0; f < 16; ++f) { const int db = f >> 2, kst = f & 3; unsigned short e[8];
#pragma unroll
            for (int j = 0; j < 8; ++j) { const int tok = 16 * kst + 8 * (j >> 2) + 4 * hf + (j & 3); e[j] = *(const LAS unsigned short*)(wl + tile_off(tok, 4 * db + (r >> 3)) + (r & 7) * 2); }
            v4u w = {(unsigned)e[0] | ((unsigned)e[1] << 16), (unsigned)e[2] | ((unsigned)e[3] << 16), (unsigned)e[4] | ((unsigned)e[5] << 16), (unsigned)e[6] | ((unsigned)e[7] << 16)};
            *(v4u*)(rec + (size_t)(32 + f) * 1024 + lane16) = w; }
        LDS_WAIT();
        { conv_rows(P, cw, m0, n * CHUNK, C_QA + h * 128, lane, [&](int row, int c16, const float* y, float q) { *(LAS bf16x8*)(wl + tile_off(row, c16)) = pack8f(y); if (c16 == 0) ssl[row] = q; });
          LDS_WAIT();
          const float ss0 = ssl[r], ss1 = ssl[32 + r];
#pragma unroll 4
          for (int it = 0; it < 16; ++it) { const int a = it >> 3, s = it & 7;
              const float sc = 0.08838834764831845f / sqrtf((a ? ss1 : ss0) + EPS), eg = __expf(a ? gc_a[1] : gc_a[0]);
              LAS bf16x8* tp = (LAS bf16x8*)(wl + tile_off(32 * a + r, 2 * s + hf));
              const v4u w = __builtin_bit_cast(v4u, *tp);
              float y[8] = {bflo(w.x) * sc, bfhi(w.x) * sc, bflo(w.y) * sc, bfhi(w.y) * sc, bflo(w.z) * sc, bfhi(w.z) * sc, bflo(w.w) * sc, bfhi(w.w) * sc}, t[8];
#pragma unroll
              for (int j = 0; j < 8; ++j) t[j] = y[j] * eg;
              store_perm_frag(rec, 16 + a * 8 + s, lane16, t);
              *tp = pack8f(y); }
          LDS_WAIT(); }
        { const v4u z = {0u, 0u, 0u, 0u};
          *(v4u*)(rec + (size_t)(48 + 2) * 1024 + lane16) = z; *(v4u*)(rec + (size_t)(48 + 3) * 1024 + lane16) = z; }
#pragma unroll
        for (int tix = 0; tix < 3; ++tix) { const int jb = tix == 2 ? 1 : 0, ib = tix == 0 ? 0 : 1;
            f32x16 acc = {};
#pragma unroll
            for (int s = 0; s < 8; ++s) acc = __builtin_amdgcn_mfma_f32_32x32x16_bf16(kf[jb][s], *(const LAS bf16x8*)(wl + tile_off(32 * ib + r, 2 * s + hf)), acc, 0, 0, 0);
            const int i = 32 * ib + r; float t[16];
#pragma unroll
            for (int q = 0; q < 4; ++q) { const f32x4 gj = *(const LAS f32x4*)(gcl + 32 * jb + 8 * q + 4 * hf);
#pragma unroll
                for (int e = 0; e < 4; ++e) { const int j = 32 * jb + 8 * q + 4 * hf + e; t[4 * q + e] = (i >= j) ? acc[4 * q + e] * __expf(gc_a[ib] - gj[e]) : 0.f; } }
            *(bf16x8*)(rec + (size_t)(48 + ib * 4 + 2 * jb) * 1024 + lane16) = pack8f(t);
            *(bf16x8*)(rec + (size_t)(48 + ib * 4 + 2 * jb + 1) * 1024 + lane16) = pack8f(t + 8); }
        LDS_WAIT();
        { conv_rows(P, cw, m0, n * CHUNK, C_VA + h * 128, lane, [&](int row, int c16, const float* y, float q) { (void)q; const float bb = betal[row]; float t[8];
#pragma unroll
              for (int j = 0; j < 8; ++j) t[j] = y[j] * bb;
              *(LAS bf16x8*)(wl + tile_off(row, c16)) = pack8f(t); });
          LDS_WAIT();
          unsigned char* vbc = C.ws + WS_VBC + (size_t)u * 16384 + lane * 32;
#pragma unroll 2
          for (int q = 0; q < 8; ++q) { const int sl = q >> 1, rb = q & 1, ch = 32 * sl + r; unsigned short e[16];
#pragma unroll
              for (int i = 0; i < 16; ++i) e[i] = *(const LAS unsigned short*)(wl + tile_off(32 * rb + crow(i, hf), ch >> 3) + (ch & 7) * 2);
              v4u w0 = {(unsigned)e[0] | ((unsigned)e[1] << 16), (unsigned)e[2] | ((unsigned)e[3] << 16), (unsigned)e[4] | ((unsigned)e[5] << 16), (unsigned)e[6] | ((unsigned)e[7] << 16)};
              v4u w1 = {(unsigned)e[8] | ((unsigned)e[9] << 16), (unsigned)e[10] | ((unsigned)e[11] << 16), (unsigned)e[12] | ((unsigned)e[13] << 16), (unsigned)e[14] | ((unsigned)e[15] << 16)};
              *(v4u*)(vbc + sl * 4096 + rb * 2048) = w0; *(v4u*)(vbc + sl * 4096 + rb * 2048 + 16) = w1; }
          LDS_WAIT(); }
        LAS float* Lt = (LAS float*)wl;
#pragma unroll
        for (int tix = 0; tix < 3; ++tix) { const int jb = tix == 2 ? 1 : 0, ib = tix == 0 ? 0 : 1;
            f32x16 acc = {};
#pragma unroll
            for (int s = 0; s < 8; ++s) acc = __builtin_amdgcn_mfma_f32_32x32x16_bf16(kf[jb][s], kf[ib][s], acc, 0, 0, 0);
            const int i = 32 * ib + r;
#pragma unroll
            for (int q = 0; q < 4; ++q) { const f32x4 gj = *(const LAS f32x4*)(gcl + 32 * jb + 8 * q + 4 * hf);
#pragma unroll
                for (int e = 0; e < 4; ++e) { const int j = 32 * jb + 8 * q + 4 * hf + e;
                    Lt[j * 64 + i] = (i > j) ? be_a[ib] * acc[4 * q + e] * __expf(gc_a[ib] - gj[e]) : 0.f; } } }
        { const f32x4 z4 = {0.f, 0.f, 0.f, 0.f};
#pragma unroll
          for (int q = 0; q < 4; ++q) { const int idx = q * 64 + lane; *(LAS f32x4*)(Lt + (32 + (idx >> 3)) * 64 + (idx & 7) * 4) = z4; } }
        LDS_WAIT();
        { LAS float* Lb = Lt + hf * (32 * 64 + 32);
#pragma unroll 1
          for (int j = 31; j >= 0; --j) {
              float a0 = (r == j) ? 1.f : 0.f, a1 = 0.f, a2 = 0.f, a3 = 0.f;
#pragma unroll 4
              for (int q = (j + 1) >> 2; q < 8; ++q) { const f32x4 l4 = *(const LAS f32x4*)(Lb + j * 64 + 4 * q);
                  a0 -= Lb[(4 * q) * 64 + r] * l4.x; a1 -= Lb[(4 * q + 1) * 64 + r] * l4.y; a2 -= Lb[(4 * q + 2) * 64 + r] * l4.z; a3 -= Lb[(4 * q + 3) * 64 + r] * l4.w; }
              Lb[j * 64 + r] = (a0 + a1) + (a2 + a3);
          } }
        LDS_WAIT();
        { f32x16 W = {};
#pragma unroll
          for (int s2 = 0; s2 < 2; ++s2) { float ta[8], tb[8];
#pragma unroll
              for (int e = 0; e < 8; ++e) ta[e] = Lt[(16 * s2 + 8 * hf + e) * 64 + 32 + r];
              const f32x4 b0 = *(const LAS f32x4*)(Lt + r * 64 + 16 * s2 + 8 * hf), b1 = *(const LAS f32x4*)(Lt + r * 64 + 16 * s2 + 8 * hf + 4);
              tb[0] = b0.x; tb[1] = b0.y; tb[2] = b0.z; tb[3] = b0.w; tb[4] = b1.x; tb[5] = b1.y; tb[6] = b1.z; tb[7] = b1.w;
              W = __builtin_amdgcn_mfma_f32_32x32x16_bf16(pack8f(ta), pack8f(tb), W, 0, 0, 0); }
          f32x16 Z = {};
#pragma unroll
          for (int s2 = 0; s2 < 2; ++s2) { float ta[8], tw[8];
#pragma unroll
              for (int e = 0; e < 8; ++e) { const int k = 16 * s2 + 8 * (e >> 2) + 4 * hf + (e & 3); ta[e] = Lt[(32 + k) * 64 + 32 + r]; tw[e] = W[8 * s2 + e]; }
              Z = __builtin_amdgcn_mfma_f32_32x32x16_bf16(pack8f(ta), pack8f(tw), Z, 0, 0, 0); }
          LDS_WAIT();
#pragma unroll
          for (int i = 0; i < 16; ++i) Lt[r * 64 + 32 + crow(i, hf)] = -Z[i]; }
        LDS_WAIT();
#pragma unroll 1
        for (int s = 0; s < 4; ++s)
#pragma unroll
            for (int h2 = 0; h2 < 2; ++h2) { float t[8];
#pragma unroll
                for (int e = 0; e < 4; ++e) { t[e] = Lt[(16 * s + 4 * h2 + e) * 64 + lane]; t[4 + e] = Lt[(16 * s + 8 + 4 * h2 + e) * 64 + lane]; }
                *(bf16x8*)(rec + (size_t)(56 + (lane >> 5) * 4 + s) * 1024 + (lane16 & 511) + 512 * h2) = pack8f(t); }
        LDS_WAIT();
    }
}
__device__ __forceinline__ void dn_scan(const Ctx& C, int unit) {
    const int wave = C.wave, tid = C.tid, b = unit >> 4, h = unit & 15;
    int lane = C.lane; asm volatile("" : "+v"(lane));
    const unsigned char* recs = C.ws + WS_REC + (size_t)unit * 32 * 65536;
    bf16* OR = WSP(bf16, WS_ORAWB);
    f32x16 S[4];
#pragma unroll
    for (int d = 0; d < 4; ++d) S[d] = f32x16{};
    __syncthreads();
    if (wave >= 4) {
        unsigned t16 = (unsigned)(tid - 256) * 16u; asm volatile("" : "+v"(t16));
        v4u pre[16];
        { v4u tmp[16];
#pragma unroll
          for (int p = 0; p < 16; ++p) tmp[p] = *(const v4u*)(recs + p * 4096 + t16);
#pragma unroll
          for (int p = 0; p < 16; ++p) pre[p] = *(const v4u*)(recs + 65536 + p * 4096 + t16);
#pragma unroll
          for (int p = 0; p < 16; ++p) *(LAS v4u*)(C.lds + p * 4096 + t16) = tmp[p]; }
        for (int n = 0; n < 32; ++n) {
            asm volatile("s_waitcnt lgkmcnt(0)\n\ts_barrier" ::: "memory");
            if (n + 1 < 32) { LAS unsigned char* dst = C.lds + ((n + 1) & 1) * 65536;
#pragma unroll
                for (int p = 0; p < 16; ++p) *(LAS v4u*)(dst + p * 4096 + t16) = pre[p];
                if (n + 2 < 32) { const unsigned char* src = recs + (size_t)(n + 2) * 65536;
#pragma unroll
                    for (int p = 0; p < 16; ++p) pre[p] = *(const v4u*)(src + p * 4096 + t16); } }
        }
        __syncthreads();
        return;
    }
    v4u vb[4];
    { const unsigned char* vp = C.ws + WS_VBC + (size_t)(unit * 32) * 16384 + wave * 4096 + lane * 32;
      vb[0] = *(const v4u*)vp; vb[1] = *(const v4u*)(vp + 16); vb[2] = *(const v4u*)(vp + 2048); vb[3] = *(const v4u*)(vp + 2048 + 16); }
    for (int n = 0; n < 32; ++n) {
        asm volatile("s_waitcnt lgkmcnt(0)\n\ts_barrier" ::: "memory");
        {
            asm volatile("" : "+v"(lane));
            const int r = lane & 31, hf = lane >> 5;
            const LAS unsigned char* rb_ = C.lds + (n & 1) * 65536 + lane * 16;
#define FRAG(f) (*(const LAS bf16x8*)(rb_ + (f) * 1024))
            const float egl = WSP(float, WS_EGL)[unit * 32 + n];
            f32x16 X[2];
#pragma unroll
            for (int a = 0; a < 2; ++a) { const v4u w0 = vb[2 * a], w1 = vb[2 * a + 1];
                X[a][0] = bflo(w0.x); X[a][1] = bfhi(w0.x); X[a][2] = bflo(w0.y); X[a][3] = bfhi(w0.y); X[a][4] = bflo(w0.z); X[a][5] = bfhi(w0.z); X[a][6] = bflo(w0.w); X[a][7] = bfhi(w0.w);
                X[a][8] = bflo(w1.x); X[a][9] = bfhi(w1.x); X[a][10] = bflo(w1.y); X[a][11] = bfhi(w1.y); X[a][12] = bflo(w1.z); X[a][13] = bfhi(w1.z); X[a][14] = bflo(w1.w); X[a][15] = bfhi(w1.w); }
            if (n + 1 < 32) { const unsigned char* vp = C.ws + WS_VBC + (size_t)(unit * 32 + n + 1) * 16384 + wave * 4096 + lane * 32;
                vb[0] = *(const v4u*)vp; vb[1] = *(const v4u*)(vp + 16); vb[2] = *(const v4u*)(vp + 2048); vb[3] = *(const v4u*)(vp + 2048 + 16); }
            bf16x8 Sb[8];
#pragma unroll
            for (int d = 0; d < 4; ++d) { float t[16];
#pragma unroll
                for (int i = 0; i < 16; ++i) t[i] = S[d][i];
                Sb[2 * d] = pack8f(t); Sb[2 * d + 1] = pack8f(t + 8); }
            { bf16x8 f0 = FRAG(0), f1 = FRAG(8);
#pragma unroll
              for (int ks = 0; ks < 8; ++ks) { const bf16x8 g0 = f0, g1 = f1;
                  if (ks < 7) { f0 = FRAG(ks + 1); f1 = FRAG(8 + ks + 1); }
                  X[0] = __builtin_amdgcn_mfma_f32_32x32x16_bf16(g0, Sb[ks], X[0], 0, 0, 0); X[1] = __builtin_amdgcn_mfma_f32_32x32x16_bf16(g1, Sb[ks], X[1], 0, 0, 0); } }
            bf16x8 Xb[4];
#pragma unroll
            for (int a = 0; a < 2; ++a) { float t[16];
#pragma unroll
                for (int i = 0; i < 16; ++i) t[i] = X[a][i];
                Xb[2 * a] = pack8f(t); Xb[2 * a + 1] = pack8f(t + 8); }
            f32x16 V[2] = {f32x16{}, f32x16{}};
#pragma unroll
            for (int kst = 0; kst < 2; ++kst) { V[0] = __builtin_amdgcn_mfma_f32_32x32x16_bf16(FRAG(56 + kst), Xb[kst], V[0], 0, 0, 0); V[1] = __builtin_amdgcn_mfma_f32_32x32x16_bf16(FRAG(60 + kst), Xb[kst], V[1], 0, 0, 0); }
#pragma unroll
            for (int kst = 2; kst < 4; ++kst) V[1] = __builtin_amdgcn_mfma_f32_32x32x16_bf16(FRAG(60 + kst), Xb[kst], V[1], 0, 0, 0);
            bf16x8 Vb[4];
#pragma unroll
            for (int a = 0; a < 2; ++a) { float t[16];
#pragma unroll
                for (int i = 0; i < 16; ++i) t[i] = V[a][i];
                Vb[2 * a] = pack8f(t); Vb[2 * a + 1] = pack8f(t + 8); }
            f32x16 O[2] = {f32x16{}, f32x16{}};
            { bf16x8 f0 = FRAG(16), f1 = FRAG(24);
#pragma unroll
              for (int ks = 0; ks < 8; ++ks) { const bf16x8 g0 = f0, g1 = f1;
                  if (ks < 7) { f0 = FRAG(16 + ks + 1); f1 = FRAG(24 + ks + 1); }
                  O[0] = __builtin_amdgcn_mfma_f32_32x32x16_bf16(g0, Sb[ks], O[0], 0, 0, 0); O[1] = __builtin_amdgcn_mfma_f32_32x32x16_bf16(g1, Sb[ks], O[1], 0, 0, 0); } }
#pragma unroll
            for (int kst = 0; kst < 2; ++kst) { O[0] = __builtin_amdgcn_mfma_f32_32x32x16_bf16(FRAG(48 + kst), Vb[kst], O[0], 0, 0, 0); O[1] = __builtin_amdgcn_mfma_f32_32x32x16_bf16(FRAG(52 + kst), Vb[kst], O[1], 0, 0, 0); }
#pragma unroll
            for (int kst = 2; kst < 4; ++kst) O[1] = __builtin_amdgcn_mfma_f32_32x32x16_bf16(FRAG(52 + kst), Vb[kst], O[1], 0, 0, 0);
#pragma unroll
            for (int d = 0; d < 4; ++d) {
#pragma unroll
                for (int i = 0; i < 16; ++i) S[d][i] *= egl; }
#pragma unroll
            for (int kst = 0; kst < 4; ++kst) { const bf16x8 k0 = FRAG(32 + kst), k1 = FRAG(36 + kst), k2 = FRAG(40 + kst), k3 = FRAG(44 + kst);
                S[0] = __builtin_amdgcn_mfma_f32_32x32x16_bf16(k0, Vb[kst], S[0], 0, 0, 0); S[1] = __builtin_amdgcn_mfma_f32_32x32x16_bf16(k1, Vb[kst], S[1], 0, 0, 0);
                S[2] = __builtin_amdgcn_mfma_f32_32x32x16_bf16(k2, Vb[kst], S[2], 0, 0, 0); S[3] = __builtin_amdgcn_mfma_f32_32x32x16_bf16(k3, Vb[kst], S[3], 0, 0, 0); }
            bf16* op = OR + (size_t)(b * SEQ + n * CHUNK) * DM + h * 128 + wave * 32 + r;
            const int odd = r & 1; bf16* opl = op - odd;
#pragma unroll
            for (int a = 0; a < 2; ++a)
#pragma unroll
                for (int i = 0; i < 16; i += 2) { const float va = O[a][i], vb2 = O[a][i + 1], x = __shfl_xor(odd ? va : vb2, 1);
                    *(unsigned*)(opl + (size_t)(32 * a + crow(i, hf) + odd) * DM) = odd ? cvtpk(x, vb2) : cvtpk(va, x); }
#undef FRAG
        }
    }
    __syncthreads();
}
__device__ __forceinline__ void dn_post2(const Ctx& C) {
    const bf16* P = WSP(bf16, WS_P); const bf16* OR = WSP(bf16, WS_ORAWB); bf16* OA = WSP(bf16, WS_OA);
    const int gw = C.bid * NWAVES + C.wave, NGW = C.G * NWAVES, lane = C.lane;
    const float* ng = (const float*)C.A->in[7] + 8 * (lane & 15);
    const f32x4 n0 = *(const f32x4*)ng, n1 = *(const f32x4*)(ng + 4);
    for (int m = gw; m < T; m += NGW) {
        v4u ow[4], zw[4];
#pragma unroll
        for (int j = 0; j < 4; ++j) { ow[j] = *(const v4u*)(OR + (size_t)m * DM + 8 * (lane + 64 * j)); zw[j] = *(const v4u*)(P + (size_t)m * NP + C_ZA + 8 * (lane + 64 * j)); }
#pragma unroll
        for (int j = 0; j < 4; ++j) {
            float o[8] = {bflo(ow[j].x), bfhi(ow[j].x), bflo(ow[j].y), bfhi(ow[j].y), bflo(ow[j].z), bfhi(ow[j].z), bflo(ow[j].w), bfhi(ow[j].w)};
            const float z[8] = {bflo(zw[j].x), bfhi(zw[j].x), bflo(zw[j].y), bfhi(zw[j].y), bflo(zw[j].z), bfhi(zw[j].z), bflo(zw[j].w), bfhi(zw[j].w)};
            float q = 0.f;
#pragma unroll
            for (int e = 0; e < 8; ++e) q += o[e] * o[e];
            q += __shfl_xor(q, 1); q += __shfl_xor(q, 2); q += __shfl_xor(q, 4); q += __shfl_xor(q, 8);
            const float rr = __builtin_amdgcn_rsqf(q * (1.f / 128.f) + EPS);
            const float g[8] = {n0.x, n0.y, n0.z, n0.w, n1.x, n1.y, n1.z, n1.w};
#pragma unroll
            for (int e = 0; e < 8; ++e) o[e] = o[e] * rr * g[e] * z[e] * sigmoidf_(z[e]);
            v4u r; r.x = cvtpk(o[0], o[1]); r.y = cvtpk(o[2], o[3]); r.z = cvtpk(o[4], o[5]); r.w = cvtpk(o[6], o[7]);
            *(v4u*)(OA + (size_t)m * DM + 8 * (lane + 64 * j)) = r; }
    }
}
constexpr size_t WS_W1K = 109 * MiB, WS_W1V = 110 * MiB, WS_W2K = 111 * MiB, WS_W2V = 111 * MiB + 65536;
constexpr size_t WS_KT = 5 * MiB, WS_VTT = 7 * MiB;
__device__ __forceinline__ int ktile_off(int row, int chunk) { return row * 256 + ((chunk ^ (row & 15)) << 4); }
__device__ __forceinline__ int vtile_off(int dim, int key) { return dim * 256 + ((((key >> 2) ^ (dim & 31))) << 3) + (key & 3) * 2; }
__device__ __forceinline__ void nsa_compress2(const Ctx& C) {
    const bf16* P = WSP(bf16, WS_P);
    LAS float* red = (LAS float*)C.lds;
    LAS unsigned char* hid = C.lds + XTRA_OFF;
    for (int unit = C.bid; unit < 256; unit += C.G) {
        int lane = C.lane; asm volatile("" : "+v"(lane));
        const int r = lane & 31, hf = lane >> 5, w = C.wave;
        const int kv = unit >> 7, b = (unit >> 4) & 7, g = (unit >> 2) & 3, rbk = unit & 3;
        const bf16* W1T = WSP(bf16, kv ? WS_W1V : WS_W1K); const bf16* W2T = WSP(bf16, kv ? WS_W2V : WS_W2K);
        const float* pe = (const float*)C.A->in[kv ? 11 : 8];
        const int c = 32 * rbk + r; const bool valid = c < NCMP;
        const bf16* xrow = P + (size_t)(b * SEQ + (valid ? 16 * c : 0)) * NP + (kv ? C_VC : C_KC) + g * 128 + 8 * hf;
        f32x16 acc[4] = {f32x16{}, f32x16{}, f32x16{}, f32x16{}};
        __syncthreads();
#pragma unroll 1
        for (int l = 4 * w; l < 4 * w + 4; ++l) {
#pragma unroll 4
            for (int s = 0; s < 8; ++s) {
                const v4u xw = *(const v4u*)(xrow + (size_t)l * NP + 16 * s);
                const f32x4 p0 = *(const f32x4*)(pe + l * 128 + 16 * s + 8 * hf), p1 = *(const f32x4*)(pe + l * 128 + 16 * s + 8 * hf + 4);
                float t[8] = {bflo(xw.x) + p0.x, bfhi(xw.x) + p0.y, bflo(xw.y) + p0.z, bfhi(xw.y) + p0.w, bflo(xw.z) + p1.x, bfhi(xw.z) + p1.y, bflo(xw.w) + p1.z, bfhi(xw.w) + p1.w};
                const bf16x8 af = pack8f(t);
                const bf16* wp = W1T + ((size_t)(l * 8 + s) * 4 * 64 + lane) * 8;
#pragma unroll
                for (int nt = 0; nt < 4; ++nt) acc[nt] = __builtin_amdgcn_mfma_f32_32x32x16_bf16(af, *(const bf16x8*)(wp + nt * 512), acc[nt], 0, 0, 0);
            }
        }
#pragma unroll
        for (int nt = 0; nt < 4; ++nt)
#pragma unroll
            for (int i = 0; i < 16; ++i) red[(w * 32 + crow(i, hf)) * 128 + 32 * nt + r] = acc[nt][i];
        __syncthreads();
#pragma unroll
        for (int q = 0; q < 8; ++q) { const int e = C.tid + 512 * q; float sum = 0.f;
#pragma unroll
            for (int ww = 0; ww < 8; ++ww) sum += red[ww * 4096 + e];
            const float u2 = 1.5957691216057308f * (sum + 0.044715f * sum * sum * sum);
            const int row = e >> 7, col = e & 127;
            *(LAS unsigned short*)(hid + ktile_off(row, col >> 3) + (col & 7) * 2) = (unsigned short)f2bf(sum * sigmoidf_(u2)); }
        __syncthreads();
        if (w < 4) {
            f32x16 o = f32x16{};
#pragma unroll
            for (int s = 0; s < 8; ++s) o = __builtin_amdgcn_mfma_f32_32x32x16_bf16(*(const LAS bf16x8*)(hid + ktile_off(r, 2 * s + hf)), *(const bf16x8*)(W2T + (size_t)(32 * w + r) * 128 + 16 * s + 8 * hf), o, 0, 0, 0);
            const int bg = b * 4 + g, n = 32 * w + r;
#pragma unroll
            for (int i = 0; i < 16; ++i) { const int ci = 32 * rbk + crow(i, hf); const unsigned short v = ci < NCMP ? (unsigned short)f2bf(o[i]) : (unsigned short)0;
                if (kv == 0) WSP(unsigned short, WS_KT)[((size_t)bg * 128 + ci) * 128 + n] = v; else WSP(unsigned short, WS_VTT)[((size_t)bg * 128 + n) * 128 + ci] = v; }
        }
    }
    __syncthreads();
}
__device__ __forceinline__ void nsa_cmp_attn2(const Ctx& C, int wi, int nwg) {
    const bf16* P = WSP(bf16, WS_P); bf16* OC = WSP(bf16, WS_OCB); unsigned* SEL = WSP(unsigned, WS_SEL);
    LAS unsigned char* Kl = C.lds; LAS unsigned char* Vl = C.lds + 32768;
    const int per = 2048 / nwg;
    int cur_bg = -1;
    for (int j0 = 0; j0 < per; j0 += NWAVES) {
        const int job = wi * per + j0 + C.wave, bg = job >> 6, tb32 = job & 63, b = bg >> 2, g = bg & 3;
        if (((wi * per + j0) >> 6) != cur_bg) { cur_bg = (wi * per + j0) >> 6;
            __syncthreads();
            const v4u* ks = (const v4u*)(C.ws + WS_KT + (size_t)cur_bg * 32768); const v2u* vs = (const v2u*)(C.ws + WS_VTT + (size_t)cur_bg * 32768);
#pragma unroll
            for (int q = 0; q < 4; ++q) { const int idx = C.tid + 512 * q; *(LAS v4u*)(Kl + ktile_off(idx >> 4, idx & 15)) = ks[idx]; }
#pragma unroll
            for (int q = 0; q < 8; ++q) { const int idx = C.tid + 512 * q, dim = idx >> 5, gr = idx & 31; *(LAS v2u*)(Vl + vtile_off(dim, gr * 4)) = vs[idx]; }
            __syncthreads(); }
        int lane = C.lane; asm volatile("" : "+v"(lane));
        int r32 = lane & 31, hi = lane >> 5; const int t = 32 * tb32 + r32, m = b * SEQ + t;
        int nvalid = t >= 31 ? ((t - 31) >> 4) + 1 : 0;
        const int tmax = 32 * tb32 + 31, ntile = __builtin_amdgcn_readfirstlane((((tmax - 31) >> 4) + 1 + 31) >> 5);
        float imp[16];
#pragma unroll
        for (int sl = 0; sl < 16; ++sl) imp[sl] = 0.f;
#pragma unroll 1
        for (int rh = 0; rh < RG; ++rh) {
            asm volatile("" : "+v"(r32), "+v"(hi), "+v"(nvalid));
            f32x16 p[4];
            { bf16x8 qf[8];
#pragma unroll
              for (int s = 0; s < 8; ++s) qf[s] = *(const bf16x8*)(P + (size_t)m * NP + C_QB + (g * 4 + rh) * 128 + 16 * s + 8 * hi);
#pragma unroll
              for (int kt = 0; kt < 4; ++kt) { p[kt] = f32x16{};
                  if (kt < ntile) {
#pragma unroll
                      for (int s = 0; s < 8; ++s) p[kt] = __builtin_amdgcn_mfma_f32_32x32x16_bf16(*(const LAS bf16x8*)(Kl + ktile_off(32 * kt + r32, 2 * s + hi)), qf[s], p[kt], 0, 0, 0); } } }
            float mx = -1e30f;
#pragma unroll
            for (int kt = 0; kt < 4; ++kt)
#pragma unroll
                for (int i = 0; i < 16; ++i) { const bool ok = 32 * kt + crow(i, hi) < nvalid; p[kt][i] = ok ? p[kt][i] * 0.08838834764831845f : -1e30f; mx = fmaxf(mx, p[kt][i]); }
            mx = fmaxf(mx, __shfl_xor(mx, 32));
            float sum = 0.f;
#pragma unroll
            for (int kt = 0; kt < 4; ++kt)
#pragma unroll
                for (int i = 0; i < 16; ++i) { const float e = __expf(p[kt][i] - mx); p[kt][i] = e; sum += e; }
            sum += __shfl_xor(sum, 32);
            const float inv = nvalid > 0 ? __builtin_amdgcn_rcpf(sum) : 0.f;
#pragma unroll
            for (int kt = 0; kt < 4; ++kt)
#pragma unroll
                for (int i = 0; i < 16; ++i) p[kt][i] *= inv;
#pragma unroll
            for (int sl = 0; sl < 16; ++sl) { const int kt = sl >> 2, qg = sl & 3;
                const float G = (p[kt][4 * qg] + p[kt][4 * qg + 1]) + (p[kt][4 * qg + 2] + p[kt][4 * qg + 3]);
                const float same = __shfl_xor(p[kt][4 * qg + 3], 32);
                const float prev = sl > 0 ? __shfl_xor(p[(sl > 0 ? sl - 1 : 0) >> 2][4 * ((sl > 0 ? sl - 1 : 0) & 3) + 3], 32) : 0.f;
                imp[sl] += G + (hi ? same : prev); }
            { f32x16 o[4] = {f32x16{}, f32x16{}, f32x16{}, f32x16{}};
#pragma unroll
              for (int ks = 0; ks < 8; ++ks) { if ((ks >> 1) >= ntile) continue; float tt[8];
#pragma unroll
                  for (int j = 0; j < 8; ++j) tt[j] = p[ks >> 1][8 * (ks & 1) + j];
                  const bf16x8 pa = pack8f(tt);
#pragma unroll
                  for (int dt = 0; dt < 4; ++dt) { const int dim = 32 * dt + r32;
                      const v2u lo = *(const LAS v2u*)(Vl + vtile_off(dim, 16 * ks + 4 * hi)), hv = *(const LAS v2u*)(Vl + vtile_off(dim, 16 * ks + 8 + 4 * hi));
                      const v4u bw = {lo.x, lo.y, hv.x, hv.y};
                      o[dt] = __builtin_amdgcn_mfma_f32_32x32x16_bf16(pa, __builtin_bit_cast(bf16x8, bw), o[dt], 0, 0, 0); } }
              const int odd = r32 & 1; bf16* opl = OC + (size_t)(b * SEQ + 32 * tb32) * DM + (g * 4 + rh) * 128 + r32 - odd;
#pragma unroll
              for (int dt = 0; dt < 4; ++dt)
#pragma unroll
                  for (int i = 0; i < 16; i += 2) { const float a = o[dt][i], b2 = o[dt][i + 1], x = __shfl_xor(odd ? a : b2, 1);
                      *(unsigned*)(opl + (size_t)(crow(i, hi) + odd) * DM + 32 * dt) = odd ? cvtpk(x, b2) : cvtpk(a, x); } }
        }
        { const int cur = t >> 6; const float INF = __builtin_inff();
          float oth[16];
#pragma unroll
          for (int sl = 0; sl < 16; ++sl) { const int j = 2 * sl + hi, jo = 2 * sl + (1 - hi);
              float v = imp[sl]; if (j == 0 || j == cur) v = INF; else if (j > cur) v = -INF; imp[sl] = v;
              (void)jo; }
#pragma unroll
          for (int sl = 0; sl < 16; ++sl) oth[sl] = __shfl_xor(imp[sl], 32);
          unsigned bits = 0u;
#pragma unroll
          for (int sl = 0; sl < 16; ++sl) { const int j = 2 * sl + hi; const float v = imp[sl]; int rank = 0;
#pragma unroll
              for (int q = 0; q < 16; ++q) { const int jm = 2 * q + hi, jo = 2 * q + (1 - hi);
                  rank += (imp[q] > v || (imp[q] == v && jm < j)) ? 1 : 0;
                  rank += (oth[q] > v || (oth[q] == v && jo < j)) ? 1 : 0; }
              if (rank < 8 && j <= cur) bits |= 1u << j; }
          bits |= __shfl_xor(bits, 32);
          if (hi == 0) SEL[(size_t)m * GKV + g] = bits; }
    }
    __syncthreads();
}
namespace fa {
constexpr float SCALE = 0.08838834764831845f; constexpr int D = 128;
constexpr int NW = 8, QBLK = 32, KVBLK = 64, QB = NW * QBLK, PB = 64  ; constexpr int SHM_V = KVBLK * D * 2, SHM_K = KVBLK * D * 2; constexpr int LDS_BYTES = 2 * SHM_V + 2 * SHM_K + NW * 64 * 4; constexpr float THR = 8.f;
constexpr int QSTR = NP, KSTR = NP, OSTR = DM;
enum { ORDER_NATURAL = 0, ORDER_REVERSED = 1, ORDER_PAIRED = 2, ORDER_XCD = 4 };

typedef short bf16x8 __attribute__((ext_vector_type(8)));
typedef short s16x4 __attribute__((ext_vector_type(4)));
typedef float f32x16 __attribute__((ext_vector_type(16)));
typedef float f32x4 __attribute__((ext_vector_type(4)));
typedef unsigned u32x4 __attribute__((ext_vector_type(4)));
template <class A, class Bt> struct same_t { static constexpr bool v = false; };
template <class A> struct same_t<A, A> { static constexpr bool v = true; };
#define TOKOFF(w) (((w) & 1) * QBLK)
#define HEADOFF(w) (((w) >> 1) * D)
#define KSWZ(row, colB) ((row) * 256 + ((colB) ^ (((row) & 7) << 4)))
#define SBAR() __builtin_amdgcn_sched_barrier(0)
__device__ __forceinline__ int v_st(int k, int c) { const int kk = (k & ~0xC) | ((k & 4) << 1) | ((k & 8) >> 1); return ((kk >> 3) * 4 + (c >> 5)) * 512 + ((kk & 7) * 32 + (c & 31)) * 2; }
__device__ __forceinline__ int v_rd_base(int lane) { return ((lane & 3) << 3) | (((lane >> 2) & 3) << 6) | (((lane >> 4) & 1) << 5) | (((lane >> 5) & 1) << 8); }
constexpr int v_rd_off(int d0, int ks, int half) { return d0 * 512 + ks * 4096 + half * 2048; }
__device__ __forceinline__ int crow(int r, int hi) { return (r & 3) + 8 * (r >> 2) + 4 * hi; }
__device__ __forceinline__ unsigned cvtpk(float lo, float hi) {
    unsigned r; asm volatile("v_cvt_pk_bf16_f32 %0, %1, %2" : "=v"(r) : "v"(lo), "v"(hi)); return r;
}
__device__ __forceinline__ bf16x8 pack8(f32x4 a, f32x4 b) {
    u32x4 w = {cvtpk(a[0], a[1]), cvtpk(a[2], a[3]), cvtpk(b[0], b[1]), cvtpk(b[2], b[3])};
    return *reinterpret_cast<bf16x8*>(&w);
}
template <class T> __device__ __forceinline__ bf16x8 load8(const T* p) {
    if constexpr (same_t<T, float>::v) { return pack8(*(const f32x4*)p, *(const f32x4*)(p + 4)); }
    else { return *reinterpret_cast<const bf16x8*>(p); }
}
__device__ __forceinline__ void mask_tile(f32x16& p0, f32x16& p1, int dq, unsigned W) {
    const float NEG = -__builtin_inff();
#pragma unroll
    for (int r = 0; r < 16; ++r) {
        const int c = (r & 3) + 8 * (r >> 2);
        if ((unsigned)(dq - c) >= W) p0[r] = NEG;
        if ((unsigned)(dq - c - 32) >= W) p1[r] = NEG;
    }
}
__device__ __forceinline__ void mask_tile_sel(f32x16& p0, f32x16& p1, int dq, bool sel) {
    const float NEG = -__builtin_inff();
#pragma unroll
    for (int r = 0; r < 16; ++r) {
        const int c = (r & 3) + 8 * (r >> 2);
        if (!sel || dq - c < 0) p0[r] = NEG;
        if (!sel || dq - c - 32 < 0) p1[r] = NEG;
    }
}
__device__ __forceinline__ void partialSM(f32x16& p0, f32x16& p1, float& m_reg, float& mn, float& alpha) {
    float pmax = p0[0]; for (int r = 1; r < 16; ++r) pmax = fmaxf(pmax, p0[r]); for (int r = 0; r < 16; ++r) pmax = fmaxf(pmax, p1[r]);
    { auto rr = __builtin_amdgcn_permlane32_swap(__float_as_uint(pmax), __float_as_uint(pmax), false, false);
      pmax = fmaxf(__uint_as_float(rr[0]), __uint_as_float(rr[1])); }
    constexpr float C2 = 1.4426950408889634f * SCALE;
    if (__builtin_expect(__all((pmax - m_reg) * SCALE <= THR), 1)) { mn = m_reg; alpha = 1.f; }
    else { mn = fmaxf(m_reg, pmax); alpha = __builtin_amdgcn_exp2f((m_reg - mn) * C2); m_reg = mn; }
    const float mnL = -mn * C2;
    for (int r = 0; r < 16; ++r) p0[r] = fmaf(p0[r], C2, mnL); for (int r = 0; r < 16; ++r) p1[r] = fmaf(p1[r], C2, mnL);
    for (int r = 0; r < 16; ++r) p0[r] = __builtin_amdgcn_exp2f(p0[r]);
}
__device__ __forceinline__ void finishSM(f32x16& p0, f32x16& p1, float alpha, float& l_reg, bf16x8& pa0, bf16x8& pa1, bf16x8& pa2, bf16x8& pa3) {
    for (int r = 0; r < 16; ++r) p1[r] = __builtin_amdgcn_exp2f(p1[r]);
    float ps = 0; for (int r = 0; r < 16; ++r) ps += p0[r]; for (int r = 0; r < 16; ++r) ps += p1[r];
    { auto rr = __builtin_amdgcn_permlane32_swap(__float_as_uint(ps), __float_as_uint(ps), false, false);
      ps = __uint_as_float(rr[0]) + __uint_as_float(rr[1]); }
    l_reg = l_reg * alpha + ps;
#define PK4(P, B_, OUT) do { unsigned a0 = cvtpk(P[B_+0], P[B_+1]), a1 = cvtpk(P[B_+2], P[B_+3]);                          \
        unsigned b0 = cvtpk(P[B_+4], P[B_+5]), b1 = cvtpk(P[B_+6], P[B_+7]);                                             \
        auto r0 = __builtin_amdgcn_permlane32_swap(a0, b0, false, false); auto r1 = __builtin_amdgcn_permlane32_swap(a1, b1, false, false); \
        u32x4 w = {r0[0], r1[0], r0[1], r1[1]}; OUT = *reinterpret_cast<bf16x8*>(&w); } while (0)
    PK4(p0, 0, pa0); PK4(p0, 8, pa1); PK4(p1, 0, pa2); PK4(p1, 8, pa3);
#undef PK4
}
template <int KB, bool SK>
__device__ __forceinline__ void qkt(f32x16& p0, f32x16& p1, const char* K_lds, int r32, int hi, const bf16x8* qr, bool act) {
    if (SK && !act) { const float NEG = -__builtin_inff();
#pragma unroll
        for (int r = 0; r < 16; ++r) { p0[r] = NEG; p1[r] = NEG; } return; }
    p0 = f32x16{}; p1 = f32x16{};
    const char* kb[4];
#pragma unroll
    for (int dd = 0; dd < 4; ++dd) kb[dd] = K_lds + KB * SHM_K + KSWZ(r32, (dd * 16 + hi * 8) * 2);
#pragma unroll
    for (int d0 = 0; d0 < 8; ++d0) { const char* a = kb[d0 & 3] + (d0 >> 2) * 128;
        bf16x8 b0 = *reinterpret_cast<const bf16x8*>(a);
        bf16x8 b1 = *reinterpret_cast<const bf16x8*>(a + 32 * 256);
        p0 = __builtin_amdgcn_mfma_f32_32x32x16_bf16(b0, qr[d0], p0, 0, 0, 0);
        p1 = __builtin_amdgcn_mfma_f32_32x32x16_bf16(b1, qr[d0], p1, 0, 0, 0); }
}
template <int VB, bool SK>
__device__ __forceinline__ void pv_tile(f32x16* o, int vb0, bf16x8 pa0, bf16x8 pa1, bf16x8 pa2, bf16x8 pa3, bool act) {
    if (SK && !act) return;
#define TRRD(dst, off) asm volatile("ds_read_b64_tr_b16 %0, %1 offset:%2" : "=&v"(dst) : "v"(vb0), "i"(off) : "memory")
#define PV_D0(d0) do { s16x4 l0, l1, l2, l3, h0, h1, h2, h3; constexpr int b_ = VB * SHM_V + v_rd_off(d0, 0, 0);     \
        TRRD(l0, b_); TRRD(h0, b_ + 2048); TRRD(l1, b_ + 4096); TRRD(h1, b_ + 6144); TRRD(l2, b_ + 8192); TRRD(h2, b_ + 10240); TRRD(l3, b_ + 12288); TRRD(h3, b_ + 14336); \
        asm volatile("s_waitcnt lgkmcnt(0)" ::: "memory"); SBAR();                 \
        o[d0] = __builtin_amdgcn_mfma_f32_32x32x16_bf16(pa0, (bf16x8){l0[0], l0[1], l0[2], l0[3], h0[0], h0[1], h0[2], h0[3]}, o[d0], 0, 0, 0);   \
        o[d0] = __builtin_amdgcn_mfma_f32_32x32x16_bf16(pa1, (bf16x8){l1[0], l1[1], l1[2], l1[3], h1[0], h1[1], h1[2], h1[3]}, o[d0], 0, 0, 0);   \
        o[d0] = __builtin_amdgcn_mfma_f32_32x32x16_bf16(pa2, (bf16x8){l2[0], l2[1], l2[2], l2[3], h2[0], h2[1], h2[2], h2[3]}, o[d0], 0, 0, 0);   \
        o[d0] = __builtin_amdgcn_mfma_f32_32x32x16_bf16(pa3, (bf16x8){l3[0], l3[1], l3[2], l3[3], h3[0], h3[1], h3[2], h3[3]}, o[d0], 0, 0, 0); } while (0)
    PV_D0(0); PV_D0(1); PV_D0(2); PV_D0(3);
#undef PV_D0
#undef TRRD
}

template <class TIn, class TOut> struct BlockRef { const TIn* Q; const TIn* K; const TIn* V; TOut* O; const unsigned* SELP; int P0; };
template <class TIn> struct Seam {
    bf16x8 qr[8];
    bf16x8 st_v0, st_v1, st_k0, st_k1; f32x4 sf0, sf1, sf2, sf3;
    f32x4 tq[16];
};
__device__ __forceinline__ int swa_jlo(int P0, int W) { const int lowk = P0 - W + 1; return lowk > 0 ? lowk / KVBLK : 0; }
#define ROW(p, k0, rr) ((p) + (size_t)((k0) + (rr)) * KSTR + sc)
#define VMW() asm volatile("s_waitcnt vmcnt(0)" ::: "memory")
#define VMWN(n) asm volatile("s_waitcnt vmcnt(%0)" :: "i"(n) : "memory")
#define SLOAD_H(Kp, Vp, k0) do { S.st_v0 = load8<TIn>(ROW(Vp, k0, sr)); S.st_v1 = load8<TIn>(ROW(Vp, k0, 32 + sr));              \
                         S.st_k0 = load8<TIn>(ROW(Kp, k0, sr)); S.st_k1 = load8<TIn>(ROW(Kp, k0, 32 + sr)); } while (0)
#define SWRITE_HK(bf) do { *(bf16x8*)(K_lds + (bf) * SHM_K + kws) = S.st_k0; *(bf16x8*)(K_lds + (bf) * SHM_K + kws + 32 * 256) = S.st_k1; } while (0)
#define SWRITE_HV(bf) do { *(bf16x8*)(V_lds + (bf) * SHM_V + vst0) = S.st_v0; *(bf16x8*)(V_lds + (bf) * SHM_V + vst1) = S.st_v1; } while (0)
#define SWRITE_H(bf) do { SWRITE_HV(bf); SWRITE_HK(bf); } while (0)
#define SLOAD_F(p, k0) do { S.sf0 = *(const f32x4*)ROW(p, k0, sr); S.sf1 = *(const f32x4*)(ROW(p, k0, sr) + 4);                \
                            S.sf2 = *(const f32x4*)ROW(p, k0, 32 + sr); S.sf3 = *(const f32x4*)(ROW(p, k0, 32 + sr) + 4); } while (0)
#define SWRITE_KF(bf) do { *(bf16x8*)(K_lds + (bf) * SHM_K + kws) = pack8(S.sf0, S.sf1); *(bf16x8*)(K_lds + (bf) * SHM_K + kws + 32 * 256) = pack8(S.sf2, S.sf3); } while (0)
#define SWRITE_VF(bf) do { *(bf16x8*)(V_lds + (bf) * SHM_V + vst0) = pack8(S.sf0, S.sf1); *(bf16x8*)(V_lds + (bf) * SHM_V + vst1) = pack8(S.sf2, S.sf3); } while (0)
template <class TIn, class TOut>
__device__ __forceinline__ void causal_swa_prime(const BlockRef<TIn, TOut>& cur, int W, char* lds, Seam<TIn>& S) {
    constexpr bool F32 = same_t<TIn, float>::v;
    const int tid = threadIdx.x, wid = __builtin_amdgcn_readfirstlane(tid >> 6), lane = tid & 63, r32 = lane & 31, hi = lane >> 5;
    const int sr = tid >> 4, sc = (tid & 15) * 8, kws = KSWZ(sr, sc * 2); char* K_lds = lds + 2 * SHM_V;
    const int kb0 = swa_jlo(cur.P0, W) * KVBLK;
    for (int d0 = 0; d0 < 8; ++d0) S.qr[d0] = load8<TIn>(cur.Q + HEADOFF(wid) + (size_t)(TOKOFF(wid) + r32) * QSTR + d0 * 16 + hi * 8);
    if constexpr (F32) { SLOAD_F((const float*)cur.K, kb0); VMW(); SWRITE_KF(0); SBAR(); SLOAD_F((const float*)cur.V, kb0); }
    else { SLOAD_H(cur.K, cur.V, kb0); VMW(); SWRITE_HK(0); }
    __syncthreads();
}
template <int MODE, class TIn, class TOut>
__device__ __forceinline__ void causal_swa_block(const BlockRef<TIn, TOut>& cur, const BlockRef<TIn, TOut>& nxt, int skv, int W, char* lds, Seam<TIn>& S) {
    constexpr bool F32 = same_t<TIn, float>::v;
    const int tid = threadIdx.x, wid = __builtin_amdgcn_readfirstlane(tid >> 6), lane = tid & 63, r32 = lane & 31, hi = lane >> 5;
    const int j_lo = swa_jlo(cur.P0, W);
    int j_hi = (cur.P0 + PB - 1) / KVBLK + 1; if (j_hi > skv / KVBLK) j_hi = skv / KVBLK;
    const int NT = j_hi - j_lo;
    const int kbn = swa_jlo(nxt.P0, W) * KVBLK;
    const int qlo = cur.P0 + TOKOFF(wid), qm = qlo + r32 - 4 * hi;
    unsigned selrow = 0xffffffffu; if constexpr (MODE == 1) selrow = cur.SELP[(size_t)(TOKOFF(wid) + r32) * GKV];
    char* V_lds = lds; char* K_lds = lds + 2 * SHM_V;
    float* ws = (float*)(lds + 2 * SHM_V + 2 * SHM_K) + wid * 64; float* li_l = ws, * al_l = ws + 32;
    float m_reg = -1e30f, l_reg = 0; f32x16 o[4] = {};
    const int sr = tid >> 4, sc = (tid & 15) * 8, vst0 = v_st(sr, sc), vst1 = v_st(32 + sr, sc), kws = KSWZ(sr, sc * 2);
    const int vb0 = (int)(uintptr_t)V_lds + v_rd_base(lane);
    const TIn* Kh = cur.K; const TIn* Vh = cur.V;
#define RESC(a) do { if (__any((a) < 1.f)) { if (hi == 0) al_l[r32] = (a); asm volatile("s_waitcnt lgkmcnt(0)" ::: "memory");              \
                     for (int d_ = 0; d_ < 4; ++d_) for (int r = 0; r < 16; ++r) o[d_][r] *= al_l[crow(r, hi)]; } } while (0)
#define KBASE(t) ((j_lo + (t)) * KVBLK)
#define ACT(t) (KBASE(t) <= qlo + QBLK - 1 && KBASE(t) + KVBLK - 1 >= qlo - W + 1)
#define MASKT(P0_, P1_, t) do { const int kb_ = KBASE(t); if constexpr (MODE == 1) { const bool sb_ = (selrow >> (kb_ >> 6)) & 1u; if (__any(!sb_) || kb_ + KVBLK - 1 > qlo) mask_tile_sel(P0_, P1_, qm - kb_, sb_); } else { if ((!SK || ACT(t)) && (kb_ + KVBLK - 1 > qlo || kb_ <= qlo + QBLK - 1 - W)) mask_tile(P0_, P1_, qm - kb_, (unsigned)W); } } while (0)
    constexpr int NQL = F32 ? 16 : 8;
    constexpr bool SK = false;
#define SEAM_K0() do { VMWN(NQL); if constexpr (F32) { SWRITE_KF(0); SBAR(); SLOAD_F((const float*)nxt.V, kbn); } else { SWRITE_HK(0); } SBAR(); } while (0)
    f32x16 pA0, pA1, pB0, pB1; float mnA, mnB, alA, alB; bf16x8 pa0, pa1, pa2, pa3;
    if constexpr (F32) { VMW(); SWRITE_VF(0); SBAR(); } else { SWRITE_HV(0); SBAR(); }
    if (NT > 1) { if constexpr (F32) SLOAD_F((const float*)Kh, KBASE(1)); else SLOAD_H(Kh, Vh, KBASE(1)); }
    SBAR(); qkt<0, SK>(pA0, pA1, K_lds, r32, hi, S.qr, ACT(0));
    if constexpr (F32) { if (NT > 1) { VMW(); SWRITE_KF(1); SBAR(); SLOAD_F((const float*)Vh, KBASE(1)); } }
    MASKT(pA0, pA1, 0); partialSM(pA0, pA1, m_reg, mnA, alA);
    if (NT > 1) { VMW(); if constexpr (F32) { SWRITE_VF(1); SBAR(); if (NT > 2) SLOAD_F((const float*)Kh, KBASE(2)); } else SWRITE_H(1); }
    __syncthreads();
#define HALF_STEP(PX0, PX1, mnX, alX, PY0, PY1, alY, t, KB, VB, SB) do {                                                      \
        SBAR(); qkt<KB, SK>(PX0, PX1, K_lds, r32, hi, S.qr, ACT(t));                                             \
        finishSM(PY0, PY1, alY, l_reg, pa0, pa1, pa2, pa3); SBAR();                                                           \
        if ((t) + 1 < NT) { if constexpr (F32) { VMW(); SWRITE_KF(SB); SBAR(); SLOAD_F((const float*)Vh, KBASE((t) + 1)); }  \
                            else { SLOAD_H(Kh, Vh, KBASE((t) + 1)); } SBAR(); }                                               \
        pv_tile<VB, SK>(o, vb0, pa0, pa1, pa2, pa3, ACT((t) - 1)); MASKT(PX0, PX1, (t)); partialSM(PX0, PX1, m_reg, mnX, alX);                                        \
        __syncthreads();                                                                                                      \
        if ((t) + 1 < NT) { VMW(); if constexpr (F32) { SWRITE_VF(SB); SBAR(); if ((t) + 2 < NT) SLOAD_F((const float*)Kh, KBASE((t) + 2)); } \
                            else { SWRITE_H(SB); } }                                                                          \
        RESC(alX); __syncthreads(); } while (0)
    for (int t = 1; t + 1 < NT; t += 2) {
        HALF_STEP(pB0, pB1, mnB, alB, pA0, pA1, alA, t, 1, 0, 0);
        HALF_STEP(pA0, pA1, mnA, alA, pB0, pB1, alB, t + 1, 0, 1, 1);
    }
    const bool even = (NT & 1) == 0;
    if (even) { SBAR(); qkt<1, SK>(pB0, pB1, K_lds, r32, hi, S.qr, ACT(NT - 1)); SBAR(); }
#define QROW(e) (nxt.Q + HEADOFF(wid) + (size_t)(TOKOFF(wid) + r32) * QSTR + ((e) >> 1) * 16 + hi * 8 + ((e) & 1) * 4)
    if constexpr (F32) { SLOAD_F((const float*)nxt.K, kbn); SBAR();
#pragma unroll
        for (int e = 0; e < 8; ++e) S.tq[e] = *(const f32x4*)QROW(e); }
    else { SLOAD_H(nxt.K, nxt.V, kbn); SBAR();
#pragma unroll
        for (int d0 = 0; d0 < 8; ++d0) S.qr[d0] = load8<TIn>(nxt.Q + HEADOFF(wid) + (size_t)(TOKOFF(wid) + r32) * QSTR + d0 * 16 + hi * 8); }
    SBAR();
    finishSM(pA0, pA1, alA, l_reg, pa0, pa1, pa2, pa3); SBAR();
    if constexpr (F32) {
#pragma unroll
        for (int e = 8; e < 16; ++e) S.tq[e] = *(const f32x4*)QROW(e); SBAR(); }
#undef QROW
    pv_tile<0, SK>(o, vb0, pa0, pa1, pa2, pa3, ACT(even ? NT - 2 : NT - 1));
    if (even) { MASKT(pB0, pB1, NT - 1); partialSM(pB0, pB1, m_reg, mnB, alB); __syncthreads(); RESC(alB);
        finishSM(pB0, pB1, alB, l_reg, pa0, pa1, pa2, pa3); SBAR(); pv_tile<1, SK>(o, vb0, pa0, pa1, pa2, pa3, ACT(NT - 1)); }
    SBAR(); SEAM_K0();
    if (hi == 0) li_l[r32] = l_reg; asm volatile("s_waitcnt lgkmcnt(0)" ::: "memory");
    float rli[16];
#pragma unroll
    for (int r = 0; r < 16; ++r) rli[r] = __builtin_amdgcn_rcpf(li_l[crow(r, hi)]);
    TOut* Ow = cur.O + HEADOFF(wid) + (size_t)TOKOFF(wid) * OSTR;
#pragma unroll
    for (int r = 0; r < 16; ++r) { const int orow = crow(r, hi);
#pragma unroll
        for (int d0 = 0; d0 < 4; ++d0) { const float v = o[d0][r] * rli[r];
            if constexpr (same_t<TOut, float>::v) { Ow[(size_t)orow * OSTR + d0 * 32 + r32] = v; }
            else { const float vn = __shfl_xor(v, 1);
                   if ((r32 & 1) == 0) *(unsigned*)(Ow + (size_t)orow * OSTR + d0 * 32 + r32) = cvtpk(v, vn); } } }
    if constexpr (F32) {
#pragma unroll
        for (int d0 = 0; d0 < 8; ++d0) S.qr[d0] = pack8(S.tq[2 * d0], S.tq[2 * d0 + 1]); }
    __syncthreads();
#undef RESC
#undef KBASE
#undef ACT
#undef MASKT
#undef SEAM_K0
#undef HALF_STEP
}
#undef ROW
#undef VMW
#undef VMWN
#undef SLOAD_H
#undef SWRITE_HK
#undef SWRITE_HV
#undef SWRITE_H
#undef SLOAD_F
#undef SWRITE_KF
#undef SWRITE_VF
__host__ __device__ inline int swa_nramp(int nqb, int W, int qoff) { const int t = W - 1 - qoff; const int n = t < 0 ? 0 : t / PB + 1; return n > nqb ? nqb : n; }
__host__ __device__ inline int swa_nx(int nqb, int nramp, int order) { return (order & ORDER_PAIRED) ? (nramp + 1) / 2 + (nqb - nramp) : nqb; }
struct SwaItem { int bh, qb0, qb1; };
__device__ __forceinline__ SwaItem swa_decode(int L, int nb, int nh, int nhkv, int nqb, int nx, int nramp, int order) {
    const int G = nh / nhkv; SwaItem it; int x;
    if ((order & ORDER_XCD) && (nb * nhkv) % 8 == 0) { const int xcd = L & 7, k = L >> 3, per = G * nx, gi = k / per, r = k - gi * per;
        it.bh = (gi * 8 + xcd) * G + r / nx; x = r % nx; }
    else { it.bh = L / nx; x = L - it.bh * nx; }
    if (order & ORDER_PAIRED) { const int ns = nqb - nramp;
        if (x < ns) { it.qb0 = it.qb1 = nqb - 1 - x; } else { it.qb0 = x - ns; it.qb1 = nramp - 1 - it.qb0; } }
    else { it.qb0 = it.qb1 = ((order & 3) == ORDER_REVERSED) ? nqb - 1 - x : x; }
    return it;
}
}
template <int MODE>
__device__ __forceinline__ fa::BlockRef<bf16, bf16> fa_ref(unsigned char* ws, const fa::SwaItem& it, int pass) {
    const int tb = pass ? it.qb1 : it.qb0, b = it.bh >> 2, g = it.bh & 3;
    const bf16* P = (const bf16*)(ws + WS_P);
    fa::BlockRef<bf16, bf16> r;
    const size_t m0 = (size_t)b * SEQ + (size_t)tb * fa::PB;
    r.Q = P + m0 * NP + C_QB + g * RG * 128;
    r.K = P + (size_t)b * SEQ * NP + (MODE ? C_KS : C_KW) + g * 128;
    r.V = P + (size_t)b * SEQ * NP + (MODE ? C_VS : C_VW) + g * 128;
    r.O = (bf16*)(ws + (MODE ? WS_OSB : WS_OWB)) + m0 * DM + g * RG * 128;
    r.SELP = (const unsigned*)(ws + WS_SEL) + m0 * GKV + g;
    r.P0 = tb * fa::PB;
    return r;
}
#ifndef FA0_CMP_ITEMS
#define FA0_CMP_ITEMS 5
#endif
template <int MODE>
__device__ __forceinline__ void fa_phase(const Ctx& C, char* lds, int nwg  ) {
    using namespace fa;
    constexpr int W = MODE == 0 ? WIN : SEQ;
    constexpr int nqb = SEQ / PB, order = ORDER_PAIRED | ORDER_XCD;
    const int nramp = swa_nramp(nqb, W, 0), nx = swa_nx(nqb, nramp, order); int total = nx * BATCH * GKV, stride = nwg;
    int L = (MODE == 0 && nwg == C.G) ? (C.bid + C.G / 2) % C.G : C.bid;
    if (MODE == 0 && nwg == C.G && FA0_CMP_ITEMS > 0 && total == 7 * (C.G / 2)) {
        const int h = C.G / 2; stride = h;
        if (L < h) total = FA0_CMP_ITEMS * h; else L = FA0_CMP_ITEMS * h + (L - h); }
    if (L >= total || C.bid >= nwg) return;
    SwaItem it = swa_decode(L, BATCH, GKV, GKV, nqb, nx, nramp, order); int pass = 0;
    BlockRef<bf16, bf16> cur = fa_ref<MODE>(C.ws, it, 0);
    Seam<bf16> S;
    causal_swa_prime<bf16, bf16>(cur, W, lds, S);
    for (;;) {
        const bool more_pass = pass == 0 && it.qb1 != it.qb0, more_item = L + stride < total, last = !more_pass && !more_item;
        SwaItem itn = it; int passn = pass + 1, Ln = L;
        if (!more_pass) { passn = 0; Ln = more_item ? L + stride : L; itn = swa_decode(Ln, BATCH, GKV, GKV, nqb, nx, nramp, order); }
        const BlockRef<bf16, bf16> nxt = last ? cur : fa_ref<MODE>(C.ws, itn, passn);
        causal_swa_block<MODE, bf16, bf16>(cur, nxt, SEQ, W, lds, S);
        if (last) break;
        cur = nxt; it = itn; pass = passn; L = Ln;
    }
}
__device__ __forceinline__ void nsa_combine(const Ctx& C) {
    const bf16* P = WSP(bf16, WS_P); const bf16* OC = WSP(bf16, WS_OCB); const bf16* OS = WSP(bf16, WS_OSB); const bf16* OW = WSP(bf16, WS_OWB); bf16* OB = WSP(bf16, WS_OB);
    for (int idx = C.bid * NTHR + C.tid; idx < T * 256; idx += C.G * NTHR) {
        const int m = idx >> 8, col = (idx & 255) * 8, hb = col >> 7;
        const bf16* gp = P + (size_t)m * NP + C_GB + hb * 3;
        const float g0 = sigmoidf_(bf2f(gp[0])), g1 = sigmoidf_(bf2f(gp[1])), g2 = sigmoidf_(bf2f(gp[2]));
        const size_t o = (size_t)m * DM + col;
        const v4u cw = *(const v4u*)(OC + o);
        const f32x4 c0 = {bflo(cw.x), bfhi(cw.x), bflo(cw.y), bfhi(cw.y)}, c1 = {bflo(cw.z), bfhi(cw.z), bflo(cw.w), bfhi(cw.w)};
        const v4u sw = *(const v4u*)(OS + o), ww = *(const v4u*)(OW + o);
        v4u r;
        r.x = pk2(g0 * c0.x + g1 * bflo(sw.x) + g2 * bflo(ww.x), g0 * c0.y + g1 * bfhi(sw.x) + g2 * bfhi(ww.x));
        r.y = pk2(g0 * c0.z + g1 * bflo(sw.y) + g2 * bflo(ww.y), g0 * c0.w + g1 * bfhi(sw.y) + g2 * bfhi(ww.y));
        r.z = pk2(g0 * c1.x + g1 * bflo(sw.z) + g2 * bflo(ww.z), g0 * c1.y + g1 * bfhi(sw.z) + g2 * bfhi(ww.z));
        r.w = pk2(g0 * c1.z + g1 * bflo(sw.w) + g2 * bflo(ww.w), g0 * c1.w + g1 * bfhi(sw.w) + g2 * bfhi(ww.w));
        *(v4u*)(OB + o) = r;
    }
}
#ifndef MK_N_LAUNCHES
#define MK_N_LAUNCHES 1
#endif
constexpr int N_PHASES = 13;
#ifndef FA1_WGS
#define FA1_WGS 171
#endif
#ifndef CONV_P4
#define CONV_P4 49000
#endif
#ifndef G10_WGS
#define G10_WGS 224
#endif
#ifndef CONV_P10
#define CONV_P10 24576
#endif
#ifndef CONV_Q10
#define CONV_Q10 8192
#endif


__global__ void __launch_bounds__(NTHR, 2) fwd(Args args) {
    extern __shared__ __attribute__((aligned(16))) unsigned char lds_raw[];
    Ctx C;
    C.lds = (LAS unsigned char*)lds_raw; C.tid = threadIdx.x; C.lane = C.tid & 63; C.wave = __builtin_amdgcn_readfirstlane(C.tid >> 6); C.G = gridDim.x; C.bid = blockIdx.x;
    C.A = &args;
    C.out = args.out; C.ws = args.ws; C.ctl = (unsigned*)(args.ws + WS_CTL);
    volatile LAS unsigned* MISC = (volatile LAS unsigned*)(C.lds + MISC_OFF);
    if (C.tid < 32) MISC[C.tid] = 0u;
    __syncthreads();
    const int lo = args.ph_lo, hi = args.ph_hi;
    XcdBarrier bar; bar.bar = C.ctl + CW_BAR + args.li * 4096; bar.x = 0; bar.st = nullptr;
    if (hi - lo > 1) bar = xcd_barrier_post(C.ctl + CW_BAR + args.li * 4096, MISC + 8);
#ifndef PH_MASK
#define PH_MASK 0x1FFF
#endif
#define IN(k) (((PH_MASK >> (k)) & 1) && lo <= (k) && (k) < hi)
#define PH_BEGIN() do { int t_ = threadIdx.x; asm volatile("" : "+v"(t_)); C.tid = t_; C.lane = t_ & 63; } while (0)
#define SEAM(k) do { if (IN(k) && IN((k) + 1)) xcd_barrier(bar); } while (0)
    bf16* P = WSP(bf16, WS_P);
    if (IN(0)) { PH_BEGIN(); p0_prologue(C); SEAM(0); }
    if (IN(1)) { PH_BEGIN();
        pg8::Gemm g{WSP(bf16, P1_FP8 ? WS_H8 : WS_H), WSP(bf16, WS_WINT), T, 17408, P1_FP8 ? DM / 2 : DM}; pg8::StaticOrderT<P1_FP8 != 0> S; S.init(T, 17408, C.G, C.bid);
        EpiP1 E{P, WSP(float, WS_RC), WSP(float, WS_RS)};
        pg8::gemm_phase<EpiP1, pg8::StaticOrderT<P1_FP8 != 0>, PG8_ALIGN, PG8_SP2>(C.lds + RING_OFF, g, S, E);
        if (args.pad != 1) small_proj(C);
        SEAM(1);
    }
    const int sub = args.pad;
    if (IN(2)) { PH_BEGIN(); if (sub != 2) dn_chunk_prep(C, C.bid * NWAVES + C.wave, C.G * NWAVES); if (sub != 1) nsa_compress2(C); SEAM(2); }
    if (IN(3)) { PH_BEGIN();
        const int half = C.G / 2;
#ifndef X_NO_SCAN
        if (C.bid < half && sub != 2 && sub != 4) { for (int u = C.bid; u < BATCH * HA; u += half) dn_scan(C, u); }
#endif
#ifndef X_NO_CMP
        if (C.bid >= half && sub != 2 && sub != 3) nsa_cmp_attn2(C, C.bid - half, C.G - half);
#endif
        __syncthreads();
#ifndef X_NO_FA0
        if (sub != 1) fa_phase<0>(C, (char*)lds_raw + RING_OFF, C.G);
#endif
        SEAM(3);
    }
    if (IN(4)) { PH_BEGIN();
        const int nfa = C.G > FA1_WGS ? FA1_WGS : C.G;
        if (sub != 2) fa_phase<1>(C, (char*)lds_raw + RING_OFF, nfa);
        if (sub == 0 && C.bid >= nfa) moe_weight_convert(C, 0, CONV_P4, (C.bid - nfa) * NWAVES + C.wave, (C.G - nfa) * NWAVES);
        if (sub != 1) dn_post2(C); SEAM(4); }
    if (IN(5)) { PH_BEGIN(); nsa_combine(C); SEAM(5); }
    if (IN(6)) { PH_BEGIN();
        { pg8::Gemm g{WSP(bf16, WS_OA), WSP(bf16, WS_WPA), T, DM, DM}; pg8::StaticOrder S; S.init(T, DM, C.G, C.bid);
          EpiProj<0> E{P, WSP(bf16, WS_M1), WSP(bf16, WS_MERGED)};
          pg8::gemm_phase<EpiProj<0>, pg8::StaticOrder, PG8_ALIGN, PG8_SP2>(C.lds + RING_OFF, g, S, E); }
        { pg8::Gemm g{WSP(bf16, WS_OB), WSP(bf16, WS_WPB), T, DM, DM}; pg8::StaticOrder S; S.init(T, DM, C.G, C.bid);
          EpiProj<1> E{P, WSP(bf16, WS_M1), WSP(bf16, WS_MERGED)};
          pg8::gemm_phase<EpiProj<1>, pg8::StaticOrder, PG8_ALIGN, PG8_SP2>(C.lds + RING_OFF, g, S, E); }
        SEAM(6);
    }
    if (IN(7)) { PH_BEGIN();
        pg8::Gemm g{WSP(bf16, WS_MERGED), WSP(bf16, WS_WOT), T, DM, DM}; pg8::StaticOrder S; S.init(T, DM, C.G, C.bid);
        EpiOut E{((const float*)C.A->in[0]), WSP(bf16, WS_HN)};
        pg8::gemm_phase<EpiOut, pg8::StaticOrder, PG8_ALIGN, PG8_SP2>(C.lds + RING_OFF, g, S, E);
        SEAM(7);
    }
    if (IN(8)) { PH_BEGIN(); if (C.tid < 4) ((LAS int*)(C.lds + 133120 + (C.tid >> 1) * 5120))[1120 + (C.tid & 1)] = 0; __syncthreads();
        p7_norm_router(C); moe_weight_convert(C, (C.G > FA1_WGS) ? CONV_P4 : 0, (C.G > FA1_WGS) ? 98304 - CONV_Q10 - ((C.G > G10_WGS) ? CONV_P10 : 0) : (1 << 30), C.wave < 4 ? -1 : C.bid * (NWAVES - 4) + C.wave - 4, C.G * (NWAVES - 4)); SEAM(8); }
    if (IN(9)) { PH_BEGIN(); p8_gather(C); SEAM(9); }
    if (IN(10)) { PH_BEGIN();
        int total; moe_tables(C, 16, total);
        pg8::Gemm g{WSP(bf16, WS_XG), WSP(bf16, WS_WGU), MOE_ROWS, NEXP * 4096, MOE_FP8 ? DM / 2 : DM};
        const int g10 = (C.G > FA1_WGS && C.G > G10_WGS && sub == 0) ? G10_WGS : C.G;
        MoeOrder<false> S{(const LAS int*)(C.lds + TAB_OFF), 16, g10, C.bid, total, nullptr};
        EpiMoe1 E{WSP(bf16, WS_ACT), ((const float*)C.A->in[21]), ((const float*)C.A->in[23])};
        if (C.bid < g10) pg8::gemm_phase<EpiMoe1, MoeOrder<false>, PG8_ALIGN, MOE_SP2>(C.lds + RING_OFF, g, S, E);
        else moe_weight_convert(C, 98304 - CONV_Q10 - CONV_P10, 98304 - CONV_Q10, (C.bid - g10) * NWAVES + C.wave, (C.G - g10) * NWAVES);
        if (sub == 0 && C.G > FA1_WGS) moe_convert_queue(C, 98304 - CONV_Q10, CONV_Q10);
        SEAM(10);
    }
    if (IN(11)) { PH_BEGIN();
        int total; moe_tables(C, 8, total);
        pg8::Gemm g{WSP(bf16, WS_ACT), WSP(bf16, WS_WD), MOE_ROWS, NEXP * DM, MOE_FP8 ? DFF / 2 : DFF};
        MoeOrder<false> S{(const LAS int*)(C.lds + TAB_OFF), 8, C.G, C.bid, total, nullptr};
        EpiMoe2 E{WSP(bf16, WS_Y), ((const float*)C.A->in[25])};
        pg8::gemm_phase<EpiMoe2, MoeOrder<false>, PG8_ALIGN, MOE_SP2>(C.lds + RING_OFF, g, S, E);
        SEAM(11);
    }
    if (IN(12)) { PH_BEGIN(); p11_final(C); }
}

extern "C" void kernel_launch(void* const* d_in, const int* in_sizes, int n_in, void* d_out, int out_size, void* d_ws, size_t ws_size, hipStream_t stream) {
    static int grid = 0;
    if (grid == 0) {
        if (n_in != 27 || out_size != T * DM || ws_size < WS_END) { fprintf(stderr, "kernel_launch: unexpected shapes (n_in %d out %d ws %zu)\n", n_in, out_size, ws_size); grid = -1; return; }
        int dev = 0, cus = 0, per_cu = 0;
        if (hipGetDevice(&dev) != hipSuccess || hipDeviceGetAttribute(&cus, hipDeviceAttributeMultiprocessorCount, dev) != hipSuccess) { grid = -1; return; }
        if (hipFuncSetAttribute((const void*)fwd, hipFuncAttributeMaxDynamicSharedMemorySize, LDS_BYTES) != hipSuccess) { fprintf(stderr, "kernel_launch: hipFuncSetAttribute failed\n"); grid = -1; return; }
        if (hipOccupancyMaxActiveBlocksPerMultiprocessor(&per_cu, (const void*)fwd, NTHR, LDS_BYTES) != hipSuccess || per_cu < 1) fprintf(stderr, "kernel_launch: occupancy query says %d\n", per_cu);
        (void)hipGetLastError();
        grid = cus;
    }
    if (grid < 0) return;
    if (hipMemsetAsync((char*)d_ws + WS_CTL, 0, CTL_ZERO_BYTES, stream) != hipSuccess) return;
    Args a{};
    for (int i = 0; i < 27; ++i) a.in[i] = d_in[i];
    a.out = (float*)d_out; a.ws = (unsigned char*)d_ws;
#if MK_N_LAUNCHES == 1
    const int cuts[2] = {0, N_PHASES}; const int nl = 1;
#else
    int cuts[N_PHASES + 1]; for (int i = 0; i <= N_PHASES; ++i) cuts[i] = i; const int nl = N_PHASES;
#endif
    for (int li = 0; li < nl; ++li) {
        a.ph_lo = cuts[li]; a.ph_hi = cuts[li + 1]; a.li = li; a.pad = 0;
        hipLaunchKernelGGL(fwd, dim3(grid), dim3(NTHR), LDS_BYTES, stream, a);
        const hipError_t le = hipPeekAtLastError();
        if (le != hipSuccess) { fprintf(stderr, "kernel_launch: launch %d failed: %s\n", li, hipGetErrorName(le)); break; }
    }
#if defined(PROBE_LO)
    { a.ph_lo = PROBE_LO; a.ph_hi = PROBE_HI; a.li = 1;
#if defined(PROBE_SUB)
      a.pad = PROBE_SUB;
#else
      a.pad = 0;
#endif
 hipLaunchKernelGGL(fwd, dim3(grid), dim3(NTHR), LDS_BYTES, stream, a); }
#endif
}
```
